# Optimizing an MI355X kernel written in HIP

```python
import jax, jax.numpy as jnp
from jax import lax
import numpy as np

D_MODEL = 1024
BATCH = 8
SEQ = 4096
DEPTH = 2

ML_HEADS = 4
ML_DIM = 128
ML_W = ML_HEADS * ML_DIM
ML_CONV = 4
ML_CHUNK = 64
GLA_HEADS = 4
GLA_DK = 64
GLA_DV = 128
GLA_K_W = GLA_HEADS * GLA_DK
GLA_V_W = GLA_HEADS * GLA_DV
GLA_RANK = 16
GLA_TAU = 16.0
GLA_CHUNK = 32
RET_HEADS = 4
RET_DIM = 128
RET_W = RET_HEADS * RET_DIM
RET_CHUNK = 64
ROPE_BASE = 10000.0
RW_HEADS = 8
RW_DIM = 64
RW_W = RW_HEADS * RW_DIM
RW_DECAY_RANK = 64
RW_A_RANK = 64
RW_GATE_RANK = 128
RW_LN_EPS = 64e-5
D_FF = 3584
N_EXPERTS = 8
TOP_K = 2
EPS = 1e-6

E_SPLITS = (2 * ML_W, ML_W, ML_W, 2 * ML_HEADS, GLA_K_W, GLA_K_W, GLA_V_W, GLA_V_W, GLA_RANK)
E_COLS = sum(E_SPLITS)
E_MIX_W = ML_W + GLA_V_W
RET_SPLITS = (RET_W, RET_W, RET_W, RET_W)
RET_COLS = sum(RET_SPLITS)
RW_SPLITS = (RW_W, RW_W, RW_W, RW_DECAY_RANK, RW_A_RANK, RW_GATE_RANK)
RW_COLS = sum(RW_SPLITS)
O_COLS = RET_COLS + RW_COLS
O_MIX_W = RET_W + RW_W

kernel_name = 'hybrid_mlstm_gla_retnet_rwkv7_moe'


def rms_norm(x, g):
    xf = x.astype(jnp.float32)
    y = xf * lax.rsqrt(jnp.mean(xf * xf, axis=-1, keepdims=True) + EPS)
    return (y * g).astype(x.dtype)


def head_layer_norm(x, eps):
    xf = x.astype(jnp.float32)
    xc = xf - jnp.mean(xf, axis=-1, keepdims=True)
    return xc * lax.rsqrt(jnp.mean(xc * xc, axis=-1, keepdims=True) + eps)


def head_rms_norm(x, eps):
    xf = x.astype(jnp.float32)
    return xf * lax.rsqrt(jnp.mean(xf * xf, axis=-1, keepdims=True) + eps)


def split_cols(p, sizes):
    idx = np.cumsum(sizes)[:-1].tolist()
    return jnp.split(p, idx, axis=-1)


def heads(a, n):
    return a.reshape(a.shape[:-1] + (n, -1)).astype(jnp.float32)


def token_shift(x):
    return jnp.pad(x[:, :-1], ((0, 0), (1, 0), (0, 0)))


def causal_depthwise_conv(x, w, b):
    c = x.shape[-1]
    y = lax.conv_general_dilated(x, w[:, None, :].astype(x.dtype), window_strides=(1,),
                                 padding=[(w.shape[0] - 1, 0)],
                                 dimension_numbers=('NWC', 'WIO', 'NWC'), feature_group_count=c)
    return y + b


def apply_rotary(x, positions):
    d = x.shape[-1]
    inv = ROPE_BASE ** (-jnp.arange(0, d, 2, dtype=jnp.float32) / d)
    ang = positions.astype(jnp.float32)[:, None] * inv[None, :]
    cos = jnp.cos(ang)[None, :, None, :]
    sin = jnp.sin(ang)[None, :, None, :]
    x1, x2 = x[..., : d // 2], x[..., d // 2:]
    return jnp.concatenate([x1 * cos - x2 * sin, x1 * sin + x2 * cos], axis=-1)


def to_chunks(a, L):
    b, t = a.shape[:2]
    a = a.reshape((b, t // L, L) + a.shape[2:])
    return jnp.moveaxis(a, (1, 3), (0, 2))


def from_chunks(a):
    a = jnp.moveaxis(a, (0, 2), (1, 3))
    return a.reshape((a.shape[0], a.shape[1] * a.shape[2]) + a.shape[3:])


def mlstm_chunkwise(q, k, v, i_pre, f_pre):
    bsz, t, nh, d = q.shape
    L = ML_CHUNK
    causal = jnp.tril(jnp.ones((L, L), dtype=bool))
    log_f = jax.nn.log_sigmoid(f_pre)
    xs = (to_chunks(q * d ** -0.5, L), to_chunks(k, L), to_chunks(v, L),
          to_chunks(i_pre, L), to_chunks(log_f, L))

    def step(carry, inp):
        c_st, n_st, m_st = carry
        qc, kc, vc, ic, fc = inp
        b = jnp.cumsum(fc, axis=-1)
        d_intra = jnp.where(causal, b[..., :, None] - b[..., None, :] + ic[..., None, :], -jnp.inf)
        d_inter = b + m_st[..., None]
        m_row = jnp.maximum(d_inter, jnp.max(d_intra, axis=-1))
        w_intra = jnp.exp(d_intra - m_row[..., None])
        w_inter = jnp.exp(d_inter - m_row)
        s = jnp.einsum('bhid,bhjd->bhij', qc, kc) * w_intra
        num = jnp.einsum('bhij,bhje->bhie', s, vc) + w_inter[..., None] * jnp.einsum('bhid,bhde->bhie', qc, c_st)
        den = jnp.sum(s, axis=-1) + w_inter * jnp.einsum('bhid,bhd->bhi', qc, n_st)
        h = num / jnp.maximum(jnp.abs(den), jnp.exp(-m_row))[..., None]
        g = b[..., -1]
        d_state = g[..., None] - b + ic
        m_new = jnp.maximum(g + m_st, jnp.max(d_state, axis=-1))
        w_state = jnp.exp(d_state - m_new[..., None])
        carry_decay = jnp.exp(g + m_st - m_new)
        c_st = carry_decay[..., None, None] * c_st + jnp.einsum('bhj,bhjd,bhje->bhde', w_state, kc, vc)
        n_st = carry_decay[..., None] * n_st + jnp.einsum('bhj,bhjd->bhd', w_state, kc)
        return (c_st, n_st, m_new), h

    init = (jnp.zeros((bsz, nh, d, v.shape[-1]), jnp.float32), jnp.zeros((bsz, nh, d), jnp.float32),
            jnp.zeros((bsz, nh), jnp.float32))
    _, h = lax.scan(step, init, xs)
    return from_chunks(h)


def gla_chunkwise(q, k, v, log_a):
    bsz, t, nh, dk = q.shape
    L = GLA_CHUNK
    causal = jnp.tril(jnp.ones((L, L), dtype=bool))[:, :, None]
    xs = (to_chunks(q, L), to_chunks(k, L), to_chunks(v, L), to_chunks(log_a, L))

    def step(s_st, inp):
        qc, kc, vc, ac = inp
        b = jnp.cumsum(ac, axis=2)
        diff = jnp.where(causal, b[:, :, :, None, :] - b[:, :, None, :, :], -jnp.inf)
        att = jnp.einsum('bhid,bhjd,bhijd->bhij', qc, kc, jnp.exp(diff))
        o = jnp.einsum('bhij,bhje->bhie', att, vc) + jnp.einsum('bhid,bhde->bhie', qc * jnp.exp(b), s_st)
        g = b[:, :, -1]
        s_st = jnp.exp(g)[..., None] * s_st + jnp.einsum('bhjd,bhje->bhde', kc * jnp.exp(g[:, :, None] - b), vc)
        return s_st, o

    init = jnp.zeros((bsz, nh, dk, v.shape[-1]), jnp.float32)
    _, o = lax.scan(step, init, xs)
    return from_chunks(o)


def retention_chunkwise(q, k, v, log_gamma):
    bsz, t, nh, d = q.shape
    L = RET_CHUNK
    idx = jnp.arange(L, dtype=jnp.float32)
    causal = idx[:, None] >= idx[None, :]
    rel = jnp.where(causal, idx[:, None] - idx[None, :], 0.0)
    intra_decay = jnp.where(causal, jnp.exp(log_gamma[:, None, None] * rel), 0.0)
    inter_decay = jnp.exp(log_gamma[:, None] * (idx + 1.0))[:, :, None]
    state_decay = jnp.exp(log_gamma[:, None] * (L - 1.0 - idx))[:, :, None]
    chunk_decay = jnp.exp(log_gamma * L)[:, None, None]
    xs = (to_chunks(q, L), to_chunks(k, L), to_chunks(v, L))

    def step(s_st, inp):
        qc, kc, vc = inp
        s = jnp.einsum('bhid,bhjd->bhij', qc, kc) * intra_decay
        o = jnp.einsum('bhij,bhje->bhie', s, vc) + inter_decay * jnp.einsum('bhid,bhde->bhie', qc, s_st)
        s_st = chunk_decay * s_st + jnp.einsum('bhjd,bhje->bhde', kc * state_decay, vc)
        return s_st, o

    init = jnp.zeros((bsz, nh, d, v.shape[-1]), jnp.float32)
    _, o = lax.scan(step, init, xs)
    return from_chunks(o)


def rwkv7_recurrence(r, w, k, v, a, b):
    bsz, t, nh, n = r.shape

    def step(s_st, inp):
        rt, wt, kt, vt, at, bt = inp
        sa = jnp.einsum('bhij,bhj->bhi', s_st, at)
        s_st = s_st * wt[:, :, None, :] + sa[..., None] * bt[:, :, None, :] + vt[..., None] * kt[:, :, None, :]
        return s_st, jnp.einsum('bhij,bhj->bhi', s_st, rt)

    xs = tuple(jnp.moveaxis(z, 1, 0) for z in (r, w, k, v, a, b))
    _, y = lax.scan(step, jnp.zeros((bsz, nh, n, n), jnp.float32), xs)
    return jnp.moveaxis(y, 0, 1)


def swiglu(h, w_gate, w_up, w_down):
    return (jax.nn.silu(h @ w_gate) * (h @ w_up)) @ w_down


def moe_swiglu(h, router, w_gate, w_up, w_down):
    logits = (h @ router).astype(jnp.float32)
    top_val, top_idx = lax.top_k(logits, TOP_K)
    top_w = jax.nn.softmax(top_val, axis=-1)
    gate = jnp.sum(jax.nn.one_hot(top_idx, N_EXPERTS, dtype=jnp.float32) * top_w[..., None], axis=-2)
    out = jnp.zeros(h.shape, jnp.float32)
    for e in range(N_EXPERTS):
        out = out + gate[..., e:e + 1] * swiglu(h, w_gate[e], w_up[e], w_down[e]).astype(jnp.float32)
    return out.astype(h.dtype)


def even_mixer(h, w_in, ml_conv_w, ml_conv_b, ml_gate_b, ml_norm_g, gla_gate_up, gla_gate_b, gla_norm_g, w_out):
    bsz, t, _ = h.shape
    p = h @ w_in
    ml_qk, ml_v, ml_o, ml_if, g_q, g_k, g_v, g_r, g_low = split_cols(p, E_SPLITS)
    ml_qk = jax.nn.silu(causal_depthwise_conv(ml_qk, ml_conv_w, ml_conv_b))
    q_ml, k_ml = jnp.split(ml_qk, 2, axis=-1)
    gates = (ml_if + ml_gate_b).astype(jnp.float32)
    h_ml = mlstm_chunkwise(heads(q_ml, ML_HEADS), heads(k_ml, ML_HEADS), heads(ml_v, ML_HEADS),
                           gates[..., :ML_HEADS], gates[..., ML_HEADS:])
    h_ml = jax.nn.sigmoid(heads(ml_o, ML_HEADS)) * h_ml
    h_ml = head_layer_norm(h_ml, EPS).reshape(bsz, t, ML_W) * ml_norm_g
    log_a = jax.nn.log_sigmoid((g_low @ gla_gate_up + gla_gate_b).astype(jnp.float32)) / GLA_TAU
    o_gla = gla_chunkwise(heads(g_q, GLA_HEADS) * GLA_DK ** -0.5, heads(g_k, GLA_HEADS), heads(g_v, GLA_HEADS),
                          log_a.reshape(bsz, t, GLA_HEADS, GLA_DK))
    o_gla = head_rms_norm(o_gla, EPS).reshape(bsz, t, GLA_V_W) * gla_norm_g * jax.nn.silu(g_r.astype(jnp.float32))
    mixed = jnp.concatenate([h_ml, o_gla], axis=-1).astype(h.dtype)
    return mixed @ w_out


def odd_mixer(h, w_in, ret_norm_g, rw_mu, rw_w_up, rw_w0, rw_a_up, rw_a0, rw_g_up, rw_k_k, rw_k_a, rw_r_k,
              rw_ln_g, rw_ln_b, w_out):
    bsz, t, _ = h.shape
    p = h @ w_in
    p_ret, p_rw = p[..., :RET_COLS], p[..., RET_COLS:]
    r_q, r_k, r_v, r_g = split_cols(p_ret, RET_SPLITS)
    positions = jnp.arange(t)
    log_gamma = jnp.log1p(-jnp.exp2(-5.0 - jnp.arange(RET_HEADS, dtype=jnp.float32)))
    q_ret = apply_rotary(heads(r_q, RET_HEADS), positions) * RET_DIM ** -0.5
    k_ret = apply_rotary(heads(r_k, RET_HEADS), positions)
    y_ret = retention_chunkwise(q_ret, k_ret, heads(r_v, RET_HEADS), log_gamma)
    y_ret = head_layer_norm(y_ret, EPS).reshape(bsz, t, RET_W) * ret_norm_g * jax.nn.silu(r_g.astype(jnp.float32))
    p_rw = (p_rw + (token_shift(p_rw) - p_rw) * rw_mu).astype(jnp.float32)
    x_r, x_k, x_v, x_dl, x_al, x_gl = split_cols(p_rw, RW_SPLITS)
    w_log = -jax.nn.softplus(-(rw_w0 + jnp.tanh(x_dl) @ rw_w_up)) - 0.5
    decay = jnp.exp(-jnp.exp(w_log))
    a = jax.nn.sigmoid(rw_a0 + x_al @ rw_a_up)
    g_out = jax.nn.sigmoid(x_gl) @ rw_g_up
    kk = heads(x_k * rw_k_k, RW_HEADS)
    kk = kk / jnp.maximum(jnp.linalg.norm(kk, axis=-1, keepdims=True), 1e-12)
    k_h = heads(x_k * (1.0 + (a - 1.0) * rw_k_a), RW_HEADS)
    r_h, v_h, a_h = heads(x_r, RW_HEADS), heads(x_v, RW_HEADS), heads(a, RW_HEADS)
    y_rw = rwkv7_recurrence(r_h, heads(decay, RW_HEADS), k_h, v_h, -kk, kk * a_h)
    y_rw = head_layer_norm(y_rw, RW_LN_EPS).reshape(bsz, t, RW_W) * rw_ln_g + rw_ln_b
    bonus = jnp.sum(r_h * k_h * rw_r_k, axis=-1, keepdims=True) * v_h
    y_rw = (y_rw + bonus.reshape(bsz, t, RW_W)) * g_out
    mixed = jnp.concatenate([y_ret, y_rw], axis=-1).astype(h.dtype)
    return mixed @ w_out


def setup_inputs(seed: int = 0) -> dict:
    key = jax.random.key(seed)
    ks = iter(jax.random.split(key, 64))
    f32 = jnp.float32
    ne, no = (DEPTH + 1) // 2, DEPTH // 2

    def normal(shape, scale):
        return jax.random.normal(next(ks), shape, f32) * scale

    def gain(n, dim):
        return 1.0 + normal((n, dim), 0.02)

    d = D_MODEL
    inp = {}
    inp['x'] = normal((BATCH, SEQ, d), 1.0)
    inp['e_norm1_g'] = gain(ne, d)
    inp['e_w_in'] = normal((ne, d, E_COLS), d ** -0.5)
    inp['e_ml_conv_w'] = normal((ne, ML_CONV, 2 * ML_W), 0.5)
    inp['e_ml_conv_b'] = normal((ne, 2 * ML_W), 0.02)
    inp['e_ml_gate_b'] = jnp.concatenate(
        [normal((ne, ML_HEADS), 0.1),
         jnp.linspace(3.0, 6.0, ML_HEADS, dtype=f32)[None, :] + normal((ne, ML_HEADS), 0.1)], axis=-1)
    inp['e_ml_norm_g'] = gain(ne, ML_W)
    inp['e_gla_gate_up'] = normal((ne, GLA_RANK, GLA_K_W), GLA_RANK ** -0.5)
    inp['e_gla_gate_b'] = normal((ne, GLA_K_W), 0.1)
    inp['e_gla_norm_g'] = gain(ne, GLA_V_W)
    inp['e_w_out'] = normal((ne, E_MIX_W, d), E_MIX_W ** -0.5)
    inp['e_norm2_g'] = gain(ne, d)
    inp['e_ffn_w_gate'] = normal((ne, d, D_FF), d ** -0.5)
    inp['e_ffn_w_up'] = normal((ne, d, D_FF), d ** -0.5)
    inp['e_ffn_w_down'] = normal((ne, D_FF, d), D_FF ** -0.5)
    inp['o_norm1_g'] = gain(no, d)
    inp['o_w_in'] = normal((no, d, O_COLS), d ** -0.5)
    inp['o_ret_norm_g'] = gain(no, RET_W)
    inp['o_rw_mu'] = jax.random.uniform(next(ks), (no, RW_COLS), f32)
    inp['o_rw_w_up'] = normal((no, RW_DECAY_RANK, RW_W), 0.1 * RW_DECAY_RANK ** -0.5)
    w0_ramp = jnp.broadcast_to(jnp.linspace(-6.0, -1.0, RW_DIM, dtype=f32), (RW_HEADS, RW_DIM)).reshape(-1)
    inp['o_rw_w0'] = w0_ramp[None, :] + normal((no, RW_W), 0.1)
    inp['o_rw_a_up'] = normal((no, RW_A_RANK, RW_W), 0.5 * RW_A_RANK ** -0.5)
    inp['o_rw_a0'] = normal((no, RW_W), 0.1)
    inp['o_rw_g_up'] = normal((no, RW_GATE_RANK, RW_W), RW_GATE_RANK ** -0.5)
    inp['o_rw_k_k'] = 0.85 + normal((no, RW_W), 0.02)
    inp['o_rw_k_a'] = 1.0 + normal((no, RW_W), 0.02)
    inp['o_rw_r_k'] = normal((no, RW_HEADS, RW_DIM), 0.1)
    inp['o_rw_ln_g'] = gain(no, RW_W)
    inp['o_rw_ln_b'] = normal((no, RW_W), 0.02)
    inp['o_w_out'] = normal((no, O_MIX_W, d), O_MIX_W ** -0.5)
    inp['o_norm2_g'] = gain(no, d)
    inp['o_moe_router'] = normal((no, d, N_EXPERTS), d ** -0.5)
    inp['o_moe_w_gate'] = normal((no, N_EXPERTS, d, D_FF), d ** -0.5)
    inp['o_moe_w_up'] = normal((no, N_EXPERTS, d, D_FF), d ** -0.5)
    inp['o_moe_w_down'] = normal((no, N_EXPERTS, D_FF, d), D_FF ** -0.5)
    inp['final_norm_g'] = 1.0 + normal((d,), 0.02)
    return inp


def reference(x, e_norm1_g, e_w_in, e_ml_conv_w, e_ml_conv_b, e_ml_gate_b, e_ml_norm_g, e_gla_gate_up,
              e_gla_gate_b, e_gla_norm_g, e_w_out, e_norm2_g, e_ffn_w_gate, e_ffn_w_up, e_ffn_w_down,
              o_norm1_g, o_w_in, o_ret_norm_g, o_rw_mu, o_rw_w_up, o_rw_w0, o_rw_a_up, o_rw_a0, o_rw_g_up,
              o_rw_k_k, o_rw_k_a, o_rw_r_k, o_rw_ln_g, o_rw_ln_b, o_w_out, o_norm2_g, o_moe_router,
              o_moe_w_gate, o_moe_w_up, o_moe_w_down, final_norm_g):
    h = x
    for layer in range(DEPTH):
        j = layer // 2
        if layer % 2 == 0:
            h = h + even_mixer(rms_norm(h, e_norm1_g[j]), e_w_in[j], e_ml_conv_w[j], e_ml_conv_b[j],
                               e_ml_gate_b[j], e_ml_norm_g[j], e_gla_gate_up[j], e_gla_gate_b[j],
                               e_gla_norm_g[j], e_w_out[j])
            h = h + swiglu(rms_norm(h, e_norm2_g[j]), e_ffn_w_gate[j], e_ffn_w_up[j], e_ffn_w_down[j])
        else:
            h = h + odd_mixer(rms_norm(h, o_norm1_g[j]), o_w_in[j], o_ret_norm_g[j], o_rw_mu[j], o_rw_w_up[j],
                              o_rw_w0[j], o_rw_a_up[j], o_rw_a0[j], o_rw_g_up[j], o_rw_k_k[j], o_rw_k_a[j],
                              o_rw_r_k[j], o_rw_ln_g[j], o_rw_ln_b[j], o_w_out[j])
            h = h + moe_swiglu(rms_norm(h, o_norm2_g[j]), o_moe_router[j], o_moe_w_gate[j], o_moe_w_up[j],
                               o_moe_w_down[j])
    return rms_norm(h, final_norm_g)
```

```cpp
#include <hip/hip_runtime.h>
#include <cstdio>
#include <cstdint>
#define PG8_MMA_PRIO 0
namespace pg8 {
#define PG8_LAS __attribute__((address_space(3)))
typedef unsigned short bf16_t;
typedef short bf16x8 __attribute__((ext_vector_type(8)));
typedef float f32x4 __attribute__((ext_vector_type(4)));
typedef unsigned u32x4 __attribute__((ext_vector_type(4)));
constexpr int BM = 256, BK = 64, HALF = 128, HTB = HALF * BK * 2  , STAGE_BYTES = 8 * HTB, NXCD = 8;

__host__ __device__ __forceinline__ int lds_byte(int r, int c) { const int st = (r >> 4) * 2 + (c >> 5), rr = r & 15, cc = c & 31, ob = rr * 64 + cc * 2; return st * 1024 + (ob ^ (((ob >> 9) & 1) << 5)); }
__host__ __device__ __forceinline__ void stage_rc(int b, int& R, int& C) { const int st = b / 1024, sb = b % 1024, swz = sb ^ (((sb >> 9) & 1) << 5); R = (st >> 1) * 16 + swz / 64; C = (st & 1) * 32 + (swz % 64) / 2; }
__host__ __device__ __forceinline__ int perm32(int rho) { const int n = rho >> 4, i = rho & 15; return 8 * (i >> 2) + 4 * n + (i & 3); }

struct Unit { int pm, pn, bn, po, hm, hn; };
__host__ __device__ __forceinline__ bool tail_split(int i, int G, int c, int nwg, int smax, int& L, int& hm, int& hn) {
    const int F = nwg / G, R = nwg - F * G; hm = 0; hn = 0;
    if (i < F) { L = i * G + c; return true; }
    if (i > F || R == 0) return false;
    const int sh = (smax >= 4 && 4 * R <= G) ? 2 : ((smax >= 2 && 2 * R <= G) ? 1 : 0);
    if (c >= (R << sh)) return false;
    const int pc = c & ((1 << sh) - 1); L = F * G + (c >> sh);
    if (sh >= 1) hm = 1 + (pc & 1); if (sh == 2) hn = 1 + (pc >> 1);
    return true;
}
struct Gemm { const bf16_t* A; const bf16_t* Bt; int M, N, K; };

struct StaticOrder {
    int nM, nN, nwg, G, c, WGM, smax;
    __host__ __device__ void init(int M, int N, int G_, int c_, int wgm, int smax_) { nM = M / BM; nN = N / BM; nwg = nM * nN; G = G_; c = c_; WGM = wgm; smax = smax_; }
    __host__ __device__ bool next(int i, Unit& u) const {
        int L; if (!tail_split(i, G, c, nwg, smax, L, u.hm, u.hn)) return false;
        int wgid = L; { const int q = nwg / NXCD, r = nwg % NXCD, xcd = wgid % NXCD, off = wgid / NXCD; wgid = (xcd < r ? xcd * (q + 1) : r * (q + 1) + (xcd - r) * q) + off; }
        const int nig = WGM * nN, gid = wgid / nig, fm = gid * WGM, gsz = (nM - fm) < WGM ? (nM - fm) : WGM;
        u.pm = fm + ((wgid % nig) % gsz); u.pn = (wgid % nig) / gsz; u.bn = u.pn; u.po = u.pm; return true;
    }
    __device__ __forceinline__ void a_ready(const Unit&) const {}
    __device__ __forceinline__ void done(const Unit&) const {}
};

__device__ __forceinline__ unsigned cvt_pk_bf16(float lo, float hi) { unsigned r; asm volatile("v_cvt_pk_bf16_f32 %0, %1, %2" : "=v"(r) : "v"(lo), "v"(hi)); return r; }
typedef float f32x2 __attribute__((ext_vector_type(2)));
typedef int i32x4 __attribute__((ext_vector_type(4)));
typedef int i32x8 __attribute__((ext_vector_type(8)));
__device__ __forceinline__ unsigned pk4f8(float a, float b, float c, float d) {
    a = __builtin_amdgcn_fmed3f(a, -448.f, 448.f); b = __builtin_amdgcn_fmed3f(b, -448.f, 448.f); c = __builtin_amdgcn_fmed3f(c, -448.f, 448.f); d = __builtin_amdgcn_fmed3f(d, -448.f, 448.f);
    int w = __builtin_amdgcn_cvt_pk_fp8_f32(a, b, 0, false); w = __builtin_amdgcn_cvt_pk_fp8_f32(c, d, w, true); return (unsigned)w; }
__device__ __forceinline__ i32x8 cat8(bf16x8 a, bf16x8 b) { const i32x4 x = __builtin_bit_cast(i32x4, a), y = __builtin_bit_cast(i32x4, b); return __builtin_shufflevector(x, y, 0, 1, 2, 3, 4, 5, 6, 7); }
constexpr float RMS_EPS = 1e-6f;
__device__ __forceinline__ float rs_from_ssp(const float* ssp, int row) {
    const f32x4* p = (const f32x4*)(ssp + (size_t)row * 16);
    const f32x4 a = p[0], b = p[1], c = p[2], d = p[3];
    const float s = ((a[0] + a[1]) + (a[2] + a[3])) + ((b[0] + b[1]) + (b[2] + b[3])) + ((c[0] + c[1]) + (c[2] + c[3])) + ((d[0] + d[1]) + (d[2] + d[3]));
    return __builtin_amdgcn_rsqf(s * (1.0f / 1024.0f) + RMS_EPS);
}
__device__ __forceinline__ void rs8_from_ssp(const float* ssp, int row0, int fq, float (&rs)[8]) {
    f32x4 p[8];
#pragma unroll
    for (int i = 0; i < 8; ++i) p[i] = *(const f32x4*)(ssp + (size_t)(row0 + (i >> 2) * HALF + (i & 3) * 16) * 16 + 4 * fq);
#pragma unroll
    for (int i = 0; i < 8; ++i) { float t = (p[i][0] + p[i][1]) + (p[i][2] + p[i][3]); t += __shfl_xor(t, 16); t += __shfl_xor(t, 32); rs[i] = __builtin_amdgcn_rsqf(t * (1.0f / 1024.0f) + RMS_EPS); }
}
struct RsAhead { f32x4 a, b; float s; };
template <bool DIRECT> __device__ __forceinline__ void rs_issue(const float* src, int rowbase, int tid, RsAhead& r) {
    if constexpr (DIRECT) { const float* p = src + rowbase + (tid & 255); asm volatile("global_load_dword %0, %1, off" : "=v"(r.s) : "v"(p) : "memory"); }
    else { const float* p = src + (size_t)(rowbase + (tid >> 1)) * 16 + 8 * (tid & 1);
        asm volatile("global_load_dwordx4 %0, %2, off\n\tglobal_load_dwordx4 %1, %2, off offset:16" : "=&v"(r.a), "=&v"(r.b) : "v"(p) : "memory"); }
}
template <bool DIRECT, int NST> __device__ __forceinline__ void rs_commit(PG8_LAS float* dst, int tid, RsAhead& r) {
    if constexpr (DIRECT) { asm volatile("s_waitcnt vmcnt(%1)" : "+v"(r.s) : "n"(NST) : "memory"); dst[tid & 255] = r.s; }
    else { asm volatile("s_waitcnt vmcnt(%2)" : "+v"(r.a), "+v"(r.b) : "n"(NST) : "memory");
        float t = ((r.a[0] + r.a[1]) + (r.a[2] + r.a[3])) + ((r.b[0] + r.b[1]) + (r.b[2] + r.b[3])); t += __shfl_xor(t, 1);
        dst[tid >> 1] = __builtin_amdgcn_rsqf(t * (1.0f / 1024.0f) + RMS_EPS); }
}
__device__ __forceinline__ float fast_sigmoid(float x) { return __builtin_amdgcn_rcpf(1.0f + __builtin_amdgcn_exp2f(-1.4426950408889634f * x)); }
__device__ __forceinline__ float fast_silu(float x) { return x * fast_sigmoid(x); }

__device__ __forceinline__ f32x2 swiglu2(f32x2 G, f32x2 U, float c1, float ik2) {
    f32x2 e = G * c1; e[0] = __builtin_amdgcn_exp2f(e[0]); e[1] = __builtin_amdgcn_exp2f(e[1]);
    f32x2 d = e * ik2 + ik2; d[0] = __builtin_amdgcn_rcpf(d[0]); d[1] = __builtin_amdgcn_rcpf(d[1]);
    return (G * U) * d;
}
struct EpiProj {
    static constexpr bool PERM = true, AFTER_DRAIN = false, RSLDS = true; static constexpr int NSTORES = 16;
    bf16_t* O0; int ld0; bf16_t* O1; int ld1; int split; const float* ssp;
    __device__ __forceinline__ void rs_first(const Unit& u, PG8_LAS float* dst, int tid) const { RsAhead r; rs_issue<false>(ssp, u.po * BM, tid, r); rs_commit<false, 0>(dst, tid, r); }
    __device__ __forceinline__ void operator()(const f32x4 (&acc)[2][2][4][2], const Unit& u, int wr, int wc, int fr, int fq, const PG8_LAS float* rs_cur, PG8_LAS float* rs_nxt, const Unit& nxt, bool has_next, int tid) const {
        int frl = fr, fql = fq, tidl = tid; asm volatile("" : "+v"(frl), "+v"(fql), "+v"(tidl));
        RsAhead rn; rs_issue<false>(ssp, (has_next ? nxt.po : u.po) * BM, tidl, rn);
        const int row0 = u.po * BM + (u.hm == 2 ? HALF : 0) + wr * 64 + frl;
        bf16_t* base; int ld, ct;
        if (u.pn < split) { base = O0; ld = ld0; ct = u.pn; } else { base = O1; ld = ld1; ct = u.pn - split; }
        const int col0 = ct * BM + (u.hn == 2 ? HALF : 0) + wc * 32 + 8 * fql;
        float rsv[8];
#pragma unroll
        for (int i = 0; i < 8; ++i) rsv[i] = rs_cur[(u.hm == 2 ? HALF : 0) + wr * 64 + frl + (i >> 2) * HALF + (i & 3) * 16 - ((u.hm == 2 && i >= 4) ? HALF : 0)];
#pragma unroll
        for (int ai = 0; ai < 2; ++ai)
#pragma unroll
            for (int m = 0; m < 4; ++m) { if (ai && u.hm) continue; const int row = row0 + ai * HALF + m * 16; const float rs = rsv[ai * 4 + m]; bf16_t* rowp = base + (size_t)row * ld + col0;
#pragma unroll
                for (int bj = 0; bj < 2; ++bj) { if (bj && u.hn) continue; const f32x4 v0 = acc[ai][bj][m][0] * rs, v1 = acc[ai][bj][m][1] * rs;
                    u32x4 w; w.x = cvt_pk_bf16(v0[0], v0[1]); w.y = cvt_pk_bf16(v0[2], v0[3]); w.z = cvt_pk_bf16(v1[0], v1[1]); w.w = cvt_pk_bf16(v1[2], v1[3]);
                    *(u32x4*)(rowp + bj * HALF) = w; } }
        rs_commit<false, NSTORES>(rs_nxt, tidl, rn);
    }
};
template <bool HB8> struct EpiResidT {
    static constexpr bool PERM = false, AFTER_DRAIN = false, RSLDS = false; static constexpr int NSTORES = -1;
    const float* res; float* Hout; bf16_t* hb; float* ssp; float sc;
    __device__ __forceinline__ void operator()(const f32x4 (&acc)[2][2][4][2], const Unit& u, int wr, int wc, int fr, int fq) const {
        typedef unsigned u32x2v __attribute__((ext_vector_type(2)));
        const int row0 = u.po * BM + wr * 64 + fr, col0 = u.pn * BM + wc * 32 + 4 * fq;
        f32x4 h[2][4][2][2];
#pragma unroll
        for (int q = 0; q < 4; ++q) { const int ai = q >> 1; f32x4 r[2][2][2];
#pragma unroll
            for (int mm = 0; mm < 2; ++mm)
#pragma unroll
                for (int bj = 0; bj < 2; ++bj)
#pragma unroll
                    for (int n = 0; n < 2; ++n) r[mm][bj][n] = *(const f32x4*)(res + (size_t)(row0 + ai * HALF + ((q & 1) * 2 + mm) * 16) * 1024 + col0 + bj * HALF + n * 16);
#pragma unroll
            for (int mm = 0; mm < 2; ++mm)
#pragma unroll
                for (int bj = 0; bj < 2; ++bj)
#pragma unroll
                    for (int n = 0; n < 2; ++n) { f32x4 t = r[mm][bj][n] + acc[ai][bj][(q & 1) * 2 + mm][n] * sc; asm volatile("" : "+v"(t)); h[ai][(q & 1) * 2 + mm][bj][n] = t; }
            __builtin_amdgcn_sched_barrier(0); }
#pragma unroll
        for (int ai = 0; ai < 2; ++ai)
#pragma unroll
            for (int m = 0; m < 4; ++m) { const int row = row0 + ai * HALF + m * 16; const size_t off = (size_t)row * 1024 + col0; float ss = 0.f;
#pragma unroll
                for (int bj = 0; bj < 2; ++bj)
#pragma unroll
                    for (int n = 0; n < 2; ++n) { const size_t o = off + bj * HALF + n * 16; const f32x4 hv = h[ai][m][bj][n];
                        *(f32x4*)(Hout + o) = hv;
                        if constexpr (HB8) *(unsigned*)((unsigned char*)hb + o) = pk4f8(hv[0], hv[1], hv[2], hv[3]);
                        else { u32x2v w; w.x = cvt_pk_bf16(hv[0], hv[1]); w.y = cvt_pk_bf16(hv[2], hv[3]); *(u32x2v*)(hb + o) = w; }
                        ss += (hv[0] * hv[0] + hv[1] * hv[1]) + (hv[2] * hv[2] + hv[3] * hv[3]); }
                ss += __shfl_xor(ss, 16); ss += __shfl_xor(ss, 32);
                if (fq == 0) ssp[(size_t)row * 16 + u.pn * 4 + wc] = ss; }
    }
};
typedef EpiResidT<false> EpiResid;
template <bool MOE> struct EpiSwiGLU {
    static constexpr bool PERM = true, AFTER_DRAIN = false, RSLDS = false; static constexpr int NSTORES = 8;
    bf16_t* O; int ld; const float* rsrc;
    __device__ __forceinline__ void operator()(const f32x4 (&acc)[2][2][4][2], const Unit& u, int wr, int wc, int fr, int fq) const {
        int frl = fr, fql = fq; asm volatile("" : "+v"(frl), "+v"(fql));
        const int rloc = wr * 64 + frl, col0 = u.pn * HALF + wc * 32 + 8 * fql;
        float rsv[8];
        if constexpr (MOE) {
#pragma unroll
            for (int i = 0; i < 8; ++i) rsv[i] = rsrc[u.pm * BM + rloc + (i >> 2) * HALF + (i & 3) * 16]; }
        else rs8_from_ssp(rsrc, u.pm * BM + rloc, fql, rsv);
#pragma unroll
        for (int ai = 0; ai < 2; ++ai)
#pragma unroll
            for (int m = 0; m < 4; ++m) { const int r = rloc + ai * HALF + m * 16;
                const float rs = rsv[ai * 4 + m], c1 = -1.4426950408889634f * rs, ik2 = __builtin_amdgcn_rcpf(rs * rs);
                f32x2 o[4];
#pragma unroll
                for (int n = 0; n < 2; ++n)
#pragma unroll
                    for (int hh = 0; hh < 2; ++hh) { const f32x4 g4 = acc[ai][0][m][n], u4 = acc[ai][1][m][n]; const f32x2 G = {g4[2 * hh], g4[2 * hh + 1]}, U = {u4[2 * hh], u4[2 * hh + 1]}; o[n * 2 + hh] = swiglu2(G, U, c1, ik2); }
                u32x4 w; w.x = cvt_pk_bf16(o[0][0], o[0][1]); w.y = cvt_pk_bf16(o[1][0], o[1][1]); w.z = cvt_pk_bf16(o[2][0], o[2][1]); w.w = cvt_pk_bf16(o[3][0], o[3][1]);
                *(u32x4*)(O + (size_t)(u.po * BM + r) * ld + col0) = w; }
    }
};
template <bool MOE, bool OUT8 = true> struct EpiSwiGLU8T {
    static constexpr bool PERM = true, AFTER_DRAIN = false, RSLDS = true; static constexpr int NSTORES = 8;
    unsigned char* O; int ld; const float* rsrc; float wsc;
    __device__ __forceinline__ void rs_first(const Unit& u, PG8_LAS float* dst, int tid) const { RsAhead r; rs_issue<MOE>(rsrc, u.pm * BM, tid, r); rs_commit<MOE, 0>(dst, tid, r); }
    __device__ __forceinline__ void operator()(const f32x4 (&acc)[2][2][4][2], const Unit& u, int wr, int wc, int fr, int fq, const PG8_LAS float* rs_cur, PG8_LAS float* rs_nxt, const Unit& nxt, bool has_next, int tid) const {
        typedef unsigned u32x2v __attribute__((ext_vector_type(2)));
        int tidl = tid; asm volatile("" : "+v"(tidl));
        RsAhead rn; rs_issue<MOE>(rsrc, (has_next ? nxt.pm : u.pm) * BM, tidl, rn);
        int frl = fr, fql = fq; asm volatile("" : "+v"(frl), "+v"(fql));
        const int rloc = (u.hm == 2 ? HALF : 0) + wr * 64 + frl, col0 = u.pn * HALF + wc * 32 + 8 * fql;
        float rsv[8];
#pragma unroll
        for (int i = 0; i < 8; ++i) rsv[i] = rs_cur[rloc + (i & 3) * 16 + ((i >= 4 && !u.hm) ? HALF : 0)];
#pragma unroll
        for (int ai = 0; ai < 2; ++ai)
#pragma unroll
            for (int m = 0; m < 4; ++m) { if (ai && u.hm) continue; const int r = rloc + ai * HALF + m * 16;
                const float rs = rsv[ai * 4 + m] * wsc, c1 = -1.4426950408889634f * rs, ik2 = __builtin_amdgcn_rcpf(rs * rs * (OUT8 ? 16.0f : 1.0f));
                f32x2 o[4];
#pragma unroll
                for (int n = 0; n < 2; ++n)
#pragma unroll
                    for (int hh = 0; hh < 2; ++hh) { const f32x4 g4 = acc[ai][0][m][n], u4 = acc[ai][1][m][n]; const f32x2 G = {g4[2 * hh], g4[2 * hh + 1]}, U = {u4[2 * hh], u4[2 * hh + 1]}; o[n * 2 + hh] = swiglu2(G, U, c1, ik2); }
                if constexpr (OUT8) { u32x2v w; w.x = pk4f8(o[0][0], o[0][1], o[1][0], o[1][1]); w.y = pk4f8(o[2][0], o[2][1], o[3][0], o[3][1]);
                    *(u32x2v*)(O + (size_t)(u.po * BM + r) * ld + col0) = w; }
                else { u32x4 w; w.x = cvt_pk_bf16(o[0][0], o[0][1]); w.y = cvt_pk_bf16(o[1][0], o[1][1]); w.z = cvt_pk_bf16(o[2][0], o[2][1]); w.w = cvt_pk_bf16(o[3][0], o[3][1]);
                    *(u32x4*)((bf16_t*)O + (size_t)(u.po * BM + r) * ld + col0) = w; } }
        rs_commit<MOE, NSTORES>(rs_nxt, tidl, rn);
    }
};
typedef EpiSwiGLU8T<true> EpiSwiGLU8;
struct EpiStore {
    static constexpr bool PERM = true, AFTER_DRAIN = false, RSLDS = false; static constexpr int NSTORES = 16;
    bf16_t* O; int ld; float sc;
    __device__ __forceinline__ void operator()(const f32x4 (&acc)[2][2][4][2], const Unit& u, int wr, int wc, int fr, int fq) const {
        int frl = fr, fql = fq; asm volatile("" : "+v"(frl), "+v"(fql));
        const int row0 = u.po * BM + (u.hm == 2 ? HALF : 0) + wr * 64 + frl, col0 = u.pn * BM + (u.hn == 2 ? HALF : 0) + wc * 32 + 8 * fql;
#pragma unroll
        for (int ai = 0; ai < 2; ++ai)
#pragma unroll
            for (int m = 0; m < 4; ++m) { if (ai && u.hm) continue; bf16_t* rowp = O + (size_t)(row0 + ai * HALF + m * 16) * ld + col0;
#pragma unroll
                for (int bj = 0; bj < 2; ++bj) { if (bj && u.hn) continue; const f32x4 v0 = acc[ai][bj][m][0] * sc, v1 = acc[ai][bj][m][1] * sc;
                    u32x4 w; w.x = cvt_pk_bf16(v0[0], v0[1]); w.y = cvt_pk_bf16(v0[2], v0[3]); w.z = cvt_pk_bf16(v1[0], v1[1]); w.w = cvt_pk_bf16(v1[2], v1[3]);
                    *(u32x4*)(rowp + bj * HALF) = w; } }
    }
};
struct MoeOrder {
    int t_lo, nT, nN, nBper, G, c; const PG8_LAS int* tile_expert; bool a_local, o_local; int WGM, smax;
    __device__ bool next(int i, Unit& u) const {
        const int nwg = nT * nN; int L; if (!tail_split(i, G, c, nwg, smax, L, u.hm, u.hn)) return false;
        { const int q = nwg / NXCD, r = nwg % NXCD, xcd = L % NXCD, off = L / NXCD; L = (xcd < r ? xcd * (q + 1) : r * (q + 1) + (xcd - r) * q) + off; }
        const int nig = WGM * nN, gid = L / nig, fm = gid * WGM, gsz = (nT - fm) < WGM ? (nT - fm) : WGM, rem = L % nig;
        const int pmi = fm + rem % gsz, pn = rem / gsz, t = t_lo + pmi, e = tile_expert[t];
        u.pn = pn; u.bn = e * nBper + pn; u.pm = a_local ? pmi : t; u.po = o_local ? pmi : t; return true;
    }
    __device__ __forceinline__ void a_ready(const Unit&) const {}
    __device__ __forceinline__ void done(const Unit&) const {}
};
template <class Epi, class Sched, bool ALIGN_EPI = false, bool SP2 = false, bool FP8 = false>
__device__ __forceinline__ void gemm_phase(PG8_LAS unsigned char* lds, const Gemm g, const Sched& S, const Epi& E, const int tid  ) {
    const int wid = __builtin_amdgcn_readfirstlane(tid >> 6), lane = tid & 63, wr = wid >> 2, wc = wid & 3, fr = lane & 15, fq = lane >> 4;
    const int K = g.K, nt = K / BK;
    unsigned voffA[2], voffB[2];
#pragma unroll
    for (int i = 0; i < 2; ++i) { int R, C; stage_rc(tid * 16 + i * 8192, R, C); const int Rb = Epi::PERM ? ((R & ~31) + perm32(R & 31)) : R;
        voffA[i] = (unsigned)(R * K + C) * 2u; voffB[i] = (unsigned)(Rb * K + C) * 2u; }
    const size_t kstep = (size_t)(BK * 2);
    const size_t hstep = (size_t)HALF * K * 2;
    const size_t tstep = 2 * hstep;
    const unsigned ldsw = (unsigned)wid * 1024u;
    const int aoff = lds_byte(wr * 64 + fr, fq * 8), boff = lds_byte(wc * 32 + fr, fq * 8);
#ifndef PG8_MMA_PRIO
#define PG8_MMA_PRIO 1
#endif
#define PG8_SA(b, h) (((b) * 2 + (h)) * HTB)
#define PG8_SB(b, h) ((4 + (b) * 2 + (h)) * HTB)
#define PG8_STAGE(bufoff, gbase, voff) do { const char* gb_ = (const char*)(gbase); asm volatile("" : "+s"(gb_));   \
        _Pragma("unroll") for (int _i = 0; _i < 2; ++_i) { unsigned vo_ = (voff)[_i]; asm volatile("" : "+v"(vo_)); \
        __builtin_amdgcn_global_load_lds((const unsigned*)(gb_ + vo_), (PG8_LAS unsigned*)(lds + (bufoff) + ldsw + _i * 8192), 16, 0, 0); } } while (0)
#define PG8_LDA(dst, b, h) do { _Pragma("unroll") for (int m = 0; m < 4; ++m) _Pragma("unroll") for (int k = 0; k < 2; ++k) dst[m][k] = *(const PG8_LAS bf16x8*)(lds + PG8_SA(b, h) + aoff + m * 2048 + k * 1024); } while (0)
#define PG8_LDB(dst, b, h) do { _Pragma("unroll") for (int n = 0; n < 2; ++n) _Pragma("unroll") for (int k = 0; k < 2; ++k) dst[n][k] = *(const PG8_LAS bf16x8*)(lds + PG8_SB(b, h) + boff + n * 2048 + k * 1024); } while (0)
#define PG8_MMA(ai, bj, At, Bt) do { __builtin_amdgcn_s_setprio(PG8_MMA_PRIO); _Pragma("unroll") for (int m = 0; m < 4; ++m) _Pragma("unroll") for (int n = 0; n < 2; ++n) { \
        if constexpr (FP8) acc[ai][bj][m][n] = __builtin_amdgcn_mfma_scale_f32_16x16x128_f8f6f4(cat8(Bt[n][0], Bt[n][1]), cat8(At[m][0], At[m][1]), acc[ai][bj][m][n], 0, 0, 0, 0, 0, 0); \
        else { _Pragma("unroll") for (int k = 0; k < 2; ++k) acc[ai][bj][m][n] = __builtin_amdgcn_mfma_f32_16x16x32_bf16(Bt[n][k], At[m][k], acc[ai][bj][m][n], 0, 0, 0); } } __builtin_amdgcn_s_setprio(0); } while (0)
#define PG8_WAIT_V(n) asm volatile("s_waitcnt vmcnt(" #n ")" ::: "memory")
#define PG8_WAIT_L(n) asm volatile("s_waitcnt lgkmcnt(" #n ")" ::: "memory")
#define PG8_WAIT_VP() do { if (peel) asm volatile("s_waitcnt vmcnt(%0)" :: "n"(8 + (Epi::NSTORES > 0 ? Epi::NSTORES : 0)) : "memory"); else PG8_WAIT_V(8); } while (0)
#define PG8_BAR __builtin_amdgcn_s_barrier()
#define PG8_SCHED __builtin_amdgcn_sched_barrier(0)
    constexpr bool PRE = SP2 && Epi::NSTORES > 0 && Epi::NSTORES <= 55;
    bool pre = false;
    Unit cur, nxt; int ui = 0;
    if (!S.next(0, cur)) return;
    PG8_LAS float* rsb = (PG8_LAS float*)(lds + STAGE_BYTES + 12288);
    if constexpr (Epi::RSLDS) E.rs_first(cur, rsb, tid);
    f32x4 acc[2][2][4][2];
#pragma unroll
    for (int a = 0; a < 2; ++a)
#pragma unroll
        for (int b = 0; b < 2; ++b)
#pragma unroll
            for (int m = 0; m < 4; ++m)
#pragma unroll
                for (int n = 0; n < 2; ++n) acc[a][b][m][n] = (f32x4){0.f, 0.f, 0.f, 0.f};
    bf16x8 At[4][2], B0[2][2], B1[2][2];
    const char* cA = (const char*)g.A + (size_t)cur.pm * tstep + (cur.hm == 2 ? hstep : 0); const char* cB = (const char*)g.Bt + (size_t)cur.bn * tstep + (cur.hn == 2 ? hstep : 0);
    S.a_ready(cur);
    if constexpr (SP2) {
        PG8_STAGE(PG8_SB(0, 0), cB, voffB); PG8_STAGE(PG8_SB(0, 1), cB + hstep, voffB); PG8_STAGE(PG8_SA(0, 0), cA, voffA); PG8_STAGE(PG8_SA(0, 1), cA + hstep, voffA);
        if (wr == 1) PG8_BAR;
        PG8_WAIT_V(2); PG8_BAR;
        PG8_STAGE(PG8_SB(1, 0), cB + kstep, voffB); PG8_STAGE(PG8_SA(1, 0), cA + kstep, voffA); PG8_STAGE(PG8_SB(1, 1), cB + hstep + kstep, voffB);
        PG8_WAIT_V(6); PG8_BAR;
    } else {
        PG8_STAGE(PG8_SB(0, 0), cB, voffB); PG8_STAGE(PG8_SA(0, 0), cA, voffA); PG8_STAGE(PG8_SB(0, 1), cB + hstep, voffB); PG8_STAGE(PG8_SA(0, 1), cA + hstep, voffA);
        if (wr == 1) PG8_BAR;
        PG8_WAIT_V(4); PG8_BAR;
        PG8_STAGE(PG8_SB(1, 0), cB + kstep, voffB); PG8_STAGE(PG8_SA(1, 0), cA + kstep, voffA); PG8_STAGE(PG8_SB(1, 1), cB + hstep + kstep, voffB);
        PG8_WAIT_V(6); PG8_BAR;
    }
    for (;;) {
        const bool has_next = S.next(ui + 1, nxt);
        const char* nA = has_next ? (const char*)g.A + (size_t)nxt.pm * tstep + (nxt.hm == 2 ? hstep : 0) : cA; const char* nB = has_next ? (const char*)g.Bt + (size_t)nxt.bn * tstep + (nxt.hn == 2 ? hstep : 0) : cB;
        for (int t = 0; t < nt; t += 2) {
            const bool last = (t == nt - 2);
            const char* a1 = cA + (size_t)(t + 1) * kstep;
            const char* a2 = last ? nA : cA + (size_t)(t + 2) * kstep; const char* b2 = last ? nB : cB + (size_t)(t + 2) * kstep;
            const char* a3 = a2 + kstep; const char* b3 = b2 + kstep;
            if (last && has_next) S.a_ready(nxt);
            if constexpr (SP2) {
            const bool peel = PRE && pre && t == 0;
            PG8_LDB(B0, 0, 0); PG8_LDB(B1, 0, 1); PG8_SCHED; PG8_LDA(At, 0, 0); if (!peel) PG8_STAGE(PG8_SA(1, 1), a1 + hstep, voffA);
            PG8_WAIT_VP(); PG8_WAIT_L(0); PG8_BAR; PG8_MMA(0, 0, At, B0); if (!cur.hn) PG8_MMA(0, 1, At, B1); PG8_BAR; PG8_SCHED;
            PG8_LDA(At, 0, 1); PG8_STAGE(PG8_SB(0, 0), b2, voffB); PG8_STAGE(PG8_SB(0, 1), b2 + hstep, voffB); PG8_STAGE(PG8_SA(0, 0), a2, voffA);
            PG8_WAIT_VP(); PG8_WAIT_L(0); PG8_BAR; if (!cur.hm) { PG8_MMA(1, 0, At, B0); if (!cur.hn) PG8_MMA(1, 1, At, B1); } PG8_BAR; PG8_SCHED;
            PG8_LDB(B0, 1, 0); PG8_LDB(B1, 1, 1); PG8_SCHED; PG8_LDA(At, 1, 0); PG8_STAGE(PG8_SA(0, 1), a2 + hstep, voffA);
            PG8_WAIT_VP(); PG8_WAIT_L(0); PG8_BAR; PG8_MMA(0, 0, At, B0); if (!cur.hn) PG8_MMA(0, 1, At, B1); PG8_BAR; PG8_SCHED;
            PG8_LDA(At, 1, 1); PG8_STAGE(PG8_SB(1, 0), b3, voffB); PG8_STAGE(PG8_SB(1, 1), b3 + hstep, voffB); PG8_STAGE(PG8_SA(1, 0), a3, voffA);
            PG8_WAIT_V(8); PG8_WAIT_L(0); PG8_BAR; if (!cur.hm) { PG8_MMA(1, 0, At, B0); if (!cur.hn) PG8_MMA(1, 1, At, B1); } PG8_BAR; PG8_SCHED;
            } else {
            PG8_LDB(B0, 0, 0); PG8_SCHED; PG8_LDA(At, 0, 0); PG8_STAGE(PG8_SA(1, 1), a1 + hstep, voffA);
            PG8_WAIT_L(8); PG8_BAR; PG8_WAIT_L(0); PG8_MMA(0, 0, At, B0); PG8_BAR; PG8_SCHED;
            PG8_LDB(B1, 0, 1); PG8_STAGE(PG8_SB(0, 0), b2, voffB);
            PG8_BAR; PG8_WAIT_L(0); PG8_MMA(0, 1, At, B1); PG8_BAR;
            PG8_LDA(At, 0, 1); PG8_STAGE(PG8_SA(0, 0), a2, voffA);
            PG8_BAR; PG8_WAIT_L(0); PG8_MMA(1, 0, At, B0); PG8_BAR; PG8_SCHED;
            PG8_STAGE(PG8_SB(0, 1), b2 + hstep, voffB);
            PG8_WAIT_V(6); PG8_BAR; PG8_MMA(1, 1, At, B1); PG8_BAR;
            PG8_LDB(B0, 1, 0); PG8_SCHED; PG8_LDA(At, 1, 0); PG8_STAGE(PG8_SA(0, 1), a2 + hstep, voffA);
            PG8_WAIT_L(8); PG8_BAR; PG8_WAIT_L(0); PG8_MMA(0, 0, At, B0); PG8_BAR; PG8_SCHED;
            PG8_LDB(B1, 1, 1); PG8_STAGE(PG8_SB(1, 0), b3, voffB);
            PG8_BAR; PG8_WAIT_L(0); PG8_MMA(0, 1, At, B1); PG8_BAR;
            PG8_LDA(At, 1, 1); PG8_STAGE(PG8_SA(1, 0), a3, voffA);
            PG8_BAR; PG8_WAIT_L(0); PG8_MMA(1, 0, At, B0); PG8_BAR; PG8_SCHED;
            PG8_STAGE(PG8_SB(1, 1), b3 + hstep, voffB);
            PG8_WAIT_V(6); PG8_BAR; PG8_MMA(1, 1, At, B1); PG8_BAR;
            }
        }
        if constexpr (PRE) { if (has_next) PG8_STAGE(PG8_SA(1, 1), nA + kstep + hstep, voffA); pre = has_next; }
        if constexpr (ALIGN_EPI) { if (wr == 0) PG8_BAR; }
        if constexpr (!Epi::AFTER_DRAIN) {
            if constexpr (Epi::RSLDS) E(acc, cur, wr, wc, fr, fq, rsb + (ui & 1) * 256, rsb + ((ui & 1) ^ 1) * 256, nxt, has_next, tid); else E(acc, cur, wr, wc, fr, fq);
            S.done(cur); }
        if (!has_next) break;
#pragma unroll
        for (int a = 0; a < 2; ++a)
#pragma unroll
            for (int b = 0; b < 2; ++b)
#pragma unroll
                for (int m = 0; m < 4; ++m)
#pragma unroll
                    for (int n = 0; n < 2; ++n) acc[a][b][m][n] = (f32x4){0.f, 0.f, 0.f, 0.f};
        cur = nxt; cA = nA; cB = nB; ++ui;
        if constexpr (ALIGN_EPI) { if (wr == 1) PG8_BAR; }
    }
    PG8_WAIT_V(0);
    if constexpr (!ALIGN_EPI) { if (wr == 0) PG8_BAR; }
    PG8_BAR;
    if constexpr (Epi::AFTER_DRAIN) { E.fused(acc, cur, wr, wc, fr, fq, lds, wid, lane); S.done(cur); }
#undef PG8_SA
#undef PG8_SB
#undef PG8_STAGE
#undef PG8_LDA
#undef PG8_LDB
#undef PG8_MMA
#undef PG8_WAIT_V
#undef PG8_WAIT_L
#undef PG8_WAIT_VP
#undef PG8_BAR
#undef PG8_SCHED
}
}

constexpr int NWAVES = 8, NTHR = 512;
#ifndef FFN8_UP
#define FFN8_UP 2
#endif
constexpr int M = 32768, D = 1024, T = 4096, NBATCH = 8, PW = 3840, FF = 3584;
constexpr size_t MiB = 1u << 20;
constexpr size_t WS_CTL = 0, CTL_ZERO_BYTES = 1 * MiB;
constexpr size_t WS_SSP = 1 * MiB;
constexpr size_t WS_ROUTE = 3 * MiB;
constexpr size_t WS_LORA = 4 * MiB;
constexpr size_t WS_ROT = 5 * MiB;
constexpr size_t WS_W_EIN = 8 * MiB, WS_W_EOUT = WS_W_EIN + (size_t)PW * D * 2, WS_W_FGU = WS_W_EOUT + 2 * MiB, WS_W_FDN = WS_W_FGU + 14 * MiB,
                 WS_W_OIN = WS_W_FDN + 7 * MiB, WS_W_OOUT = WS_W_OIN + (size_t)PW * D * 2;
static_assert(WS_W_OOUT + 2 * MiB == 48 * MiB, "weight map");
constexpr size_t WS_HB0 = 48 * MiB, WS_HB1 = 112 * MiB, WS_RP = 176 * MiB, WS_RX = 416 * MiB;
constexpr size_t WS_PRET = WS_RP, WS_PRW = WS_RP + 128 * MiB;
constexpr size_t WS_YRAW = WS_HB0;
constexpr size_t WS_W_MGU = 8 * MiB, WS_W_MDN = 64 * MiB;
constexpr int MOE_ROWS = 67584, MOE_TILES = 264;
constexpr size_t WS_HMID = 176 * MiB, WS_XG = 407 * MiB, WS_END = 539 * MiB;
constexpr size_t WS_XG8 = 100 * MiB;
constexpr size_t WS_HBG = WS_HMID;
static_assert(WS_W_MGU + (size_t)5 * 2 * FF * D <= WS_W_OOUT, "experts 0..4 are converted while W_out of layer 1 is still live");
static_assert(WS_W_MGU + (size_t)8 * 2 * FF * D <= WS_W_MDN && WS_W_MDN + (size_t)8 * FF * D <= WS_XG8 && WS_XG8 + (size_t)MOE_ROWS * D <= WS_HMID, "moe fp8 map");
static_assert(WS_HMID + (size_t)MOE_TILES * 256 * FF <= WS_XG && WS_XG + (size_t)MOE_ROWS * D * 2 <= WS_END, "moe map");
constexpr size_t RT_E01 = 0, RT_W0 = 128 * 1024, RT_RS = 256 * 1024, RT_POS0 = 384 * 1024, RT_POS1 = 512 * 1024, RT_RSG = 640 * 1024, RT_CNT = 920 * 1024, RT_TILE_E = 936 * 1024, RT_META = 944 * 1024;
constexpr int CW_BAR = 4096;
constexpr int RING_BYTES = 131072, LDSCTL_OFF = RING_BYTES, MISC_OFF = LDSCTL_OFF + 320, LDS_BYTES = 147456;

#define GAS __attribute__((address_space(1)))
#define LAS __attribute__((address_space(3)))
typedef unsigned short bf16;
typedef unsigned v4u __attribute__((ext_vector_type(4)));
typedef unsigned v2u __attribute__((ext_vector_type(2)));
typedef float f32x4 __attribute__((ext_vector_type(4)));
typedef short bf16x8 __attribute__((ext_vector_type(8)));
typedef GAS unsigned gu32;
#define LDS_WAIT() asm volatile("s_waitcnt lgkmcnt(0)" ::: "memory")
#define VM_WAIT() asm volatile("s_waitcnt vmcnt(0)" ::: "memory")
#define WG_SYNC() __syncthreads()
#define LDS_SYNC() do { asm volatile("s_waitcnt lgkmcnt(0)" ::: "memory"); __builtin_amdgcn_s_barrier(); asm volatile("" ::: "memory"); } while (0)
__device__ __forceinline__ float bflo(unsigned u) { return __uint_as_float(u << 16); }
__device__ __forceinline__ float bfhi(unsigned u) { return __uint_as_float(u & 0xffff0000u); }
__device__ __forceinline__ float bf2f(bf16 u) { return __uint_as_float((unsigned)u << 16); }
typedef float f32x2n __attribute__((ext_vector_type(2)));
typedef __bf16 bfx2n __attribute__((ext_vector_type(2)));
__device__ __forceinline__ unsigned pk2(float lo, float hi) { const f32x2n v = {lo, hi}; return __builtin_bit_cast(unsigned, __builtin_convertvector(v, bfx2n)); }
__device__ __forceinline__ void unpack8(const v4u w, float (&f)[8]) { f[0] = bflo(w.x); f[1] = bfhi(w.x); f[2] = bflo(w.y); f[3] = bfhi(w.y); f[4] = bflo(w.z); f[5] = bfhi(w.z); f[6] = bflo(w.w); f[7] = bfhi(w.w); }
__device__ __forceinline__ v4u pack8(const float (&f)[8]) { v4u w; w.x = pk2(f[0], f[1]); w.y = pk2(f[2], f[3]); w.z = pk2(f[4], f[5]); w.w = pk2(f[6], f[7]); return w; }
__device__ __forceinline__ float fsig(float x) { return __builtin_amdgcn_rcpf(1.0f + __builtin_amdgcn_exp2f(-1.4426950408889634f * x)); }
__device__ __forceinline__ float fexp(float x) { return __builtin_amdgcn_exp2f(1.4426950408889634f * x); }
__device__ __forceinline__ float log_sigmoid(float x) { return fminf(x, 0.f) - 0.6931471805599453f * __builtin_amdgcn_logf(1.0f + __builtin_amdgcn_exp2f(-1.4426950408889634f * fabsf(x))); }
#define DPPF(old, v, ctrl, rmask, bc) __builtin_bit_cast(float, __builtin_amdgcn_update_dpp(__builtin_bit_cast(int, (float)(old)), __builtin_bit_cast(int, (float)(v)), (ctrl), (rmask), 0xf, (bc)))
__device__ __forceinline__ float wave_scan_add(float v) {
    v += DPPF(0.f, v, 0x111, 0xf, true); v += DPPF(0.f, v, 0x112, 0xf, true); v += DPPF(0.f, v, 0x114, 0xf, true); v += DPPF(0.f, v, 0x118, 0xf, true);
    v += DPPF(0.f, v, 0x142, 0xa, false); v += DPPF(0.f, v, 0x143, 0xc, false); return v;
}
__device__ __forceinline__ float wave_scan_max(float v) {
    const float NI = -__builtin_inff();
    v = fmaxf(v, DPPF(NI, v, 0x111, 0xf, false)); v = fmaxf(v, DPPF(NI, v, 0x112, 0xf, false)); v = fmaxf(v, DPPF(NI, v, 0x114, 0xf, false)); v = fmaxf(v, DPPF(NI, v, 0x118, 0xf, false));
    v = fmaxf(v, DPPF(NI, v, 0x142, 0xa, false)); v = fmaxf(v, DPPF(NI, v, 0x143, 0xc, false)); return v;
}
__device__ __forceinline__ float lane63(float v) { return __builtin_bit_cast(float, __builtin_amdgcn_readlane(__builtin_bit_cast(int, v), 63)); }
__device__ __forceinline__ float wave_sum(float v) { return lane63(wave_scan_add(v)); }
#define XB_TMO      128
#define XB_XCNT(j)  (256  + 64 * (j))
#define XB_XSUB(j)  (1280 + 64 * (j))
#define XB_XGEN(j)  (2304 + 64 * (j))
#define XB_TOP      3328
#define XB_TOPGEN   3392
#define XCD_BAR_WORDS 3456
#define XB_SPIN_CAP (1u << 18)

__device__ __forceinline__ unsigned xb_ld(unsigned* p)              { return __hip_atomic_load(p, __ATOMIC_RELAXED, __HIP_MEMORY_SCOPE_AGENT); }
__device__ __forceinline__ unsigned xb_add(unsigned* p, unsigned v) { return __hip_atomic_fetch_add(p, v, __ATOMIC_RELAXED, __HIP_MEMORY_SCOPE_AGENT); }
__device__ __forceinline__ unsigned xb_xcc_id() { return (unsigned)__builtin_amdgcn_s_getreg((3 << 11) | 20) & 0xFu; }
#define XB_SPIN(cond, bar) do { unsigned _sp = 0; while (cond) { __builtin_amdgcn_s_sleep(1); \
    if ((++_sp & 255u) == 0u) { if (xb_ld(&(bar)[XB_TMO])) break; if (_sp > XB_SPIN_CAP) { atomicAdd(&(bar)[XB_TMO], 1u); break; } } } } while (0)

struct XcdBarrier {
    unsigned* bar; unsigned x, wid;
    volatile LAS unsigned* st;
};

__device__ __forceinline__ unsigned xb_lane_id() { unsigned l; asm volatile("v_mbcnt_lo_u32_b32 %0, -1, 0\n\tv_mbcnt_hi_u32_b32 %0, -1, %0" : "=v"(l)); return l; }
__device__ __forceinline__ bool xb_lane0() { return xb_lane_id() == 0u; }
__device__ __forceinline__ XcdBarrier xcd_barrier_post(unsigned* bar, volatile LAS unsigned* st, unsigned wid) {
    XcdBarrier b; b.bar = bar; b.x = xb_xcc_id(); b.st = st; b.wid = wid;
    if (wid == 0u && xb_lane0()) (void)xb_add(&bar[XB_XCNT(b.x)], 1u);
    return b;
}
__device__ __forceinline__ void xcd_barrier_complete(unsigned* bar, unsigned x, unsigned& nloc, unsigned& nx) {
    const unsigned G = gridDim.x * gridDim.y * gridDim.z;
    unsigned sum, cnt, mine, sp = 0u;
    for (;;) {
        sum = 0u; cnt = 0u; mine = 0u;
#pragma unroll
        for (unsigned j = 0; j < 16; ++j) { const unsigned c = xb_ld(&bar[XB_XCNT(j)]); sum += c; cnt += (c > 0u) ? 1u : 0u; mine = (j == x) ? c : mine; }
        if (sum == G) break;
        __builtin_amdgcn_s_sleep(1);
        if ((++sp & 255u) == 0u) { if (xb_ld(&bar[XB_TMO])) break; if (sp > XB_SPIN_CAP) { atomicAdd(&bar[XB_TMO], 1u); break; } }
    }
    nloc = mine > 0u ? mine : 1u; nx = cnt > 0u ? cnt : 1u;
}

__device__ __forceinline__ void xcd_barrier(const XcdBarrier& b) {
    asm volatile("s_waitcnt vmcnt(0)" ::: "memory");
    __syncthreads();
    if (b.wid == 0u && xb_lane0()) {
        unsigned* bar = b.bar;
        __builtin_amdgcn_s_waitcnt(0);
        unsigned nloc = b.st[0], nx = b.st[1];
        if (nloc == 0u) { xcd_barrier_complete(bar, b.x, nloc, nx); b.st[0] = nloc; b.st[1] = nx; }
        const unsigned old = xb_add(&bar[XB_XSUB(b.x)], 1u);
        const unsigned gen = old / nloc;
        if (old + 1u == (gen + 1u) * nloc) {
            __builtin_amdgcn_fence(__ATOMIC_RELEASE, "agent");
            asm volatile("s_waitcnt vmcnt(0)" ::: "memory");
            const unsigned og = xb_add(&bar[XB_TOP], 1u);
            const unsigned tg = og / nx;
            if (og + 1u == (tg + 1u) * nx) xb_add(&bar[XB_TOPGEN], 1u);
            else XB_SPIN(xb_ld(&bar[XB_TOPGEN]) == tg, bar);
            __builtin_amdgcn_fence(__ATOMIC_ACQUIRE, "agent");
            xb_add(&bar[XB_XGEN(b.x)], 1u);
            asm volatile("s_waitcnt vmcnt(0)" ::: "memory");
        } else {
            XB_SPIN(xb_ld(&bar[XB_XGEN(b.x)]) == gen, bar);
            __builtin_amdgcn_fence(__ATOMIC_ACQUIRE, "agent");
            asm volatile("s_waitcnt vmcnt(0)" ::: "memory");
        }
    }
    __syncthreads();
}

enum { I_X = 0, I_EN1G, I_EWIN, I_CONVW, I_CONVB, I_GATEB, I_MLNG, I_GLAUP, I_GLAB, I_GLANG, I_EWOUT, I_EN2G, I_FFG, I_FFU, I_FFD,
       I_ON1G, I_OWIN, I_RETNG, I_RWMU, I_RWWUP, I_RWW0, I_RWAUP, I_RWA0, I_RWGUP, I_RWKK, I_RWKA, I_RWRK, I_RWLNG, I_RWLNB, I_OWOUT, I_ON2G, I_ROUTER, I_MG, I_MU, I_MD, I_FNG, N_IN };
struct Args { const float* in[N_IN]; float* out; unsigned char* ws; int ph_lo, ph_hi; };
struct Ctx { int tid, lane, wid, G, bid, vb; LAS unsigned char* lds; };

__device__ __forceinline__ void tr_item(const float* W, int K, int N, int nblk, bf16* WT, int mode, const float* gain, LAS float* scr, int item, int lane) {
    const int kb = item / nblk, nb = item % nblk, k0 = 64 * kb, n0 = 32 * nb;
    const int nn = n0 + (lane & 31); const bool ok = nn < N;
    const int c = lane & 7;
    f32x4 ga = {1.f, 1.f, 1.f, 1.f}, gb = ga; if (gain) { ga = *(const GAS f32x4*)(gain + k0 + 8 * c); gb = *(const GAS f32x4*)(gain + k0 + 8 * c + 4); }
    float wv[32];
#pragma unroll
    for (int i = 0; i < 32; ++i) { const int kk = 2 * i + (lane >> 5); wv[i] = ok ? W[(size_t)(k0 + kk) * N + nn] : 0.f; }
#pragma unroll
    for (int i = 0; i < 32; ++i) { const int kk = 2 * i + (lane >> 5); scr[kk * 33 + (lane & 31)] = wv[i]; }
    LDS_WAIT(); asm volatile("" ::: "memory");
#pragma unroll
    for (int j = 0; j < 4; ++j) { const int n = (lane >> 3) + 8 * j; const LAS float* s = scr + (8 * c) * 33 + n;
        v4u o; o.x = pk2(s[0 * 33] * ga[0], s[1 * 33] * ga[1]); o.y = pk2(s[2 * 33] * ga[2], s[3 * 33] * ga[3]); o.z = pk2(s[4 * 33] * gb[0], s[5 * 33] * gb[1]); o.w = pk2(s[6 * 33] * gb[2], s[7 * 33] * gb[3]);
        const int ncol = n0 + n; const int drow = mode == 0 ? ncol : ((ncol >> 7) * 256 + (mode == 2 ? 128 : 0) + (ncol & 127));
        *(GAS v4u*)(WT + (size_t)drow * K + k0 + 8 * c) = o; }
    LDS_WAIT(); asm volatile("" ::: "memory");
}
__device__ __forceinline__ void tr_item8(const float* W, int K, int N, int nblk, unsigned char* WT, int mode, const float* gain, LAS float* scr, int item, int lane) {
    const int kb = item / nblk, nb = item % nblk, k0 = 64 * kb, n0 = 32 * nb;
    const int nn = n0 + (lane & 31); const bool ok = nn < N;
    const int c = lane & 3;
    f32x4 g4[4];
#pragma unroll
    for (int q = 0; q < 4; ++q) { g4[q] = (f32x4){256.f, 256.f, 256.f, 256.f}; if (gain) g4[q] = *(const GAS f32x4*)(gain + k0 + 16 * c + 4 * q) * 256.0f; }
    float wv[32];
#pragma unroll
    for (int i = 0; i < 32; ++i) { const int kk = 2 * i + (lane >> 5); wv[i] = ok ? W[(size_t)(k0 + kk) * N + nn] : 0.f; }
#pragma unroll
    for (int i = 0; i < 32; ++i) { const int kk = 2 * i + (lane >> 5); scr[kk * 33 + (lane & 31)] = wv[i]; }
    LDS_WAIT(); asm volatile("" ::: "memory");
#pragma unroll
    for (int j = 0; j < 2; ++j) { const int n = (lane >> 2) + 16 * j; const LAS float* s = scr + (16 * c) * 33 + n;
        v4u o; o.x = pg8::pk4f8(s[0 * 33] * g4[0][0], s[1 * 33] * g4[0][1], s[2 * 33] * g4[0][2], s[3 * 33] * g4[0][3]); o.y = pg8::pk4f8(s[4 * 33] * g4[1][0], s[5 * 33] * g4[1][1], s[6 * 33] * g4[1][2], s[7 * 33] * g4[1][3]);
        o.z = pg8::pk4f8(s[8 * 33] * g4[2][0], s[9 * 33] * g4[2][1], s[10 * 33] * g4[2][2], s[11 * 33] * g4[2][3]); o.w = pg8::pk4f8(s[12 * 33] * g4[3][0], s[13 * 33] * g4[3][1], s[14 * 33] * g4[3][2], s[15 * 33] * g4[3][3]);
        const int ncol = n0 + n; const int drow = mode == 0 ? ncol : ((ncol >> 7) * 256 + (mode == 2 ? 128 : 0) + (ncol & 127));
        *(GAS v4u*)(WT + (size_t)drow * K + k0 + 16 * c) = o; }
    LDS_WAIT(); asm volatile("" ::: "memory");
}
struct TrJob { const float* W; int K, N, nblk; bf16* WT; int mode; const float* gain; };
__device__ __forceinline__ void tr_run(const TrJob& j, LAS float* scr, int gw, int NGW, int lane) {
    const int nitems = (j.K / 64) * j.nblk;
    for (int it = gw; it < nitems; it += NGW) tr_item(j.W, j.K, j.N, j.nblk, j.WT, j.mode, j.gain, scr, it, lane);
}
struct TrJob8 { const float* W; int K, N, nblk; unsigned char* WT; int mode; const float* gain; };
__device__ __forceinline__ void tr_run8(const TrJob8& j, LAS float* scr, int gw, int NGW, int lane) {
    const int nitems = (j.K / 64) * j.nblk;
    for (int it = gw; it < nitems; it += NGW) tr_item8(j.W, j.K, j.N, j.nblk, j.WT, j.mode, j.gain, scr, it, lane);
}
__device__ __forceinline__ void layer_weights_late(const Args& A, const Ctx& C, int gw, int NGW) {
    LAS float* scr = (LAS float*)(C.lds + C.wid * 16384); unsigned char* ws = A.ws;
    { TrJob j{A.in[I_EWOUT], D, D, D / 32, (bf16*)(ws + WS_W_EOUT), 0, nullptr}; tr_run(j, scr, gw, NGW, C.lane); }
#if FFN8_UP
    { TrJob8 j{A.in[I_FFG], D, FF, FF / 32, ws + WS_W_FGU, 1, A.in[I_EN2G]}; tr_run8(j, scr, gw, NGW, C.lane); }
    { TrJob8 j{A.in[I_FFU], D, FF, FF / 32, ws + WS_W_FGU, 2, A.in[I_EN2G]}; tr_run8(j, scr, gw, NGW, C.lane); }
#if FFN8_UP == 2
    { TrJob8 j{A.in[I_FFD], FF, D, D / 32, ws + WS_W_FDN, 0, nullptr}; tr_run8(j, scr, gw, NGW, C.lane); }
#else
    { TrJob j{A.in[I_FFD], FF, D, D / 32, (bf16*)(ws + WS_W_FDN), 0, nullptr}; tr_run(j, scr, gw, NGW, C.lane); }
#endif
#else
    { TrJob j{A.in[I_FFG], D, FF, FF / 32, (bf16*)(ws + WS_W_FGU), 1, A.in[I_EN2G]}; tr_run(j, scr, gw, NGW, C.lane); }
    { TrJob j{A.in[I_FFU], D, FF, FF / 32, (bf16*)(ws + WS_W_FGU), 2, A.in[I_EN2G]}; tr_run(j, scr, gw, NGW, C.lane); }
    { TrJob8 j{A.in[I_FFD], FF, D, D / 32, ws + WS_W_FDN, 0, nullptr}; tr_run8(j, scr, gw, NGW, C.lane); }
#endif
    { TrJob j{A.in[I_OWIN], D, PW, PW / 32, (bf16*)(ws + WS_W_OIN), 0, A.in[I_ON1G]}; tr_run(j, scr, gw, NGW, C.lane); }
    { TrJob j{A.in[I_OWOUT], D, D, D / 32, (bf16*)(ws + WS_W_OOUT), 0, nullptr}; tr_run(j, scr, gw, NGW, C.lane); }
}
__device__ __forceinline__ void p0_prologue(const Args& A, const Ctx& C) {
    LAS float* scr = (LAS float*)(C.lds + C.wid * 16384);
    const int gw = C.bid * NWAVES + C.wid, NGW = C.G * NWAVES;
    unsigned char* ws = A.ws;
    { TrJob j{A.in[I_EWIN], D, 3608, PW / 32, (bf16*)(ws + WS_W_EIN), 0, A.in[I_EN1G]}; tr_run(j, scr, gw, NGW, C.lane); }
    if (C.G != 256) layer_weights_late(A, C, gw, NGW);
    { TrJob j{A.in[I_RWWUP], 64, 512, 16, (bf16*)(ws + WS_LORA), 0, nullptr}; tr_run(j, scr, gw, NGW, C.lane); }
    { TrJob j{A.in[I_RWAUP], 64, 512, 16, (bf16*)(ws + WS_LORA + 65536), 0, nullptr}; tr_run(j, scr, gw, NGW, C.lane); }
    { TrJob j{A.in[I_RWGUP], 128, 512, 16, (bf16*)(ws + WS_LORA + 131072), 0, nullptr}; tr_run(j, scr, gw, NGW, C.lane); }
    { unsigned* tcs = (unsigned*)(ws + WS_ROT);
      for (int e = C.bid * NTHR + C.tid; e < T * 64; e += C.G * NTHR) { const int t = e >> 6, i = e & 63;
          const float inv = exp2f(-(float)(2 * i) * (1.0f / 128.0f) * 13.287712379549449f);
          double rev = (double)((float)t * inv) * 0.15915494309189535; rev -= __builtin_rint(rev); const float fr = (float)rev;
          tcs[e] = pk2(__builtin_amdgcn_cosf(fr), __builtin_amdgcn_sinf(fr)); } }
    { const float* x = A.in[I_X]; bf16* xb = (bf16*)(ws + WS_HB0); float* ssp = (float*)(ws + WS_SSP);
      const int rpw = M / C.G, mb = C.vb * rpw;
      for (int i0 = C.wid; i0 < rpw; i0 += 2 * NWAVES) { const int m0 = mb + i0; f32x4 v[2][4];
#pragma unroll
          for (int r = 0; r < 2; ++r) { const int mr = (i0 + r * NWAVES < rpw) ? m0 + r * NWAVES : m0; const GAS f32x4* xr = (const GAS f32x4*)(x + (size_t)mr * D) + C.lane;
#pragma unroll
              for (int j = 0; j < 4; ++j) v[r][j] = xr[64 * j]; }
#pragma unroll
          for (int r = 0; r < 2; ++r) { const int m = m0 + r * NWAVES; if (i0 + r * NWAVES >= rpw) break; GAS v2u* o8 = (GAS v2u*)(xb + (size_t)m * D) + C.lane; float s = 0.f;
#pragma unroll
              for (int j = 0; j < 4; ++j) { const f32x4 t = v[r][j]; s += (t[0] * t[0] + t[1] * t[1]) + (t[2] * t[2] + t[3] * t[3]); v2u w; w.x = pk2(t[0], t[1]); w.y = pk2(t[2], t[3]); o8[64 * j] = w; }
              s = wave_sum(s);
              if (C.lane < 16) ssp[(size_t)m * 16 + C.lane] = C.lane == 0 ? s : 0.f; } } }
}
__device__ __forceinline__ void moe_weights(const Args& A, const Ctx& C, unsigned gu_mask, unsigned d_mask, int gw, int NGW) {
    LAS float* scr = (LAS float*)(C.lds + C.wid * 16384);
    for (int e = 0; e < 8; ++e) {
        if ((gu_mask >> e) & 1u) {
            { TrJob8 j{A.in[I_MG] + (size_t)e * D * FF, D, FF, FF / 32, A.ws + WS_W_MGU + (size_t)e * 2 * FF * D, 1, A.in[I_ON2G]}; tr_run8(j, scr, gw, NGW, C.lane); }
            { TrJob8 j{A.in[I_MU] + (size_t)e * D * FF, D, FF, FF / 32, A.ws + WS_W_MGU + (size_t)e * 2 * FF * D, 2, A.in[I_ON2G]}; tr_run8(j, scr, gw, NGW, C.lane); } }
        if ((d_mask >> e) & 1u) { TrJob8 j{A.in[I_MD] + (size_t)e * FF * D, FF, D, D / 32, A.ws + WS_W_MDN + (size_t)e * D * FF, 0, nullptr}; tr_run8(j, scr, gw, NGW, C.lane); } }
}

template <int KS, bool SWA = false, bool SWB = false> __device__ __forceinline__ f32x4 mma_rows(const LAS unsigned char* A, int lda, int m0, const LAS unsigned char* Bt, int ldb, int n0, f32x4 acc, int lane) {
    const int r = lane & 15, q = lane >> 4;
    const int sa = SWA ? (((m0 + r) >> 3) & 7) : 0, sb = SWB ? (((n0 + r) >> 3) & 7) : 0;
#pragma unroll
    for (int ks = 0; ks < KS; ++ks) {
        const bf16x8 a = *(const LAS bf16x8*)(A + (m0 + r) * lda + (((ks * 4 + q) ^ sa) * 16));
        const bf16x8 b = *(const LAS bf16x8*)(Bt + (n0 + r) * ldb + (((ks * 4 + q) ^ sb) * 16));
        acc = __builtin_amdgcn_mfma_f32_16x16x32_bf16(a, b, acc, 0, 0, 0);
    }
    return acc;
}
struct MixArgs {
    const bf16* P; int pitch;
    bf16* out;
    const float *convw, *convb, *gateb, *normg;
    const float *gup, *gb;
    float* snap;
    const unsigned* rcs;
};
__device__ __forceinline__ void scatter8x2(LAS unsigned char* base, int ld, int col0, int j0, const v4u a, const v4u b) {
    const unsigned aa[4] = {a.x, a.y, a.z, a.w}, bb[4] = {b.x, b.y, b.z, b.w};
    const int js = j0 ^ (((col0 >> 3) & 7) << 3);
#pragma unroll
    for (int i = 0; i < 8; ++i) { const unsigned lo = (aa[i >> 1] >> (16 * (i & 1))) & 0xffffu, hi = (bb[i >> 1] >> (16 * (i & 1))) & 0xffffu; *(LAS unsigned*)(base + (col0 + i) * ld + 2 * js) = lo | (hi << 16); }
}
template <int KIND>
__device__ __forceinline__ void mixer_unit(const MixArgs& X, const Ctx& C, int b, int h, int seg, int nseg, int pass) {
    constexpr int L = 64, DK = (KIND == 1) ? 64 : 128, DV = 128;
    constexpr int LDK = (DK + 8) * 2, LDL = (L + 8) * 2;
    constexpr int OFF_Q = 0, SZ_Q = L * LDK, OFF_K = OFF_Q + SZ_Q, OFF_KT = OFF_K + SZ_Q, SZ_KT = DK * LDL, OFF_PM = OFF_KT + SZ_KT, SZ_PM = L * LDL, OFF_VT = OFF_PM + SZ_PM, SZ_VT = DV * LDL,
                  OFF_ST = OFF_VT + SZ_VT, SZ_ST = DV * LDK, OFF_SC = OFF_ST + SZ_ST, SCB = (KIND == 1) ? 24576 : 8192, OFF_HS = 0;
    constexpr int HSLD = 132;
    static_assert(OFF_SC + SCB <= RING_BYTES && L * HSLD * 4 <= ((KIND == 1) ? OFF_VT : OFF_KT), "mixer LDS map");
    constexpr int SC_U = 0, SC_MM = 64, SC_RS = 128, SC_EM = 192, SC_CS = 256, SC_DEN = 320, SC_NV = 384, SC_CD = 512, SC_TAB = 576;
    constexpr int SC_LA = 0, LALD = 65, SC_GUP = SC_LA + 64 * LALD, SC_GB = SC_GUP + 1024, SC_GG = SC_GB + 64, SC_GS = SC_GG + 64;
    static_assert((SC_GS + 64) * 4 <= 24576 && (SC_TAB + 1280) * 4 <= 8192, "scalar region");
    LAS unsigned char* lds = C.lds;
    LAS unsigned char* Qs = lds + OFF_Q; LAS unsigned char* Ks = lds + OFF_K; LAS unsigned char* Kt = lds + OFF_KT; LAS unsigned char* Vt = lds + OFF_VT;
    LAS unsigned char* St = lds + OFF_ST; LAS unsigned char* Pm = lds + OFF_PM; LAS float* SC = (LAS float*)(lds + OFF_SC); LAS float* Hs = (LAS float*)(lds + OFF_HS);
    int tid = C.tid; asm volatile("" : "+v"(tid));
    const int lane = tid & 63, wid = C.wid, q4 = lane >> 4, r16 = lane & 15;
    const bf16* P = X.P; const int pitch = X.pitch;
    const float qscale = (KIND == 1) ? 0.125f : 0.08838834764831845f;
    const int c0 = (64 * seg) / nseg, c1 = (64 * (seg + 1)) / nseg;
    const bool full = pass == 1;
    constexpr int SNAP_F = (DK / 16) * 512 * 4 + 256;
    float* snap_base = X.snap + (size_t)((b * 4 + h) * nseg) * SNAP_F;
    LDS_SYNC();
    for (int i = tid; i < SZ_ST / 4; i += NTHR) ((LAS unsigned*)St)[i] = 0u;
    LAS float* NG = (LAS float*)(lds + LDSCTL_OFF + 8192);
    {
        const float ngv = X.normg[h * 128 + (tid & 127)]; float t0 = 0.f, t1 = 0.f, t2 = 0.f;
        if (KIND == 0) { const int k = (tid >> 7) & 3, c = tid & 127, tb = tid & 255; t0 = X.convw[k * 1024 + h * 128 + c]; t1 = X.convw[k * 1024 + 512 + h * 128 + c]; t2 = X.convb[(tb >> 7) * 512 + h * 128 + (tb & 127)]; }
        if (KIND == 1) { t0 = X.gup[(tid >> 6) * 256 + h * 64 + (tid & 63)]; t1 = X.gup[((tid + 512) >> 6) * 256 + h * 64 + (tid & 63)]; t2 = X.gb[h * 64 + (tid & 63)]; }
        if (tid < 128) NG[tid] = ngv;
        if (KIND == 0) { if (tid < 128) SC[SC_NV + tid] = 0.f; SC[SC_TAB + tid] = t0; SC[SC_TAB + 512 + tid] = t1; if (tid < 256) SC[SC_TAB + 1024 + tid] = t2; }
        if (KIND == 1) { SC[SC_GUP + tid] = t0; SC[SC_GUP + 512 + tid] = t1; if (tid < 64) SC[SC_GB + tid] = t2; } }
    float lg2 = 0.f;
    if (KIND == 2) lg2 = log2f(1.0f - exp2f(-5.0f - (float)h));
    float mprev = -1e30f, fsum = 0.f;
    constexpr int NST = DK / 16;
    f32x4 accs[NST];
#pragma unroll
    for (int i = 0; i < NST; ++i) accs[i] = (f32x4){0.f, 0.f, 0.f, 0.f};
    const int s_dkt = (DK == 64) ? (wid >> 1) : wid, s_et0 = (DK == 64) ? 4 * (wid & 1) : 0;
    constexpr int NOT = 4;
    const int o_rt = wid >> 1, o_et0 = 4 * (wid & 1);
    const int cc = tid & 15, r0 = tid >> 4, j0 = 2 * r0;
    const int ei = tid >> 3, esub = tid & 7;
    v4u pq[5], pk[5], pv[2], pe_cur[2];
    v4u pcs[2][2];
    v4u pgl[2]; unsigned pgi = 0u, pgf = 0u;
    float gb_i = 0.f, gb_f = 0.f; if (KIND == 0) { gb_i = X.gateb[h]; gb_f = X.gateb[4 + h]; }
#define MIX_LOAD(c_, full_) do { const int t0_ = (c_) * L; const size_t g0_ = (size_t)b * T + t0_; \
        if (KIND == 0) { \
            if (wid == 0) { pgi = P[(g0_ + lane + lz) * pitch + 2048 + h]; pgf = P[(g0_ + lane + lz) * pitch + 2052 + h]; } } \
        if (KIND == 2) { const int s_ = ccv >> 3, c8_ = ccv & 7; \
            _Pragma("unroll") for (int rr = 0; rr < 2; ++rr) { const int j = j0v + rr; \
                { const bf16* src = P + (g0_ + j) * pitch + s_ * 512 + h * 128 + 8 * c8_; pq[2 * rr] = *(const GAS v4u*)src; pq[2 * rr + 1] = *(const GAS v4u*)(src + 64);   \
                    const GAS v4u* pc_ = (const GAS v4u*)(X.rcs + (size_t)(t0_ + j) * 64 + 8 * c8_); pcs[rr][0] = pc_[0]; pcs[rr][1] = pc_[1]; } \
                pv[rr] = *(const GAS v4u*)(P + (g0_ + j) * pitch + 1024 + h * 128 + 8 * ccv); } } \
        if (KIND == 1) { const int s_ = tid >> 8, jp_ = 2 * ((tid >> 3) & 31) + lz, c8_ = (tid & 7) + lz; \
            { _Pragma("unroll") for (int rr = 0; rr < 2; ++rr) pq[rr] = *(const GAS v4u*)(P + (g0_ + jp_ + rr) * pitch + 2056 + 256 * s_ + h * 64 + 8 * c8_); } \
            _Pragma("unroll") for (int rr = 0; rr < 2; ++rr) pv[rr] = *(const GAS v4u*)(P + (g0_ + j0v + rr) * pitch + 2568 + h * 128 + 8 * ccv); \
            const GAS v4u* gp_ = (const GAS v4u*)(P + (g0_ + lane + lz) * pitch + 3592); pgl[0] = gp_[0]; pgl[1] = gp_[1]; } \
    } while (0)
#define MIX_LOAD_NOW(c_, full_) do { const int t0_ = (c_) * L; \
        if (KIND == 0) { \
            _Pragma("unroll") for (int k = 0; k < 5; ++k) { const int tt = t0_ + j0v - 3 + k; const bool okr = tt >= 0; const size_t ro = ((size_t)b * T + (okr ? tt : 0)) * pitch + h * 128 + 8 * ccv; \
                { pq[k] = *(const GAS v4u*)(P + ro); if (!okr) pq[k] = (v4u){0u, 0u, 0u, 0u}; } \
                pk[k] = *(const GAS v4u*)(P + ro + 512); if (!okr) pk[k] = (v4u){0u, 0u, 0u, 0u}; } \
            _Pragma("unroll") for (int rr = 0; rr < 2; ++rr) pv[rr] = *(const GAS v4u*)(P + ((size_t)b * T + t0_ + j0v + rr) * pitch + 1024 + h * 128 + 8 * ccv); } \
    } while (0)
#define MIX_LOAD_E(c_) do { const size_t g0_ = (size_t)b * T + (c_) * L; const int eo_ = (KIND == 1) ? 3080 : 1536; const GAS v4u* ep_ = (const GAS v4u*)(P + (g0_ + eiv) * pitch + eo_ + h * 128 + 16 * esubv); pe_cur[0] = ep_[0]; pe_cur[1] = ep_[1]; } while (0)
    { int lz = 0; asm volatile("" : "+v"(lz)); const int j0v = j0 + lz, ccv = cc + lz; MIX_LOAD(c0, full); }
    if (KIND == 1) { for (int i = tid; i < 64; i += NTHR) SC[SC_GS + i] = 0.f; }
    if (pass == 1) {
        f32x4 nsv[NST], nax = {0.f, 0.f, 0.f, 0.f}; float nm = 0.f, nF = 0.f, nnv = 0.f;
#define MIX_FOLD_LOAD(j_) do { const float* sp_ = snap_base + (size_t)(j_) * SNAP_F; const float* aux_ = sp_ + NST * 2048; \
            _Pragma("unroll") for (int x = 0; x < NST; ++x) nsv[x] = *(const GAS f32x4*)(sp_ + (x * 512 + tid) * 4); \
            if (KIND == 0) { nm = aux_[128]; nF = aux_[129]; nnv = aux_[tid & 127]; } \
            if (KIND == 1) nax = *(const GAS f32x4*)(aux_ + 16 * s_dkt + 4 * q4); } while (0)
        if (seg > 0) MIX_FOLD_LOAD(0);
        for (int j = 0; j < seg; ++j) {
            f32x4 csv[NST]; const f32x4 cax = nax; const float cm = nm, cF = nF, cnv = nnv;
#pragma unroll
            for (int x = 0; x < NST; ++x) csv[x] = nsv[x];
            { const int jn_ = (j + 1 < seg) ? j + 1 : j; MIX_FOLD_LOAD(jn_); }
            float fa = 1.f, fb = 1.f;
            if (KIND == 0) { const float mn = fmaxf(mprev + cF, cm); fa = fexp(mprev + cF - mn); fb = fexp(cm - mn); mprev = mn; }
            if (KIND == 2) fa = __builtin_amdgcn_exp2f(lg2 * (float)(64 * ((64 * (j + 1)) / nseg - (64 * j) / nseg)));
#pragma unroll
            for (int x = 0; x < NST; ++x) { f32x4 a = accs[x];
                if (KIND == 1) {
#pragma unroll
                    for (int r = 0; r < 4; ++r) a[r] *= fexp(cax[r]);
                } else a = a * fa;
                accs[x] = a + csv[x] * fb; }
            if (KIND == 0 && tid < 128) SC[SC_NV + tid] = fa * SC[SC_NV + tid] + fb * cnv; }
#undef MIX_FOLD_LOAD
#pragma unroll
        for (int x = 0; x < NST; ++x) { const int e = 16 * (s_et0 + x) + r16; v2u w; w.x = pk2(accs[x][0], accs[x][1]); w.y = pk2(accs[x][2], accs[x][3]);
            *(LAS v2u*)(St + e * LDK + 2 * (16 * s_dkt + 4 * q4)) = w; }
    }
    LDS_SYNC();

    for (int c = c0; c < c1; ++c) {
        const int t0 = c * L; const size_t grow0 = (size_t)b * T + t0;
        int lz = 0; asm volatile("" : "+v"(lz));
        const int j0v = j0 + lz, ccv = cc + lz, eiv = ei + lz, esubv = esub + lz, lv = lane + lz, q4v = lv >> 4, r16v = lv & 15;
        MIX_LOAD_NOW(c, full);
        MIX_LOAD_E(c);
        if (KIND == 0) {
            if (wid == 0) {
                const float ip = bf2f((bf16)pgi) + gb_i, fp = bf2f((bf16)pgf) + gb_f;
                const float bs = wave_scan_add(log_sigmoid(fp));
                const float u = ip - bs, am = wave_scan_max(u);
                const float Mi = fmaxf(mprev, am), g = lane63(bs), Ml = lane63(Mi);
                SC[SC_U + lane] = u; SC[SC_MM + lane] = Mi; SC[SC_RS + lane] = fexp(mprev - Mi); SC[SC_EM + lane] = fexp(-(bs + Mi)); SC[SC_CS + lane] = fexp(u - Ml);
                if (lane == 0) SC[SC_CD] = fexp(mprev - Ml);
                mprev = g + Ml; fsum += g; }
            LDS_SYNC();
        }
        if (KIND == 1) {
            float gl[16]; { float t8[8]; unpack8(pgl[0], t8);
#pragma unroll
                for (int i = 0; i < 8; ++i) gl[i] = t8[i]; unpack8(pgl[1], t8);
#pragma unroll
                for (int i = 0; i < 8; ++i) gl[8 + i] = t8[i]; }
#pragma unroll
            for (int k = 0; k < 8; ++k) { const int d = lz + wid * 8 + k; float z = SC[SC_GB + d];
#pragma unroll
                for (int r = 0; r < 16; ++r) z += gl[r] * SC[SC_GUP + r * 64 + d];
                const float v = wave_scan_add(log_sigmoid(z) * (1.0f / 16.0f));
                SC[SC_LA + lane * LALD + d] = v; if (lane == 63) { SC[SC_GG + d] = v; SC[SC_GS + d] += v; } }
            LDS_SYNC();
        }
        {
        if (KIND == 0) {
            v4u kt2[2];
#pragma unroll
            for (int rr = 0; rr < 2; ++rr) { const int j = j0 + rr;
#pragma unroll
                for (int s = 0; s < 2; ++s) {
                    if (s == 0 && !full) continue;
                    float acc[8];
#pragma unroll
                    for (int i = 0; i < 8; ++i) acc[i] = SC[lz + SC_TAB + 1024 + s * 128 + 8 * cc + i];
#pragma unroll
                    for (int k = 0; k < 4; ++k) { float xv[8]; unpack8(s == 0 ? pq[rr + k] : pk[rr + k], xv);
#pragma unroll
                        for (int i = 0; i < 8; ++i) acc[i] += xv[i] * SC[lz + SC_TAB + (s * 4 + k) * 128 + 8 * cc + i]; }
#pragma unroll
                    for (int i = 0; i < 8; ++i) acc[i] = acc[i] * fsig(acc[i]);
                    if (s == 0) {
#pragma unroll
                        for (int i = 0; i < 8; ++i) acc[i] *= qscale;
                        *(LAS v4u*)(Qs + j * LDK + 16 * cc) = pack8(acc);
                    } else {
                        *(LAS v4u*)(Ks + j * LDK + 16 * cc) = pack8(acc);
                        const float cs = SC[SC_CS + j];
#pragma unroll
                        for (int i = 0; i < 8; ++i) acc[i] *= cs;
                        kt2[rr] = pack8(acc);
                    }
                    __builtin_amdgcn_sched_barrier(0);
                } }
            scatter8x2(Kt, LDL, 8 * cc, j0, kt2[0], kt2[1]); scatter8x2(Vt, LDL, 8 * cc, j0, pv[0], pv[1]);
        }
        if (KIND == 2) {
            const int s = cc >> 3, c8 = cc & 7; v4u kt1[2], kt2[2];
#pragma unroll
            for (int rr = 0; rr < 2; ++rr) { const int j = j0 + rr;
                if (full || s == 1) {
                    float x1[8], x2[8]; unpack8(pq[2 * rr], x1); unpack8(pq[2 * rr + 1], x2);
                    const unsigned csw[8] = {pcs[rr][0].x, pcs[rr][0].y, pcs[rr][0].z, pcs[rr][0].w, pcs[rr][1].x, pcs[rr][1].y, pcs[rr][1].z, pcs[rr][1].w};
                    float o1[8], o2[8];
#pragma unroll
                    for (int i = 0; i < 8; ++i) { const float cv = bflo(csw[i]), sv = bfhi(csw[i]); o1[i] = x1[i] * cv - x2[i] * sv; o2[i] = x1[i] * sv + x2[i] * cv; }
                    if (s == 0) {
#pragma unroll
                        for (int i = 0; i < 8; ++i) { o1[i] *= qscale; o2[i] *= qscale; }
                        *(LAS v4u*)(Qs + j * LDK + 16 * c8) = pack8(o1); *(LAS v4u*)(Qs + j * LDK + 128 + 16 * c8) = pack8(o2);
                    } else {
                        *(LAS v4u*)(Ks + j * LDK + 16 * c8) = pack8(o1); *(LAS v4u*)(Ks + j * LDK + 128 + 16 * c8) = pack8(o2);
                        const float cs = __builtin_amdgcn_exp2f(lg2 * (float)(L - 1 - j));
#pragma unroll
                        for (int i = 0; i < 8; ++i) { o1[i] *= cs; o2[i] *= cs; }
                        kt1[rr] = pack8(o1); kt2[rr] = pack8(o2);
                    } }
                __builtin_amdgcn_sched_barrier(0); }
            if (s == 1) { scatter8x2(Kt, LDL, 8 * c8, j0, kt1[0], kt1[1]); scatter8x2(Kt, LDL, 64 + 8 * c8, j0, kt2[0], kt2[1]); }
            scatter8x2(Vt, LDL, 8 * cc, j0, pv[0], pv[1]);
        }
        if (KIND == 1) {
            { const int sk = tid >> 8, jp = 2 * ((tid >> 3) & 31), c8 = tid & 7; v4u kw[2];
              if (full || sk == 1) {
#pragma unroll
                  for (int rr = 0; rr < 2; ++rr) { const int j = jp + rr; float xv[8]; unpack8(pq[rr], xv);
#pragma unroll
                      for (int i = 0; i < 8; ++i) { const float bvv = SC[SC_LA + j * LALD + 8 * c8 + i]; xv[i] *= (sk == 0) ? qscale * fexp(bvv) : fexp(-bvv); }
                      kw[rr] = pack8(xv);
                      *(LAS v4u*)((sk == 0 ? Qs : Ks) + j * LDK + 16 * c8) = kw[rr]; }
                  if (sk == 1) scatter8x2(Kt, LDL, 8 * c8, jp, kw[0], kw[1]); } }
            scatter8x2(Vt, LDL, 8 * cc, j0, pv[0], pv[1]);
        }
        }
        { const int cn_ = (c + 1 < c1) ? c + 1 : c; MIX_LOAD(cn_, full); }
        LDS_SYNC();
        f32x4 acco[NOT];
        if (full) {
            const int jt = wid >> 1;
#pragma unroll
            for (int x = 0; x < 2; ++x) { const int it = 2 * (wid & 1) + x;
                f32x4 s = (f32x4){0.f, 0.f, 0.f, 0.f};
                if (jt <= it) s = mma_rows<DK / 32>(Ks, LDK, 16 * jt, Qs, LDK, 16 * it, s, lv);
                const int i = 16 * it + r16v, j0 = 16 * jt + 4 * q4v; float p[4];
#pragma unroll
                for (int r = 0; r < 4; ++r) { const int j = j0 + r; float dcy;
                    if (KIND == 0) dcy = fexp(SC[SC_U + j] - SC[SC_MM + i]); else if (KIND == 2) dcy = __builtin_amdgcn_exp2f(lg2 * (float)(i - j)); else dcy = 1.f;
                    p[r] = (j <= i) ? s[r] * dcy : 0.f; }
                v2u w; w.x = pk2(p[0], p[1]); w.y = pk2(p[2], p[3]); *(LAS v2u*)(Pm + i * LDL + 2 * j0) = w; }
#pragma unroll
            for (int x = 0; x < NOT; ++x) { acco[x] = mma_rows<DK / 32>(Qs, LDK, 16 * o_rt, St, LDK, 16 * (o_et0 + x), (f32x4){0.f, 0.f, 0.f, 0.f}, lv);
                if (KIND != 1) {
#pragma unroll
                    for (int r = 0; r < 4; ++r) { const int i = 16 * o_rt + 4 * q4v + r; const float rs = (KIND == 0) ? SC[SC_RS + i] : __builtin_amdgcn_exp2f(lg2 * (float)(i + 1)); acco[x][r] *= rs; } }
                if (x & 1) asm volatile("" ::: "memory"); }
        }
        LDS_SYNC();
        if (full) {
#pragma unroll
            for (int x = 0; x < NOT; ++x) { acco[x] = mma_rows<L / 32, false, true>(Pm, LDL, 16 * o_rt, Vt, LDL, 16 * (o_et0 + x), acco[x], lv); if (x & 1) asm volatile("" ::: "memory"); }
            if (KIND == 0) { const int i = tid >> 3, sub = tid & 7; float pvv[8]; unpack8(*(const LAS v4u*)(Pm + i * LDL + 16 * sub), pvv);
                float ps = ((pvv[0] + pvv[1]) + (pvv[2] + pvv[3])) + ((pvv[4] + pvv[5]) + (pvv[6] + pvv[7])); float qn = 0.f;
#pragma unroll
                for (int hh = 0; hh < 2; ++hh) { float qv[8]; unpack8(*(const LAS v4u*)(Qs + i * LDK + 32 * sub + 16 * hh), qv);
#pragma unroll
                    for (int e = 0; e < 8; ++e) qn += qv[e] * SC[SC_NV + 16 * sub + 8 * hh + e]; }
                float v = ps + SC[SC_RS + i] * qn; v += __shfl_xor(v, 1); v += __shfl_xor(v, 2); v += __shfl_xor(v, 4);
                if (sub == 0) SC[SC_DEN + i] = v; }
        }
        { float pre = 1.f; if (KIND == 0) pre = SC[SC_CD]; if (KIND == 2) pre = __builtin_amdgcn_exp2f(lg2 * (float)L);
#pragma unroll
          for (int x = 0; x < NST; ++x) { f32x4 a = accs[x] * pre; a = mma_rows<L / 32, true, true>(Kt, LDL, 16 * s_dkt, Vt, LDL, 16 * (s_et0 + x), a, lv);
              if (KIND == 1) {
#pragma unroll
                  for (int r = 0; r < 4; ++r) a[r] *= fexp(SC[SC_GG + 16 * s_dkt + 4 * q4v + r]); }
              accs[x] = a; if (x & 1) asm volatile("" ::: "memory"); } }
        LDS_SYNC();
        if (full) {
#pragma unroll
            for (int x = 0; x < NOT; ++x)
#pragma unroll
                for (int r = 0; r < 4; ++r) { const int i = 16 * o_rt + 4 * q4v + r, e = 16 * (o_et0 + x) + r16v; float v = acco[x][r];
                    if (KIND == 0) v = v * __builtin_amdgcn_rcpf(fmaxf(fabsf(SC[SC_DEN + i]), SC[SC_EM + i]));
                    Hs[i * HSLD + e] = v; }
        }
        if (KIND == 0 && tid < 128) { float s = 0.f;
#pragma unroll
            for (int k = 0; k < 8; ++k) { float kv[8]; unpack8(*(const LAS v4u*)(Kt + tid * LDL + 16 * k), kv); s += ((kv[0] + kv[1]) + (kv[2] + kv[3])) + ((kv[4] + kv[5]) + (kv[6] + kv[7])); }
            SC[SC_NV + tid] = SC[SC_CD] * SC[SC_NV + tid] + s; }
#pragma unroll
        for (int x = 0; x < NST; ++x) { const int e = 16 * (s_et0 + x) + r16v; v2u w; w.x = pk2(accs[x][0], accs[x][1]); w.y = pk2(accs[x][2], accs[x][3]);
            *(LAS v2u*)(St + e * LDK + 2 * (16 * s_dkt + 4 * q4v)) = w; }
        LDS_SYNC();
        if (full) {
            const size_t row = grow0 + ei; float o[16];
#pragma unroll
            for (int k = 0; k < 4; ++k) { const f32x4 a = *(const LAS f32x4*)(Hs + ei * HSLD + 16 * esub + 4 * k); o[4 * k] = a[0]; o[4 * k + 1] = a[1]; o[4 * k + 2] = a[2]; o[4 * k + 3] = a[3]; }
            float gt[16]; { float t8[8]; unpack8(pe_cur[0], t8);
#pragma unroll
                for (int e = 0; e < 8; ++e) gt[e] = t8[e]; unpack8(pe_cur[1], t8);
#pragma unroll
                for (int e = 0; e < 8; ++e) gt[8 + e] = t8[e]; }
            if (KIND == 0) {
#pragma unroll
                for (int e = 0; e < 16; ++e) o[e] *= fsig(gt[e]); }
            float sm = 0.f;
            if (KIND != 1) {
#pragma unroll
                for (int e = 0; e < 16; ++e) sm += o[e];
                sm += __shfl_xor(sm, 1); sm += __shfl_xor(sm, 2); sm += __shfl_xor(sm, 4); }
            const float mean = sm * (1.0f / 128.0f); float vs = 0.f;
#pragma unroll
            for (int e = 0; e < 16; ++e) { o[e] -= mean; vs += o[e] * o[e]; }
            vs += __shfl_xor(vs, 1); vs += __shfl_xor(vs, 2); vs += __shfl_xor(vs, 4);
            const float rinv = __builtin_amdgcn_rsqf(vs * (1.0f / 128.0f) + 1e-6f);
            const int ocol = ((KIND == 1) ? 512 : 0) + h * 128 + 16 * esub;
#pragma unroll
            for (int e = 0; e < 16; ++e) { float v = o[e] * rinv * NG[lz + 16 * esub + e]; if (KIND != 0) v *= gt[e] * fsig(gt[e]); o[e] = v; }
            float lo8[8], hi8[8];
#pragma unroll
            for (int e = 0; e < 8; ++e) { lo8[e] = o[e]; hi8[e] = o[8 + e]; }
            GAS v4u* dst = (GAS v4u*)(X.out + row * 1024 + ocol); dst[0] = pack8(lo8); dst[1] = pack8(hi8);
            LDS_SYNC();
        }
    }
    if (pass == 0) {
        float* sp = snap_base + (size_t)seg * SNAP_F; float* aux = sp + NST * 2048;
#pragma unroll
        for (int x = 0; x < NST; ++x) *(GAS f32x4*)(sp + (x * 512 + tid) * 4) = accs[x];
        if (KIND == 0) { if (tid < 128) aux[tid] = SC[SC_NV + tid]; if (tid == 0) { aux[128] = mprev; aux[129] = fsum; } }
        if (KIND == 1) { if (tid < 64) aux[tid] = SC[SC_GS + tid]; }
    }
#undef MIX_LOAD
#undef MIX_LOAD_NOW
#undef MIX_LOAD_E
}

typedef short s16x4 __attribute__((ext_vector_type(4)));
#define DPP_ADD(v, ctrl) ((v) + __builtin_bit_cast(float, __builtin_amdgcn_update_dpp(0, __builtin_bit_cast(int, (v)), (ctrl), 0xf, 0xf, true)))
__device__ __forceinline__ float row16_sum(float v) { v = DPP_ADD(v, 0xB1); v = DPP_ADD(v, 0x4E); v = DPP_ADD(v, 0x141); v = DPP_ADD(v, 0x140); return v; }
__device__ __forceinline__ float row16_scan(float v) { v = DPP_ADD(v, 0x111); v = DPP_ADD(v, 0x112); v = DPP_ADD(v, 0x114); v = DPP_ADD(v, 0x118); return v; }
__device__ __forceinline__ f32x4 mfma32(bf16x8 a, bf16x8 b, f32x4 c) { return __builtin_amdgcn_mfma_f32_16x16x32_bf16(a, b, c, 0, 0, 0); }
__device__ __forceinline__ f32x4 mfma16(s16x4 a, s16x4 b, f32x4 c) { bf16x8 a8, b8; a8[0] = a[0]; a8[1] = a[1]; a8[2] = a[2]; a8[3] = a[3]; a8[4] = 0; a8[5] = 0; a8[6] = 0; a8[7] = 0;
    b8[0] = b[0]; b8[1] = b[1]; b8[2] = b[2]; b8[3] = b[3]; b8[4] = 0; b8[5] = 0; b8[6] = 0; b8[7] = 0; return mfma32(a8, b8, c); }
__device__ __forceinline__ s16x4 pk4(float a, float b, float c, float d) { v2u w; w.x = pk2(a, b); w.y = pk2(c, d); return __builtin_bit_cast(s16x4, w); }
__device__ __forceinline__ s16x4 pk4v(f32x4 v) { return pk4(v[0], v[1], v[2], v[3]); }
__device__ __forceinline__ bf16x8 cat8(s16x4 lo, s16x4 hi) { bf16x8 r; r[0] = lo[0]; r[1] = lo[1]; r[2] = lo[2]; r[3] = lo[3]; r[4] = hi[0]; r[5] = hi[1]; r[6] = hi[2]; r[7] = hi[3]; return r; }
constexpr int RW_REC = 11520;
constexpr int RWO_FU = 0, RWO_FS = 2048, RWO_FY = 6144, RWO_W2 = 8192, RWO_W4 = 8704, RWO_VC = 9216, RWO_G = 11264;
constexpr size_t WS_CHD_A = WS_RP, WS_CHD_B = WS_RX, WS_RWG2 = WS_RX + 68 * MiB, WS_RWBON = WS_RX + 100 * MiB;
static_assert(5 * 2048 * (size_t)RW_REC <= 128 * MiB && 3 * 2048 * (size_t)RW_REC <= 68 * MiB && WS_RWBON + MiB <= WS_END, "rwkv map");
__device__ __forceinline__ unsigned char* rw_record(unsigned char* ws, int b, int h, int c) {
    return b < 5 ? ws + WS_CHD_A + (size_t)((b * 8 + h) * 256 + c) * RW_REC : ws + WS_CHD_B + (size_t)(((b - 5) * 8 + h) * 256 + c) * RW_REC;
}
struct RwArgs {
    const bf16* PRW;
    const float *mu, *w0, *a0, *kk_w, *ka_w, *rk_w, *lng, *lnb;
    const bf16 *WupT, *AupT, *GupT;
    bf16* G; float* bonus;
    unsigned char* ws;
    float* yraw;
    bf16* out;
};
__device__ __forceinline__ void shift4(const bf16* PRW, const float* mu, size_t row, int t, int c, float (&o)[4]) {
    const v2u cur = *(const GAS v2u*)(PRW + row * 1792 + c); v2u prv; prv.x = 0u; prv.y = 0u;
    if (t > 0) prv = *(const GAS v2u*)(PRW + (row - 1) * 1792 + c);
    const f32x4 m = *(const GAS f32x4*)(mu + c);
    const float cu[4] = {bflo(cur.x), bfhi(cur.x), bflo(cur.y), bfhi(cur.y)}, pr[4] = {bflo(prv.x), bfhi(prv.x), bflo(prv.y), bfhi(prv.y)};
#pragma unroll
    for (int i = 0; i < 4; ++i) o[i] = cu[i] + (pr[i] - cu[i]) * m[i];
}
constexpr int RW_RAWLD = 3072 + 16;
__device__ __forceinline__ void shift4_lds(const LAS unsigned char* RAW, const LAS float* PAR, int tok16, int t, int arr, int c, float (&o)[4]) {
    const LAS unsigned char* rp = RAW + (tok16 + 1) * RW_RAWLD + arr * 1024 + c * 2;
    const v2u cur = *(const LAS v2u*)rp; v2u prv = *(const LAS v2u*)(rp - RW_RAWLD); if (t == 0) { prv.x = 0u; prv.y = 0u; }
    const f32x4 m = *(const LAS f32x4*)(PAR + arr * 512 + c);
    const float cu[4] = {bflo(cur.x), bfhi(cur.x), bflo(cur.y), bfhi(cur.y)}, pr[4] = {bflo(prv.x), bfhi(prv.x), bflo(prv.y), bfhi(prv.y)};
#pragma unroll
    for (int i = 0; i < 4; ++i) o[i] = cu[i] + (pr[i] - cu[i]) * m[i];
}
__device__ __forceinline__ void rwkv_prep_unit(const RwArgs& X, const Ctx& C, int unit, bool fill_par) {
    constexpr int LD64 = (64 + 8) * 2, LD128 = (128 + 8) * 2;
    LAS unsigned char* TD = C.lds; LAS unsigned char* XA = TD + 64 * LD64; LAS unsigned char* SG = XA + 64 * LD64;
    LAS float* PAR = (LAS float*)(C.lds + 36864);
    LAS unsigned char* RAW = C.lds + 36864 + 16384;
    int tid = C.tid; asm volatile("" : "+v"(tid));
    const int lane = tid & 63, wid = C.wid, q4_ = lane >> 4, r16_ = lane & 15;
    const size_t row0 = (size_t)unit * 64; const int tb = (unit * 64) & (T - 1), bat = unit >> 6;
    WG_SYNC();
    if (fill_par) { float pv[8]; pv[0] = X.mu[tid]; pv[1] = X.mu[512 + tid]; pv[2] = X.mu[1024 + tid]; pv[3] = X.w0[tid]; pv[4] = X.a0[tid]; pv[5] = X.kk_w[tid]; pv[6] = X.ka_w[tid]; pv[7] = X.rk_w[tid];
#pragma unroll
        for (int k = 0; k < 8; ++k) PAR[512 * k + tid] = pv[k]; }
    v4u cuw[4], prw[4];
#pragma unroll
    for (int k = 0; k < 4; ++k) { const int task = tid + NTHR * k, tok = task >> 5, ch = task & 31; const int c = 1536 + 8 * ch; const size_t row = row0 + tok; const int t = tb + tok;
        cuw[k] = *(const GAS v4u*)(X.PRW + row * 1792 + c); prw[k] = *(const GAS v4u*)(X.PRW + (t > 0 ? row - 1 : row) * 1792 + c); }
#pragma unroll
    for (int k = 0; k < 4; ++k) { const int task = tid + NTHR * k, tok = task >> 5, ch = task & 31;
        const int c = 1536 + 8 * ch; const int t = tb + tok;
        float cu[8], pr[8]; unpack8(cuw[k], cu); unpack8(prw[k], pr);
        if (!(t > 0)) {
#pragma unroll
            for (int i = 0; i < 8; ++i) pr[i] = 0.f; }
        float o[8]; const f32x4 mu0 = *(const GAS f32x4*)(X.mu + c), mu1 = *(const GAS f32x4*)(X.mu + c + 4);
#pragma unroll
        for (int i = 0; i < 8; ++i) { const float xs = cu[i] + (pr[i] - cu[i]) * (i < 4 ? mu0[i & 3] : mu1[i & 3]);
            const float r = __builtin_amdgcn_rcpf(1.0f + __builtin_amdgcn_exp2f((ch < 8 ? 2.885390081777927f : -1.4426950408889634f) * xs));
            o[i] = ch < 8 ? 1.0f - 2.0f * r : (ch < 16 ? xs : r); }
        const v4u w = pack8(o);
        if (ch < 8) *(LAS v4u*)(TD + tok * LD64 + 16 * ch) = w; else if (ch < 16) *(LAS v4u*)(XA + tok * LD64 + 16 * (ch - 8)) = w; else *(LAS v4u*)(SG + tok * LD128 + 16 * (ch - 16)) = w; }
    WG_SYNC();
    const s16x4 Ic = pk4(4 * q4_ + 0 == r16_ ? 1.f : 0.f, 4 * q4_ + 1 == r16_ ? 1.f : 0.f, 4 * q4_ + 2 == r16_ ? 1.f : 0.f, 4 * q4_ + 3 == r16_ ? 1.f : 0.f);
    const f32x4 Z4 = (f32x4){0.f, 0.f, 0.f, 0.f};
    bf16x8 fw[2], fa[2], fg[4];
#define RW_LDF(ct_) do { const size_t rb_ = (size_t)(64 * wid + 16 * (ct_) + r16); \
        _Pragma("unroll") for (int ks = 0; ks < 2; ++ks) { fw[ks] = *(const GAS bf16x8*)(X.WupT + rb_ * 64 + ks * 32 + 8 * q4); fa[ks] = *(const GAS bf16x8*)(X.AupT + rb_ * 64 + ks * 32 + 8 * q4); } \
        _Pragma("unroll") for (int ks = 0; ks < 4; ++ks) fg[ks] = *(const GAS bf16x8*)(X.GupT + rb_ * 128 + ks * 32 + 8 * q4); } while (0)
    { const int r16 = r16_, q4 = q4_; RW_LDF(0); }
#pragma unroll 1
    for (int tt = 0; tt < 4; ++tt) {
        int r16 = r16_, q4 = q4_; asm volatile("" : "+v"(r16), "+v"(q4));
        const int tok = 16 * tt + r16; const size_t row = row0 + tok; const int t = tb + tok;
        unsigned char* rec = rw_record(X.ws, bat, wid, (tb >> 4) + tt);
        LDS_SYNC();
        for (int pc = wid; pc < 51; pc += NWAVES) { const int rr_ = pc / 3, pp_ = pc - 3 * rr_;
            __builtin_amdgcn_global_load_lds((const unsigned*)((const unsigned char*)X.PRW + ((long)row0 + 16 * tt - 1 + rr_) * 3584 + pp_ * 1024 + lane * 16), (LAS unsigned*)(RAW + rr_ * RW_RAWLD + pp_ * 1024), 16, 0, 0); }
        asm volatile("s_waitcnt vmcnt(0)" ::: "memory");
        LDS_SYNC();
        float ss = 0.f;
#pragma unroll
        for (int ct = 0; ct < 4; ++ct) { const int c0 = 64 * wid + 16 * ct + 4 * q4; float xk[4]; shift4_lds(RAW, PAR, r16, t, 1, c0, xk);
            const f32x4 kw = *(const LAS f32x4*)(PAR + 5 * 512 + c0);
#pragma unroll
            for (int i = 0; i < 4; ++i) { const float v = xk[i] * kw[i]; ss += v * v; } }
        ss += __shfl_xor(ss, 16); ss += __shfl_xor(ss, 32);
        const float invn = 1.0f / fmaxf(sqrtf(ss), 1e-12f);
        float bon = 0.f;
        s16x4 fA[4], fBi[4], fKi[4], fR[4];
        bf16x8 tbd[2], tba[2], tbg[4];
#pragma unroll
        for (int ks = 0; ks < 2; ++ks) { tbd[ks] = *(const LAS bf16x8*)(TD + tok * LD64 + (ks * 32 + 8 * q4) * 2); tba[ks] = *(const LAS bf16x8*)(XA + tok * LD64 + (ks * 32 + 8 * q4) * 2); }
#pragma unroll
        for (int ks = 0; ks < 4; ++ks) tbg[ks] = *(const LAS bf16x8*)(SG + tok * LD128 + (ks * 32 + 8 * q4) * 2);
#pragma unroll
        for (int ct = 0; ct < 4; ++ct) {
            const int cb = 64 * wid + 16 * ct, c0 = cb + 4 * q4;
            f32x4 cw = Z4, ca = Z4, cg = Z4;
#pragma unroll
            for (int ks = 0; ks < 2; ++ks) { cw = mfma32(fw[ks], tbd[ks], cw); ca = mfma32(fa[ks], tba[ks], ca); }
#pragma unroll
            for (int ks = 0; ks < 4; ++ks) cg = mfma32(fg[ks], tbg[ks], cg);
            asm volatile("" : "+v"(cw), "+v"(ca), "+v"(cg));
            RW_LDF((ct + 1) & 3);
            const f32x4 w0v = *(const LAS f32x4*)(PAR + 3 * 512 + c0), a0v = *(const LAS f32x4*)(PAR + 4 * 512 + c0), kaw = *(const LAS f32x4*)(PAR + 6 * 512 + c0), rkw = *(const LAS f32x4*)(PAR + 7 * 512 + c0), kw = *(const LAS f32x4*)(PAR + 5 * 512 + c0);
            float xr[4], xk[4], xv[4]; shift4_lds(RAW, PAR, r16, t, 0, c0, xr); shift4_lds(RAW, PAR, r16, t, 1, c0, xk); shift4_lds(RAW, PAR, r16, t, 2, c0, xv);
            { v2u w; w.x = pk2(cg[0], cg[1]); w.y = pk2(cg[2], cg[3]); *(GAS v2u*)(X.G + row * 512 + c0) = w; }
            { const f32x4 vc = mfma16(pk4(xv[0], xv[1], xv[2], xv[3]), Ic, Z4); *(GAS s16x4*)(rec + RWO_VC + 512 * ct + lane * 8) = pk4v(vc); }
            float pa[4], pbi[4], pki[4], pr[4], pbh[4], pkh[4]; f32x4 g15;
#pragma unroll
            for (int i = 0; i < 4; ++i) { const float z = w0v[i] + cw[i];
                const float e = fexp(log_sigmoid(z) - 0.5f);
                const float a = fsig(a0v[i] + ca[i]);
                const float kkv = xk[i] * kw[i] * invn, khv = xk[i] * (1.0f + (a - 1.0f) * kaw[i]), bbv = kkv * a;
                bon += xr[i] * khv * rkw[i];
                const float cs = row16_scan(e), tot = row16_sum(e);
                const float gp = fexp(-(cs - e)), gi = fexp(cs), gt = fexp(-cs), gl = fexp(cs - tot);
                pa[i] = -kkv * gp; pbi[i] = bbv * gi; pki[i] = khv * gi; pr[i] = xr[i] * gt; pbh[i] = bbv * gl; pkh[i] = khv * gl; g15[i] = fexp(-tot); }
            fA[ct] = pk4(pa[0], pa[1], pa[2], pa[3]); fBi[ct] = pk4(pbi[0], pbi[1], pbi[2], pbi[3]); fKi[ct] = pk4(pki[0], pki[1], pki[2], pki[3]);
            fR[ct] = pk4(pr[0], pr[1], pr[2], pr[3]);
            { const s16x4 bhc = pk4v(mfma16(pk4(pbh[0], pbh[1], pbh[2], pbh[3]), Ic, Z4)), khc = pk4v(mfma16(pk4(pkh[0], pkh[1], pkh[2], pkh[3]), Ic, Z4));
              *(GAS bf16x8*)(rec + RWO_FS + 1024 * ct + lane * 16) = cat8(bhc, khc); }
            if (r16 == 0) *(GAS f32x4*)(rec + RWO_G + (16 * ct + 4 * q4) * 4) = g15;
        }
        bon += __shfl_xor(bon, 16); bon += __shfl_xor(bon, 32);
        if (q4 == 0) X.bonus[row * 8 + wid] = bon;
        f32x4 nA = Z4, nC = Z4, mkaA = Z4, mkaC = Z4, mbrA = Z4, mkrA = Z4;
#pragma unroll
        for (int ks = 0; ks < 2; ++ks) { const bf16x8 a8 = cat8(fA[2 * ks], fA[2 * ks + 1]), bi8 = cat8(fBi[2 * ks], fBi[2 * ks + 1]), ki8 = cat8(fKi[2 * ks], fKi[2 * ks + 1]), r8 = cat8(fR[2 * ks], fR[2 * ks + 1]);
            nA = mfma32(bi8, a8, nA); nC = mfma32(a8, bi8, nC); mkaA = mfma32(ki8, a8, mkaA); mkaC = mfma32(a8, ki8, mkaC); mbrA = mfma32(bi8, r8, mbrA); mkrA = mfma32(ki8, r8, mkrA); }
#pragma unroll
        for (int j = 0; j < 4; ++j) { const int o = 4 * q4 + j;
            if (!(o < r16)) { nA[j] = 0.f; mkaA[j] = 0.f; } if (!(r16 < o)) { nC[j] = 0.f; mkaC[j] = 0.f; } if (!(o <= r16)) { mbrA[j] = 0.f; mkrA[j] = 0.f; } }
        s16x4 Ta;
        { const s16x4 Na = pk4v(nA), Nc = pk4v(nC);
          const f32x4 n2c = mfma16(Na, Nc, Z4), n2a = mfma16(Nc, Na, Z4); const s16x4 N2a = pk4v(n2a), N2c = pk4v(n2c);
          const f32x4 n4c = mfma16(N2a, N2c, Z4), n4a = mfma16(N2c, N2a, Z4); const s16x4 N4a = pk4v(n4a), N4c = pk4v(n4c);
          const f32x4 n8c = mfma16(N4a, N4c, Z4);
          f32x4 f0 = nA, f1 = n2c, f2 = n4c, f3 = n8c;
#pragma unroll
          for (int j = 0; j < 4; ++j) if (4 * q4 + j == r16) { f0[j] += 1.f; f1[j] += 1.f; f2[j] += 1.f; f3[j] += 1.f; }
          const f32x4 p1 = mfma16(pk4v(f1), pk4v(f0), Z4);
          const f32x4 p2 = mfma16(pk4v(f2), pk4v(p1), Z4);
          const f32x4 p3 = mfma16(pk4v(f3), pk4v(p2), Z4);
          Ta = pk4v(p3); }
        const s16x4 MbrA = pk4v(mbrA), MkaC = pk4v(mkaC);
        { const f32x4 w2a = mfma16(MkaC, Ta, Z4), w2c = mfma16(Ta, MkaC, Z4);
          const f32x4 w4a = mfma16(pk4v(w2c), MbrA, mkrA);
          *(GAS s16x4*)(rec + RWO_W2 + lane * 8) = pk4v(w2a); *(GAS s16x4*)(rec + RWO_W4 + lane * 8) = pk4v(w4a); }
        s16x4 w1a[4], w3a[4];
#pragma unroll
        for (int ct = 0; ct < 4; ++ct) { const s16x4 Ac = pk4v(mfma16(fA[ct], Ic, Z4));
            const f32x4 x1a = mfma16(Ac, Ta, Z4), x1c = mfma16(Ta, Ac, Z4);
            f32x4 r0; { const v2u w = __builtin_bit_cast(v2u, fR[ct]); r0[0] = bflo(w.x); r0[1] = bfhi(w.x); r0[2] = bflo(w.y); r0[3] = bfhi(w.y); }
            const f32x4 x3a = mfma16(pk4v(x1c), MbrA, r0);
            w1a[ct] = pk4v(x1a); w3a[ct] = pk4v(x3a); }
#pragma unroll
        for (int ks = 0; ks < 2; ++ks) { *(GAS bf16x8*)(rec + RWO_FU + 1024 * ks + lane * 16) = cat8(w1a[2 * ks], w1a[2 * ks + 1]); *(GAS bf16x8*)(rec + RWO_FY + 1024 * ks + lane * 16) = cat8(w3a[2 * ks], w3a[2 * ks + 1]); }
    }
#undef RW_LDF
}
__device__ __forceinline__ void rwkv_scan(const RwArgs& X, const Ctx& C) {
    constexpr int SLOT = 12288, RING = 8, AHEAD = 6;
    const int lane = C.lane, q4 = lane >> 4, r16 = lane & 15, wid = C.wid;
    for (int v = C.vb; v < 256; v += C.G) { if ((v & 31) >= 8) continue; const int b = v >> 5, h = v & 31;
        const unsigned char* rec0 = rw_record(X.ws, b, h, 0);
        __syncthreads();
        if (wid >= 4) {
            const int lw = wid - 4;
#define RW_DMA(c_) do { const unsigned char* r_ = rec0 + (size_t)(c_) * RW_REC; LAS unsigned char* s_ = C.lds + ((c_) & (RING - 1)) * SLOT; \
                _Pragma("unroll") for (int p_ = 0; p_ < 3; ++p_) __builtin_amdgcn_global_load_lds((const unsigned*)(r_ + (lw + 4 * p_) * 1024 + lane * 16), (LAS unsigned*)(s_ + (lw + 4 * p_) * 1024), 16, 0, 0); } while (0)
            for (int c = 0; c < AHEAD; ++c) RW_DMA(c);
            for (int c = 0; c < 256; ++c) {
                if (c + AHEAD < 256) { RW_DMA(c + AHEAD); asm volatile("s_waitcnt vmcnt(18)" ::: "memory"); }
                else asm volatile("s_waitcnt vmcnt(0)" ::: "memory");
                __builtin_amdgcn_s_barrier();
            }
#undef RW_DMA
        } else {
            const int rg = wid;
            f32x4 S[4];
#pragma unroll
            for (int i = 0; i < 4; ++i) S[i] = (f32x4){0.f, 0.f, 0.f, 0.f};
            for (int c = 0; c < 256; ++c) {
                asm volatile("s_waitcnt lgkmcnt(0)" ::: "memory");
                __builtin_amdgcn_s_barrier();
                asm volatile("" ::: "memory");
                const LAS unsigned char* r = C.lds + (c & (RING - 1)) * SLOT;
                const bf16x8 fu0 = *(const LAS bf16x8*)(r + RWO_FU + lane * 16), fu1 = *(const LAS bf16x8*)(r + RWO_FU + 1024 + lane * 16);
                const bf16x8 fy0 = *(const LAS bf16x8*)(r + RWO_FY + lane * 16), fy1 = *(const LAS bf16x8*)(r + RWO_FY + 1024 + lane * 16);
                const bf16x8 fs0 = *(const LAS bf16x8*)(r + RWO_FS + lane * 16), fs1 = *(const LAS bf16x8*)(r + RWO_FS + 1024 + lane * 16), fs2 = *(const LAS bf16x8*)(r + RWO_FS + 2048 + lane * 16), fs3 = *(const LAS bf16x8*)(r + RWO_FS + 3072 + lane * 16);
                const s16x4 w2 = *(const LAS s16x4*)(r + RWO_W2 + lane * 8), w4 = *(const LAS s16x4*)(r + RWO_W4 + lane * 8), vc = *(const LAS s16x4*)(r + RWO_VC + 512 * rg + lane * 8);
                const f32x4 g0 = *(const LAS f32x4*)(r + RWO_G + (4 * q4) * 4), g1 = *(const LAS f32x4*)(r + RWO_G + (16 + 4 * q4) * 4), g2 = *(const LAS f32x4*)(r + RWO_G + (32 + 4 * q4) * 4), g3 = *(const LAS f32x4*)(r + RWO_G + (48 + 4 * q4) * 4);
                const bf16x8 s0 = cat8(pk4v(S[0]), pk4v(S[1])), s1 = cat8(pk4v(S[2]), pk4v(S[3]));
                f32x4 U = mfma16(w2, vc, (f32x4){0.f, 0.f, 0.f, 0.f}); U = mfma32(fu0, s0, U); U = mfma32(fu1, s1, U);
                f32x4 Y = mfma16(w4, vc, (f32x4){0.f, 0.f, 0.f, 0.f}); Y = mfma32(fy0, s0, Y); Y = mfma32(fy1, s1, Y);
                const bf16x8 uv = cat8(pk4v(U), vc);
                S[0] = mfma32(fs0, uv, S[0] * g0); S[1] = mfma32(fs1, uv, S[1] * g1); S[2] = mfma32(fs2, uv, S[2] * g2); S[3] = mfma32(fs3, uv, S[3] * g3);
                float* yp = X.yraw + ((size_t)b * T + (size_t)c * 16 + 4 * q4) * 512 + h * 64 + 16 * rg + r16;
                yp[0] = Y[0]; yp[512] = Y[1]; yp[1024] = Y[2]; yp[1536] = Y[3];
            }
        }
    }
}
__device__ __forceinline__ void rwkv_finish(const RwArgs& X, const Ctx& C) {
    const int gw = C.bid * NWAVES + C.wid, NGW = C.G * NWAVES, lane = C.lane, c = 8 * lane;
    float lg[8], lb[8], mv[8];
#pragma unroll
    for (int i = 0; i < 8; ++i) { lg[i] = X.lng[c + i]; lb[i] = X.lnb[c + i]; mv[i] = X.mu[1024 + c + i]; }
    const int rpw = M / C.G, mb = C.vb * rpw;
    for (int i0 = C.wid; i0 < rpw; i0 += 2 * NWAVES) { const int m0 = mb + i0;
        f32x4 yl[2][2]; v4u vw[2], pw[2], gw4[2]; float bsr[2];
#pragma unroll
        for (int r = 0; r < 2; ++r) { const int m = (i0 + r * NWAVES < rpw) ? m0 + r * NWAVES : m0; const size_t o = (size_t)m * 512 + c;
            yl[r][0] = *(const GAS f32x4*)(X.yraw + o); yl[r][1] = *(const GAS f32x4*)(X.yraw + o + 4);
            vw[r] = *(const GAS v4u*)(X.PRW + (size_t)m * 1792 + 1024 + c);
            { const bool hp = (m & (T - 1)) != 0; pw[r] = *(const GAS v4u*)(X.PRW + (size_t)(hp ? m - 1 : m) * 1792 + 1024 + c); if (!hp) pw[r] = (v4u){0u, 0u, 0u, 0u}; }
            gw4[r] = *(const GAS v4u*)(X.G + o); bsr[r] = X.bonus[(size_t)m * 8 + (lane >> 3)]; }
#pragma unroll
        for (int r = 0; r < 2; ++r) { const int m = m0 + r * NWAVES; if (i0 + r * NWAVES >= rpw) break;
            float y[8] = {yl[r][0][0], yl[r][0][1], yl[r][0][2], yl[r][0][3], yl[r][1][0], yl[r][1][1], yl[r][1][2], yl[r][1][3]}, v[8], pv[8], g[8];
            unpack8(vw[r], v); unpack8(pw[r], pv); unpack8(gw4[r], g); const float bs = bsr[r];
            float sm = 0.f;
#pragma unroll
            for (int i = 0; i < 8; ++i) { sm += y[i]; v[i] = v[i] + (pv[i] - v[i]) * mv[i]; }
            sm += __shfl_xor(sm, 1); sm += __shfl_xor(sm, 2); sm += __shfl_xor(sm, 4);
            const float mean = sm * (1.0f / 64.0f); float vs = 0.f;
#pragma unroll
            for (int i = 0; i < 8; ++i) { y[i] -= mean; vs += y[i] * y[i]; }
            vs += __shfl_xor(vs, 1); vs += __shfl_xor(vs, 2); vs += __shfl_xor(vs, 4);
            const float rinv = __builtin_amdgcn_rsqf(vs * (1.0f / 64.0f) + 64e-5f);
            float ov[8];
#pragma unroll
            for (int i = 0; i < 8; ++i) ov[i] = (y[i] * rinv * lg[i] + lb[i] + bs * v[i]) * g[i];
            *(GAS v4u*)(X.out + (size_t)m * 1024 + 512 + c) = pack8(ov); } }
}

__device__ __forceinline__ void route_tokens(const Args& A, const Ctx& C) {
    unsigned char* rt = A.ws + WS_ROUTE;
    int* e01 = (int*)(rt + RT_E01); float* w0a = (float*)(rt + RT_W0); float* rsa = (float*)(rt + RT_RS); int* cnt = (int*)(rt + RT_CNT);
    LAS float* Rg = (LAS float*)C.lds;
    LAS int* lcnt = (LAS int*)(C.lds + 32768);
    const float* h = A.out; const float* rw = A.in[I_ROUTER]; const float* g2 = A.in[I_ON2G];
    WG_SYNC();
    for (int i = C.tid; i < 8192; i += NTHR) Rg[(i & 7) * 1024 + (i >> 3)] = rw[i] * g2[i >> 3];
    for (int blk = C.vb; blk < 256; blk += C.G) {
        if (C.tid < 8) lcnt[C.tid] = 0;
        WG_SYNC();
        f32x4 xn[4]; { const GAS f32x4* xr0 = (const GAS f32x4*)(h + (size_t)(blk * 128 + C.wid * 16) * D) + C.lane;
#pragma unroll
            for (int j = 0; j < 4; ++j) xn[j] = xr0[64 * j]; }
        int res_e = 0; float res_w = 0.f, res_r = 0.f;
        for (int k = 0; k < 16; ++k) { const int m = blk * 128 + C.wid * 16 + k;
            f32x4 xc[4];
#pragma unroll
            for (int j = 0; j < 4; ++j) xc[j] = xn[j];
            if (k + 1 < 16) { const GAS f32x4* xr1 = (const GAS f32x4*)(h + (size_t)(m + 1) * D) + C.lane;
#pragma unroll
                for (int j = 0; j < 4; ++j) xn[j] = xr1[64 * j]; }
            float ss = 0.f; float lg[8];
#pragma unroll
            for (int e = 0; e < 8; ++e) lg[e] = 0.f;
#pragma unroll
            for (int j = 0; j < 4; ++j) { const f32x4 v = xc[j]; ss += (v[0] * v[0] + v[1] * v[1]) + (v[2] * v[2] + v[3] * v[3]);
#pragma unroll
                for (int e = 0; e < 8; ++e) { const f32x4 r = *(const LAS f32x4*)(Rg + e * 1024 + 4 * C.lane + 256 * j); lg[e] += (v[0] * r[0] + v[1] * r[1]) + (v[2] * r[2] + v[3] * r[3]); } }
            ss = wave_sum(ss);
#pragma unroll
            for (int e = 0; e < 8; ++e) lg[e] = wave_sum(lg[e]);
            const float rs = 1.0f / sqrtf(ss * (1.0f / 1024.0f) + 1e-6f);
            int b0 = 0; float v0 = lg[0];
#pragma unroll
            for (int e = 1; e < 8; ++e) if (lg[e] > v0) { v0 = lg[e]; b0 = e; }
            int b1 = (b0 + 1) & 7; float v1 = -3.0e38f;
#pragma unroll
            for (int e = 0; e < 8; ++e) if (e != b0 && lg[e] > v1) { v1 = lg[e]; b1 = e; }
            if (C.lane == k) { res_e = b0 | (b1 << 8); res_w = 1.0f / (1.0f + expf((v1 - v0) * rs)); res_r = rs; }
            if (C.lane == 0) { atomicAdd((int*)&lcnt[b0], 1); atomicAdd((int*)&lcnt[b1], 1); } }
        if (C.lane < 16) { const int m = blk * 128 + C.wid * 16 + C.lane; e01[m] = res_e; w0a[m] = res_w; rsa[m] = res_r; }
        WG_SYNC();
        if (C.tid < 8) cnt[blk * 8 + C.tid] = lcnt[C.tid];
        WG_SYNC();
    }
}
__device__ __forceinline__ void route_gather(const Args& A, const Ctx& C) {
    unsigned char* rt = A.ws + WS_ROUTE;
    const int* e01 = (const int*)(rt + RT_E01); const float* rsa = (const float*)(rt + RT_RS); const int* cnt = (const int*)(rt + RT_CNT);
    int* pos0 = (int*)(rt + RT_POS0); int* pos1 = (int*)(rt + RT_POS1); float* rsg = (float*)(rt + RT_RSG); int* tile_e = (int*)(rt + RT_TILE_E); int* meta = (int*)(rt + RT_META);
    const bf16* hb = (const bf16*)(A.ws + WS_HBG); unsigned char* xg = A.ws + WS_XG8;
    LAS int* sh = (LAS int*)C.lds;
    WG_SYNC();
    for (int blk = C.vb; blk < 256; blk += C.G) {
        if (C.tid < 24) sh[C.tid] = 0;
        WG_SYNC();
        { int cv[4];
#pragma unroll
          for (int j = 0; j < 4; ++j) cv[j] = cnt[C.tid + NTHR * j];
          int tot = 0, before = 0;
#pragma unroll
          for (int j = 0; j < 4; ++j) { tot += cv[j]; if ((C.tid >> 3) + 64 * j < blk) before += cv[j]; }
          atomicAdd((int*)&sh[C.tid & 7], tot); atomicAdd((int*)&sh[16 + (C.tid & 7)], before); }
        WG_SYNC();
        if (C.tid == 0) { int s = 0; for (int e = 0; e < 8; ++e) { sh[8 + e] = s; s += (sh[e] + 255) & ~255; }
            if (blk == 0) { meta[0] = s / 256; int t = 0; for (int e = 0; e < 8; ++e) { const int nt = (sh[e] + 255) / 256; for (int i = 0; i < nt; ++i) tile_e[t++] = e; } for (; t < MOE_TILES + 8; ++t) tile_e[t] = 0; } }
        WG_SYNC();
        int my0 = 0, my1 = 0;
        if (C.tid < 128) { const int m = blk * 128 + C.tid; const int ee = e01[m]; const int b0 = ee & 255, b1 = ee >> 8;
            for (int e = 0; e < 8; ++e) { const bool has = (b0 == e) || (b1 == e); const unsigned long long bal = __ballot(has);
                const int below = __popcll(bal & ((1ull << C.lane) - 1ull)); const int wtot = __popcll(bal);
                if (C.lane == 0) sh[512 + C.wid * 8 + e] = wtot;
                if (b0 == e) my0 = below; if (b1 == e) my1 = below; } }
        WG_SYNC();
        if (C.tid < 128) { const int m = blk * 128 + C.tid; const int ee = e01[m]; const int b0 = ee & 255, b1 = ee >> 8;
            const int p0 = sh[8 + b0] + sh[16 + b0] + (C.wid == 1 ? sh[512 + b0] : 0) + my0, p1 = sh[8 + b1] + sh[16 + b1] + (C.wid == 1 ? sh[512 + b1] : 0) + my1;
            pos0[m] = p0; pos1[m] = p1; sh[32 + 2 * C.tid] = p0; sh[32 + 2 * C.tid + 1] = p1; const float rs = rsa[m]; rsg[p0] = rs; rsg[p1] = rs; }
        WG_SYNC();
        for (int k = 0; k < 32; k += 4) { v4u t0[4], t1[4];
#pragma unroll
            for (int q = 0; q < 4; ++q) { const int s = C.wid * 32 + k + q, m = blk * 128 + (s >> 1); const GAS v4u* src = (const GAS v4u*)(hb + (size_t)m * D) + C.lane; t0[q] = src[0]; t1[q] = src[64]; }
#pragma unroll
            for (int q = 0; q < 4; ++q) { const int p = sh[32 + C.wid * 32 + k + q]; GAS v2u* dst = (GAS v2u*)(xg + (size_t)p * D) + C.lane; const v4u a = t0[q], b = t1[q]; v2u oa, ob;
                oa.x = pg8::pk4f8(bflo(a.x), bfhi(a.x), bflo(a.y), bfhi(a.y)); oa.y = pg8::pk4f8(bflo(a.z), bfhi(a.z), bflo(a.w), bfhi(a.w));
                ob.x = pg8::pk4f8(bflo(b.x), bfhi(b.x), bflo(b.y), bfhi(b.y)); ob.y = pg8::pk4f8(bflo(b.z), bfhi(b.z), bflo(b.w), bfhi(b.w));
                dst[0] = oa; dst[64] = ob; } }
        WG_SYNC();
    }
}
__device__ __forceinline__ void final_combine(const Args& A, const Ctx& C) {
    unsigned char* rt = A.ws + WS_ROUTE;
    const float* w0a = (const float*)(rt + RT_W0); const int* pos0 = (const int*)(rt + RT_POS0); const int* pos1 = (const int*)(rt + RT_POS1);
    const bf16* y = (const bf16*)(A.ws + WS_XG); const float* fg = A.in[I_FNG]; float* out = A.out;
    const int gw = C.bid * NWAVES + C.wid, NGW = C.G * NWAVES;
    f32x4 gv[4];
#pragma unroll
    for (int j = 0; j < 4; ++j) gv[j] = *(const GAS f32x4*)(fg + 4 * C.lane + 256 * j);
    const int rpw = M / C.G, mb = C.vb * rpw;
    for (int i0 = C.wid; i0 < rpw; i0 += 2 * NWAVES) { const int m0 = mb + i0;
        f32x4 hv[2][4]; v2u ya[2][4], yb[2][4]; float w0r[2];
#pragma unroll
        for (int r = 0; r < 2; ++r) { const int m = (i0 + r * NWAVES < rpw) ? m0 + r * NWAVES : m0; w0r[r] = w0a[m]; const int p0 = pos0[m], p1 = pos1[m];
            const GAS f32x4* hr = (const GAS f32x4*)(out + (size_t)m * D) + C.lane; const GAS v2u* y0 = (const GAS v2u*)(y + (size_t)p0 * D) + C.lane; const GAS v2u* y1 = (const GAS v2u*)(y + (size_t)p1 * D) + C.lane;
#pragma unroll
            for (int j = 0; j < 4; ++j) { hv[r][j] = hr[64 * j]; ya[r][j] = y0[64 * j]; yb[r][j] = y1[64 * j]; } }
#pragma unroll
        for (int r = 0; r < 2; ++r) { const int m = m0 + r * NWAVES; if (i0 + r * NWAVES >= rpw) break; const float w0 = w0r[r], w1 = 1.0f - w0; f32x4 v[4]; float ss = 0.f;
#pragma unroll
            for (int j = 0; j < 4; ++j) { const f32x4 h4 = hv[r][j]; const v2u a = ya[r][j], b = yb[r][j];
                f32x4 o; o[0] = h4[0] + w0 * bflo(a.x) + w1 * bflo(b.x); o[1] = h4[1] + w0 * bfhi(a.x) + w1 * bfhi(b.x); o[2] = h4[2] + w0 * bflo(a.y) + w1 * bflo(b.y); o[3] = h4[3] + w0 * bfhi(a.y) + w1 * bfhi(b.y);
                v[j] = o; ss += (o[0] * o[0] + o[1] * o[1]) + (o[2] * o[2] + o[3] * o[3]); }
            ss = wave_sum(ss); const float rs = 1.0f / sqrtf(ss * (1.0f / 1024.0f) + 1e-6f);
            GAS f32x4* hw = (GAS f32x4*)(out + (size_t)m * D) + C.lane;
#pragma unroll
            for (int j = 0; j < 4; ++j) hw[64 * j] = v[j] * rs * gv[j]; } }
}

#ifndef MK_SPLIT
#define MK_SPLIT 0
#endif
constexpr int N_PHASES = 17;
#ifndef WGM_WIDE
#define WGM_WIDE 4
#endif
#ifndef WGM_NARROW
#define WGM_NARROW 4
#endif
#ifndef P2_ML
#define P2_ML 4
#endif
#ifndef MOEW_REP
#define MOEW_REP 1
#endif
#ifndef PROBE_REPEAT
#define PROBE_REPEAT 0u
#endif
#ifndef PROBE_SKIP
#define PROBE_SKIP 0u
#endif
#define NREP(k) ((((unsigned)(PROBE_SKIP)) >> (k)) & 1u ? 0 : ((((unsigned)(PROBE_REPEAT)) >> (k)) & 1u ? 2 : 1))
__device__ __forceinline__ int seg4(int s) { return s <= 0 ? 0 : s == 1 ? 25 : s == 2 ? 42 : s == 3 ? 55 : 64; }
__device__ __forceinline__ int seg4g(int s) { return s <= 0 ? 0 : s == 1 ? 25 : s == 2 ? 42 : s == 3 ? 55 : 64; }
__device__ __forceinline__ int seg8(int s) { return s <= 0 ? 0 : s == 1 ? 20 : s == 2 ? 34 : s == 3 ? 44 : s == 4 ? 51 : s == 5 ? 56 : s == 6 ? 60 : s == 7 ? 62 : 64; }

__global__ void __launch_bounds__(NTHR, 2) fwd_kernel(Args args) {
    extern __shared__ __attribute__((aligned(16))) unsigned char lds_raw[];
    Ctx C; C.lds = (LAS unsigned char*)lds_raw; C.tid = threadIdx.x; C.lane = C.tid & 63; C.wid = __builtin_amdgcn_readfirstlane(C.tid >> 6); C.G = gridDim.x; C.bid = blockIdx.x; C.vb = (C.G == 256) ? ((C.bid & 7) * 32 + (C.bid >> 3)) : C.bid;
    volatile LAS unsigned* MISC = (volatile LAS unsigned*)(C.lds + MISC_OFF);
    for (int u = C.tid; u < (LDS_BYTES - LDSCTL_OFF) / 4; u += NTHR) ((LAS unsigned*)(C.lds + LDSCTL_OFF))[u] = 0u;
    __syncthreads();
    unsigned char* ws = args.ws;
    XcdBarrier bar = xcd_barrier_post((unsigned*)(ws + WS_CTL) + CW_BAR, MISC + 8, (unsigned)C.wid);
    const int lo = args.ph_lo, hi = args.ph_hi;
#define IN(k) (lo <= (k) && (k) < hi)
#define PHASE_TID() do { int t_ = C.wid * 64 + (int)xb_lane_id(); C.tid = t_; C.lane = t_ & 63; } while (0)
#define SEAM(k) do { if (IN(k) && IN((k) + 1)) xcd_barrier(bar); } while (0)
    float* ssp = (float*)(ws + WS_SSP);
    bf16* HB0 = (bf16*)(ws + WS_HB0); bf16* HB1 = (bf16*)(ws + WS_HB1); bf16* RP = (bf16*)(ws + WS_RP);

    if (IN(0)) for (int rep_ = 0; rep_ < NREP(0); ++rep_) { if (rep_) WG_SYNC(); PHASE_TID(); p0_prologue(args, C); } SEAM(0);
#ifdef XBAR_EXTRA
    for (int q_ = 0; q_ < XBAR_EXTRA; ++q_) xcd_barrier(bar);
#endif
    if (IN(1)) for (int rep_ = 0; rep_ < NREP(1); ++rep_) { if (rep_) WG_SYNC(); PHASE_TID(); pg8::Gemm g{HB0, (const bf16*)(ws + WS_W_EIN), M, PW, D}; pg8::StaticOrder S; S.init(M, PW, C.G, C.bid, WGM_WIDE, 2);
        pg8::EpiProj E{RP, PW, RP, PW, 1 << 30, ssp};
        pg8::gemm_phase<pg8::EpiProj, pg8::StaticOrder, true, true>(C.lds, g, S, E, C.tid); } SEAM(1);
    if (IN(2)) for (int rep_ = 0; rep_ < NREP(2); ++rep_) { if (rep_) WG_SYNC(); PHASE_TID(); MixArgs X{}; X.P = RP; X.pitch = PW; X.out = HB1; X.convw = args.in[I_CONVW]; X.convb = args.in[I_CONVB]; X.gateb = args.in[I_GATEB]; X.gup = args.in[I_GLAUP]; X.gb = args.in[I_GLAB];
        for (int pass = 0; pass < 2; ++pass) { int late_j = -1;
            for (int u = C.vb; u < 256; u += C.G) { const int bb = u >> 5, r = u & 31;
                if (r < 4 * P2_ML) { const int hh = r / P2_ML, sg = r - P2_ML * hh; X.normg = args.in[I_MLNG]; X.snap = (float*)(ws + WS_RX); if (pass == 1 || sg < P2_ML - 1) mixer_unit<0>(X, C, bb, hh, sg, P2_ML, pass); else late_j = bb * 8 + hh; }
                else { const int v = r - 4 * P2_ML, hh = v / (8 - P2_ML), sg = v - (8 - P2_ML) * hh; X.normg = args.in[I_GLANG]; X.snap = (float*)(ws + WS_RX + 16 * MiB); if (pass == 1 || sg < 7 - P2_ML) mixer_unit<1>(X, C, bb, hh, sg, 8 - P2_ML, pass); else late_j = bb * 8 + 4 + hh; } }
            if (pass == 0 && C.G == 256 && late_j >= 0) { WG_SYNC(); layer_weights_late(args, C, late_j * NWAVES + C.wid, 64 * NWAVES); }
            if (pass == 0) xcd_barrier(bar); } } SEAM(2);
    if (IN(3)) for (int rep_ = 0; rep_ < NREP(3); ++rep_) { if (rep_) WG_SYNC(); PHASE_TID(); pg8::Gemm g{HB1, (const bf16*)(ws + WS_W_EOUT), M, D, D}; pg8::StaticOrder S; S.init(M, D, C.G, C.bid, WGM_NARROW, 1);
#if FFN8_UP
        pg8::EpiResidT<true> E{args.in[I_X], args.out, HB0, ssp, 1.0f};
        pg8::gemm_phase<pg8::EpiResidT<true>, pg8::StaticOrder, true, true>(C.lds, g, S, E, C.tid); } SEAM(3);
#else
        pg8::EpiResid E{args.in[I_X], args.out, HB0, ssp, 1.0f};
        pg8::gemm_phase<pg8::EpiResid, pg8::StaticOrder, true, true>(C.lds, g, S, E, C.tid); } SEAM(3);
#endif
#if FFN8_UP
    if (IN(4)) for (int rep_ = 0; rep_ < NREP(4); ++rep_) { if (rep_) WG_SYNC(); PHASE_TID(); int k8 = D / 2; asm volatile("" : "+s"(k8)); pg8::Gemm g{HB0, (const bf16*)(ws + WS_W_FGU), M, 2 * FF, k8}; pg8::StaticOrder S; S.init(M, 2 * FF, C.G, C.bid, WGM_WIDE, 2);
#if FFN8_UP == 2
        pg8::EpiSwiGLU8T<false, true> E{(unsigned char*)RP, FF, ssp, 1.0f / 256.0f};
        pg8::gemm_phase<pg8::EpiSwiGLU8T<false, true>, pg8::StaticOrder, true, true, true>(C.lds, g, S, E, C.tid); } SEAM(4);
    if (IN(5)) for (int rep_ = 0; rep_ < NREP(5); ++rep_) { if (rep_) WG_SYNC(); PHASE_TID(); int k8 = FF / 2; asm volatile("" : "+s"(k8)); pg8::Gemm g{RP, (const bf16*)(ws + WS_W_FDN), M, D, k8}; pg8::StaticOrder S; S.init(M, D, C.G, C.bid, WGM_NARROW, 1);
        pg8::EpiResid E{args.out, args.out, HB0, ssp, 1.0f / 4096.0f};
        pg8::gemm_phase<pg8::EpiResid, pg8::StaticOrder, true, true, true>(C.lds, g, S, E, C.tid); } SEAM(5);
#else
        pg8::EpiSwiGLU8T<false, false> E{(unsigned char*)RP, FF, ssp, 1.0f / 256.0f};
        pg8::gemm_phase<pg8::EpiSwiGLU8T<false, false>, pg8::StaticOrder, true, true, true>(C.lds, g, S, E, C.tid); } SEAM(4);
    if (IN(5)) for (int rep_ = 0; rep_ < NREP(5); ++rep_) { if (rep_) WG_SYNC(); PHASE_TID(); pg8::Gemm g{RP, (const bf16*)(ws + WS_W_FDN), M, D, FF}; pg8::StaticOrder S; S.init(M, D, C.G, C.bid, WGM_NARROW, 1);
        pg8::EpiResid E{args.out, args.out, HB0, ssp, 1.0f};
        pg8::gemm_phase<pg8::EpiResid, pg8::StaticOrder, true, true>(C.lds, g, S, E, C.tid); } SEAM(5);
#endif
#else
    if (IN(4)) for (int rep_ = 0; rep_ < NREP(4); ++rep_) { if (rep_) WG_SYNC(); PHASE_TID(); pg8::Gemm g{HB0, (const bf16*)(ws + WS_W_FGU), M, 2 * FF, D}; pg8::StaticOrder S; S.init(M, 2 * FF, C.G, C.bid, WGM_WIDE, 2);
        pg8::EpiSwiGLU8T<false> E{(unsigned char*)RP, FF, ssp, 1.0f};
        pg8::gemm_phase<pg8::EpiSwiGLU8T<false>, pg8::StaticOrder, true, true>(C.lds, g, S, E, C.tid); } SEAM(4);
    if (IN(5)) for (int rep_ = 0; rep_ < NREP(5); ++rep_) { if (rep_) WG_SYNC(); PHASE_TID(); int k8 = FF / 2; asm volatile("" : "+s"(k8)); pg8::Gemm g{RP, (const bf16*)(ws + WS_W_FDN), M, D, k8}; pg8::StaticOrder S; S.init(M, D, C.G, C.bid, WGM_NARROW, 1);
        pg8::EpiResid E{args.out, args.out, HB0, ssp, 1.0f / 4096.0f};
        pg8::gemm_phase<pg8::EpiResid, pg8::StaticOrder, true, true, true>(C.lds, g, S, E, C.tid); } SEAM(5);
#endif
    if (IN(6)) for (int rep_ = 0; rep_ < NREP(6); ++rep_) { if (rep_) WG_SYNC(); PHASE_TID(); pg8::Gemm g{HB0, (const bf16*)(ws + WS_W_OIN), M, PW, D}; pg8::StaticOrder S; S.init(M, PW, C.G, C.bid, WGM_WIDE, 2);
        pg8::EpiProj E{(bf16*)(ws + WS_PRET), 2048, (bf16*)(ws + WS_PRW), 1792, 8, ssp};
        pg8::gemm_phase<pg8::EpiProj, pg8::StaticOrder, true, true>(C.lds, g, S, E, C.tid); } SEAM(6);
    if (IN(7)) for (int rep_ = 0; rep_ < NREP(7); ++rep_) { if (rep_) WG_SYNC(); PHASE_TID(); MixArgs X{}; X.P = (const bf16*)(ws + WS_PRET); X.pitch = 2048; X.out = HB1; X.normg = args.in[I_RETNG]; X.rcs = (const unsigned*)(ws + WS_ROT);
        X.snap = (float*)(ws + WS_RX + 32 * MiB);
        for (int pass = 0; pass < 2; ++pass) {
            for (int u = C.vb; u < 256; u += C.G) { const int bb = u >> 5, hh = (u >> 3) & 3, sg = u & 7; if (pass == 1 || sg < 7) mixer_unit<2>(X, C, bb, hh, sg, 8, pass); }
            if (pass == 0) xcd_barrier(bar); } } SEAM(7);
    RwArgs RW{}; RW.PRW = (const bf16*)(ws + WS_PRW); RW.mu = args.in[I_RWMU]; RW.w0 = args.in[I_RWW0]; RW.a0 = args.in[I_RWA0]; RW.kk_w = args.in[I_RWKK]; RW.ka_w = args.in[I_RWKA]; RW.rk_w = args.in[I_RWRK];
    RW.lng = args.in[I_RWLNG]; RW.lnb = args.in[I_RWLNB]; RW.WupT = (const bf16*)(ws + WS_LORA); RW.AupT = (const bf16*)(ws + WS_LORA + 65536); RW.GupT = (const bf16*)(ws + WS_LORA + 131072);
    RW.G = (bf16*)(ws + WS_RWG2); RW.bonus = (float*)(ws + WS_RWBON); RW.ws = ws; RW.yraw = (float*)(ws + WS_YRAW); RW.out = HB1;
    if (IN(8)) for (int rep_ = 0; rep_ < NREP(8); ++rep_) { if (rep_) WG_SYNC(); PHASE_TID(); for (int u = 2 * C.vb; u < M / 64; u += 2 * C.G) { rwkv_prep_unit(RW, C, u, true); rwkv_prep_unit(RW, C, u + 1, false); } } SEAM(8);
    if (IN(9)) for (int rep_ = 0; rep_ < NREP(9); ++rep_) { if (rep_) WG_SYNC(); PHASE_TID(); rwkv_scan(RW, C);
        if (C.G == 256 && (C.vb & 31) >= 8) { const int j_ = (C.vb >> 5) * 24 + (C.vb & 31) - 8; WG_SYNC(); moe_weights(args, C, 0x1fu, 0u, j_ * NWAVES + C.wid, 192 * NWAVES); } } SEAM(9);
    if (IN(10)) for (int rep_ = 0; rep_ < NREP(10); ++rep_) { if (rep_) WG_SYNC(); PHASE_TID(); rwkv_finish(RW, C); } SEAM(10);
    if (IN(11)) for (int rep_ = 0; rep_ < NREP(11); ++rep_) { if (rep_) WG_SYNC(); PHASE_TID(); pg8::Gemm g{HB1, (const bf16*)(ws + WS_W_OOUT), M, D, D}; pg8::StaticOrder S; S.init(M, D, C.G, C.bid, WGM_NARROW, 1);
        pg8::EpiResid E{args.out, args.out, (bf16*)(ws + WS_HBG), ssp, 1.0f};
        pg8::gemm_phase<pg8::EpiResid, pg8::StaticOrder, true, true>(C.lds, g, S, E, C.tid); } SEAM(11);
    if (IN(12)) for (int rep_ = 0; rep_ < NREP(12); ++rep_) { if (rep_) WG_SYNC(); PHASE_TID(); route_tokens(args, C); WG_SYNC(); moe_weights(args, C, C.G == 256 ? 0x20u : 0x3fu, 0x0fu, C.bid * NWAVES + C.wid, C.G * NWAVES); } SEAM(12);
    if (IN(13)) for (int rep_ = 0; rep_ < NREP(13); ++rep_) { if (rep_) WG_SYNC(); PHASE_TID(); route_gather(args, C); WG_SYNC(); moe_weights(args, C, 0xc0u, 0xf0u, C.bid * NWAVES + C.wid, C.G * NWAVES); } SEAM(13);
    {
        const int* meta = (const int*)(ws + WS_ROUTE + RT_META); const int* tile_e = (const int*)(ws + WS_ROUTE + RT_TILE_E); const float* rsg = (const float*)(ws + WS_ROUTE + RT_RSG);
        LAS int* te_lds = (LAS int*)(C.lds + LDSCTL_OFF + 4096);
        bf16* Y = (bf16*)(ws + WS_XG); unsigned char* XG8 = ws + WS_XG8; unsigned char* HM = ws + WS_HMID;
        if (IN(14)) for (int rep_ = 0; rep_ < NREP(14); ++rep_) { if (rep_) WG_SYNC(); PHASE_TID(); for (int i_ = C.tid; i_ < MOE_TILES + 8; i_ += NTHR) te_lds[i_] = tile_e[i_]; WG_SYNC(); const int nt = meta[0];
            int k8 = D / 2; asm volatile("" : "+s"(k8));
            pg8::Gemm g{(const bf16*)XG8, (const bf16*)(ws + WS_W_MGU), 0, 0, k8}; pg8::MoeOrder S{0, nt, 2 * FF / 256, 2 * FF / 256, C.G, C.bid, te_lds, false, true, WGM_WIDE, 2};
            pg8::EpiSwiGLU8 E{HM, FF, rsg, 1.0f / 256.0f};
            pg8::gemm_phase<pg8::EpiSwiGLU8, pg8::MoeOrder, true, true, true>(C.lds, g, S, E, C.tid); } SEAM(14);
        if (IN(15)) for (int rep_ = 0; rep_ < NREP(15); ++rep_) { if (rep_) WG_SYNC(); PHASE_TID(); for (int i_ = C.tid; i_ < MOE_TILES + 8; i_ += NTHR) te_lds[i_] = tile_e[i_]; WG_SYNC(); const int nt = meta[0];
            int k8 = FF / 2; asm volatile("" : "+s"(k8));
            pg8::Gemm g{(const bf16*)HM, (const bf16*)(ws + WS_W_MDN), 0, 0, k8}; pg8::MoeOrder S{0, nt, D / 256, D / 256, C.G, C.bid, te_lds, true, false, WGM_NARROW, 4};
            pg8::EpiStore E{Y, D, 1.0f / 4096.0f};
            pg8::gemm_phase<pg8::EpiStore, pg8::MoeOrder, true, true, true>(C.lds, g, S, E, C.tid); } SEAM(15);
    }
    if (IN(16)) for (int rep_ = 0; rep_ < NREP(16); ++rep_) { if (rep_) WG_SYNC(); PHASE_TID(); final_combine(args, C); }
#undef IN
#undef SEAM
}

extern "C" void kernel_launch(void* const* d_in, const int* in_sizes, int n_in, void* d_out, int out_size, void* d_ws, size_t ws_size, hipStream_t stream) {
    static int grid = 0;
    if (grid == 0) {
        if (n_in != N_IN || in_sizes[0] != M * D || out_size != M * D || ws_size < WS_END) { fprintf(stderr, "kernel_launch: unexpected shapes (n_in %d, ws %zu < %zu?)\n", n_in, ws_size, (size_t)WS_END); grid = -1; return; }
        int dev = 0, cus = 0;
        if (hipGetDevice(&dev) != hipSuccess || hipDeviceGetAttribute(&cus, hipDeviceAttributeMultiprocessorCount, dev) != hipSuccess) { grid = -1; return; }
        if (hipFuncSetAttribute((const void*)fwd_kernel, hipFuncAttributeMaxDynamicSharedMemorySize, LDS_BYTES) != hipSuccess) { fprintf(stderr, "kernel_launch: hipFuncSetAttribute failed\n"); grid = -1; return; }
        int per_cu = 0;
        if (hipOccupancyMaxActiveBlocksPerMultiprocessor(&per_cu, (const void*)fwd_kernel, NTHR, LDS_BYTES) != hipSuccess || per_cu < 1) { fprintf(stderr, "kernel_launch: occupancy query says %d\n", per_cu); }
        (void)hipGetLastError();
        grid = cus;
    }
    if (grid < 0) return;
    (void)hipMemsetAsync((char*)d_ws + WS_CTL, 0, CTL_ZERO_BYTES, stream);
    Args a{};
    for (int i = 0; i < N_IN; ++i) a.in[i] = (const float*)d_in[i];
    a.out = (float*)d_out; a.ws = (unsigned char*)d_ws;
#if MK_SPLIT
    for (int p = 0; p < N_PHASES; ++p) { a.ph_lo = p; a.ph_hi = p + 1; hipLaunchKernelGGL(fwd_kernel, dim3(grid), dim3(NTHR), LDS_BYTES, stream, a); }
#else
    a.ph_lo = 0; a.ph_hi = N_PHASES;
    hipLaunchKernelGGL(fwd_kernel, dim3(grid), dim3(NTHR), LDS_BYTES, stream, a);
#endif
}
```

```cpp
#include <hip/hip_runtime.h>
#include <cstdio>
#include <cstdint>
namespace pg8 {
#define PG8_LAS __attribute__((address_space(3)))
typedef unsigned short bf16_t;
typedef short bf16x8 __attribute__((ext_vector_type(8)));
typedef float f32x4 __attribute__((ext_vector_type(4)));
typedef unsigned u32x4 __attribute__((ext_vector_type(4)));
constexpr int BM = 256, BK = 64, HALF = 128, HTB = HALF * BK * 2  , STAGE_BYTES = 8 * HTB, NXCD = 8;

__host__ __device__ __forceinline__ int lds_byte(int r, int c) { const int st = (r >> 4) * 2 + (c >> 5), rr = r & 15, cc = c & 31, ob = rr * 64 + cc * 2; return st * 1024 + (ob ^ (((ob >> 9) & 1) << 5)); }
__host__ __device__ __forceinline__ void stage_rc(int b, int& R, int& C) { const int st = b / 1024, sb = b % 1024, swz = sb ^ (((sb >> 9) & 1) << 5); R = (st >> 1) * 16 + swz / 64; C = (st & 1) * 32 + (swz % 64) / 2; }
__host__ __device__ __forceinline__ int perm32(int rho) { const int n = rho >> 4, i = rho & 15; return 8 * (i >> 2) + 4 * n + (i & 3); }

struct Unit { int pm, pn, bn, po, hm, hn; };
__host__ __device__ __forceinline__ bool tail_split(int i, int G, int c, int nwg, int smax, int& L, int& hm, int& hn) {
    const int F = nwg / G, R = nwg - F * G; hm = 0; hn = 0;
    if (i < F) { L = i * G + c; return true; }
    if (i > F || R == 0) return false;
    const int sh = (smax >= 4 && 4 * R <= G) ? 2 : ((smax >= 2 && 2 * R <= G) ? 1 : 0);
    if (c >= (R << sh)) return false;
    const int pc = c & ((1 << sh) - 1); L = F * G + (c >> sh);
    if (sh >= 1) hm = 1 + (pc & 1); if (sh == 2) hn = 1 + (pc >> 1);
    return true;
}
struct Gemm { const bf16_t* A; const bf16_t* Bt; int M, N, K; };

struct StaticOrder {
    int nM, nN, nwg, G, c, WGM, smax;
    __host__ __device__ void init(int M, int N, int G_, int c_, int wgm, int smax_) { nM = M / BM; nN = N / BM; nwg = nM * nN; G = G_; c = c_; WGM = wgm; smax = smax_; }
    __host__ __device__ bool next(int i, Unit& u) const {
        int L; if (!tail_split(i, G, c, nwg, smax, L, u.hm, u.hn)) return false;
        int wgid = L; { const int q = nwg / NXCD, r = nwg % NXCD, xcd = wgid % NXCD, off = wgid / NXCD; wgid = (xcd < r ? xcd * (q + 1) : r * (q + 1) + (xcd - r) * q) + off; }
        const int nig = WGM * nN, gid = wgid / nig, fm = gid * WGM, gsz = (nM - fm) < WGM ? (nM - fm) : WGM;
        u.pm = fm + ((wgid % nig) % gsz); u.pn = (wgid % nig) / gsz; u.bn = u.pn; u.po = u.pm; return true;
    }
    __device__ __forceinline__ void a_ready(const Unit&) const {}
    __device__ __forceinline__ void done(const Unit&) const {}
};

__device__ __forceinline__ unsigned cvt_pk_bf16(float lo, float hi) { unsigned r; asm volatile("v_cvt_pk_bf16_f32 %0, %1, %2" : "=v"(r) : "v"(lo), "v"(hi)); return r; }
typedef float f32x2 __attribute__((ext_vector_type(2)));
typedef int i32x4 __attribute__((ext_vector_type(4)));
typedef int i32x8 __attribute__((ext_vector_type(8)));
__device__ __forceinline__ unsigned pk4f8(float a, float b, float c, float d) {
    a = __builtin_amdgcn_fmed3f(a, -448.f, 448.f); b = __builtin_amdgcn_fmed3f(b, -448.f, 448.f); c = __builtin_amdgcn_fmed3f(c, -448.f, 448.f); d = __builtin_amdgcn_fmed3f(d, -448.f, 448.f);
    int w = __builtin_amdgcn_cvt_pk_fp8_f32(a, b, 0, false); w = __builtin_amdgcn_cvt_pk_fp8_f32(c, d, w, true); return (unsigned)w; }
__device__ __forceinline__ i32x8 cat8(bf16x8 a, bf16x8 b) { const i32x4 x = __builtin_bit_cast(i32x4, a), y = __builtin_bit_cast(i32x4, b); return __builtin_shufflevector(x, y, 0, 1, 2, 3, 4, 5, 6, 7); }
constexpr float RMS_EPS = 1e-6f;
__device__ __forceinline__ float rs_from_ssp(const float* ssp, int row) {
    const f32x4* p = (const f32x4*)(ssp + (size_t)row * 16);
    const f32x4 a = p[0], b = p[1], c = p[2], d = p[3];
    const float s = ((a[0] + a[1]) + (a[2] + a[3])) + ((b[0] + b[1]) + (b[2] + b[3])) + ((c[0] + c[1]) + (c[2] + c[3])) + ((d[0] + d[1]) + (d[2] + d[3]));
    return __builtin_amdgcn_rsqf(s * (1.0f / 1024.0f) + RMS_EPS);
}
__device__ __forceinline__ void rs8_from_ssp(const float* ssp, int row0, int fq, float (&rs)[8]) {
    f32x4 p[8];
#pragma unroll
    for (int i = 0; i < 8; ++i) p[i] = *(const f32x4*)(ssp + (size_t)(row0 + (i >> 2) * HALF + (i & 3) * 16) * 16 + 4 * fq);
#pragma unroll
    for (int i = 0; i < 8; ++i) { float t = (p[i][0] + p[i][1]) + (p[i][2] + p[i][3]); t += __shfl_xor(t, 16); t += __shfl_xor(t, 32); rs[i] = __builtin_amdgcn_rsqf(t * (1.0f / 1024.0f) + RMS_EPS); }
}
struct RsAhead { f32x4 a, b; float s; };
template <bool DIRECT> __device__ __forceinline__ void rs_issue(const float* src, int rowbase, int tid, RsAhead& r) {
    if constexpr (DIRECT) { const float* p = src + rowbase + (tid & 255); asm volatile("global_load_dword %0, %1, off" : "=v"(r.s) : "v"(p) : "memory"); }
    else { const float* p = src + (size_t)(rowbase + (tid >> 1)) * 16 + 8 * (tid & 1);
        asm volatile("global_load_dwordx4 %0, %2, off\n\tglobal_load_dwordx4 %1, %2, off offset:16" : "=&v"(r.a), "=&v"(r.b) : "v"(p) : "memory"); }
}
template <bool DIRECT, int NST> __device__ __forceinline__ void rs_commit(PG8_LAS float* dst, int tid, RsAhead& r) {
    if constexpr (DIRECT) { asm volatile("s_waitcnt vmcnt(%1)" : "+v"(r.s) : "n"(NST) : "memory"); dst[tid & 255] = r.s; }
    else { asm volatile("s_waitcnt vmcnt(%2)" : "+v"(r.a), "+v"(r.b) : "n"(NST) : "memory");
        float t = ((r.a[0] + r.a[1]) + (r.a[2] + r.a[3])) + ((r.b[0] + r.b[1]) + (r.b[2] + r.b[3])); t += __shfl_xor(t, 1);
        dst[tid >> 1] = __builtin_amdgcn_rsqf(t * (1.0f / 1024.0f) + RMS_EPS); }
}
__device__ __forceinline__ float fast_sigmoid(float x) { return __builtin_amdgcn_rcpf(1.0f + __builtin_amdgcn_exp2f(-1.4426950408889634f * x)); }
__device__ __forceinline__ float fast_silu(float x) { return x * fast_sigmoid(x); }

__device__ __forceinline__ f32x2 swiglu2(f32x2 G, f32x2 U, float c1, float ik2) {
    f32x2 e = G * c1; e[0] = __builtin_amdgcn_exp2f(e[0]); e[1] = __builtin_amdgcn_exp2f(e[1]);
    f32x2 d = e * ik2 + ik2; d[0] = __builtin_amdgcn_rcpf(d[0]); d[1] = __builtin_amdgcn_rcpf(d[1]);
    return (G * U) * d;
}
struct EpiProj {
    static constexpr bool PERM = true, AFTER_DRAIN = false, RSLDS = true; static constexpr int NSTORES = 16;
    bf16_t* O0; int ld0; bf16_t* O1; int ld1; int split; const float* ssp;
    __device__ __forceinline__ void rs_first(const Unit& u, PG8_LAS float* dst, int tid) const { RsAhead r; rs_issue<false>(ssp, u.po * BM, tid, r); rs_commit<false, 0>(dst, tid, r); }
    __device__ __forceinline__ void operator()(const f32x4 (&acc)[2][2][4][2], const Unit& u, int wr, int wc, int fr, int fq, const PG8_LAS float* rs_cur, PG8_LAS float* rs_nxt, const Unit& nxt, bool has_next, int tid) const {
        int frl = fr, fql = fq, tidl = tid; asm volatile("" : "+v"(frl), "+v"(fql), "+v"(tidl));
        RsAhead rn; rs_issue<false>(ssp, (has_next ? nxt.po : u.po) * BM, tidl, rn);
        const int row0 = u.po * BM + (u.hm == 2 ? HALF : 0) + wr * 64 + frl;
        bf16_t* base; int ld, ct;
        if (u.pn < split) { base = O0; ld = ld0; ct = u.pn; } else { base = O1; ld = ld1; ct = u.pn - split; }
        const int col0 = ct * BM + (u.hn == 2 ? HALF : 0) + wc * 32 + 8 * fql;
        float rsv[8];
#pragma unroll
        for (int i = 0; i < 8; ++i) rsv[i] = rs_cur[(u.hm == 2 ? HALF : 0) + wr * 64 + frl + (i >> 2) * HALF + (i & 3) * 16 - ((u.hm == 2 && i >= 4) ? HALF : 0)];
#pragma unroll
        for (int ai = 0; ai < 2; ++ai)
#pragma unroll
            for (int m = 0; m < 4; ++m) { if (ai && u.hm) continue; const int row = row0 + ai * HALF + m * 16; const float rs = rsv[ai * 4 + m]; bf16_t* rowp = base + (size_t)row * ld + col0;
#pragma unroll
                for (int bj = 0; bj < 2; ++bj) { if (bj && u.hn) continue; const f32x4 v0 = acc[ai][bj][m][0] * rs, v1 = acc[ai][bj][m][1] * rs;
                    u32x4 w; w.x = cvt_pk_bf16(v0[0], v0[1]); w.y = cvt_pk_bf16(v0[2], v0[3]); w.z = cvt_pk_bf16(v1[0], v1[1]); w.w = cvt_pk_bf16(v1[2], v1[3]);
                    *(u32x4*)(rowp + bj * HALF) = w; } }
        rs_commit<false, NSTORES>(rs_nxt, tidl, rn);
    }
};
template <bool HB8> struct EpiResidT {
    static constexpr bool PERM = false, AFTER_DRAIN = false, RSLDS = false; static constexpr int NSTORES = -1;
    const float* res; float* Hout; bf16_t* hb; float* ssp; float sc;
    __device__ __forceinline__ void operator()(const f32x4 (&acc)[2][2][4][2], const Unit& u, int wr, int wc, int fr, int fq) const {
        typedef unsigned u32x2v __attribute__((ext_vector_type(2)));
        const int row0 = u.po * BM + wr * 64 + fr, col0 = u.pn * BM + wc * 32 + 4 * fq;
        f32x4 h[2][4][2][2];
#pragma unroll
        for (int q = 0; q < 4; ++q) { const int ai = q >> 1; f32x4 r[2][2][2];
#pragma unroll
            for (int mm = 0; mm < 2; ++mm)
#pragma unroll
                for (int bj = 0; bj < 2; ++bj)
#pragma unroll
                    for (int n = 0; n < 2; ++n) r[mm][bj][n] = *(const f32x4*)(res + (size_t)(row0 + ai * HALF + ((q & 1) * 2 + mm) * 16) * 1024 + col0 + bj * HALF + n * 16);
#pragma unroll
            for (int mm = 0; mm < 2; ++mm)
#pragma unroll
                for (int bj = 0; bj < 2; ++bj)
#pragma unroll
                    for (int n = 0; n < 2; ++n) { f32x4 t = r[mm][bj][n] + acc[ai][bj][(q & 1) * 2 + mm][n] * sc; asm volatile("" : "+v"(t)); h[ai][(q & 1) * 2 + mm][bj][n] = t; }
            __builtin_amdgcn_sched_barrier(0); }
#pragma unroll
        for (int ai = 0; ai < 2; ++ai)
#pragma unroll
            for (int m = 0; m < 4; ++m) { const int row = row0 + ai * HALF + m * 16; const size_t off = (size_t)row * 1024 + col0; float ss = 0.f;
#pragma unroll
                for (int bj = 0; bj < 2; ++bj)
#pragma unroll
                    for (int n = 0; n < 2; ++n) { const size_t o = off + bj * HALF + n * 16; const f32x4 hv = h[ai][m][bj][n];
                        *(f32x4*)(Hout + o) = hv;
                        if constexpr (HB8) *(unsigned*)((unsigned char*)hb + o) = pk4f8(hv[0], hv[1], hv[2], hv[3]);
                        else { u32x2v w; w.x = cvt_pk_bf16(hv[0], hv[1]); w.y = cvt_pk_bf16(hv[2], hv[3]); *(u32x2v*)(hb + o) = w; }
                        ss += (hv[0] * hv[0] + hv[1] * hv[1]) + (hv[2] * hv[2] + hv[3] * hv[3]); }
                ss += __shfl_xor(ss, 16); ss += __shfl_xor(ss, 32);
                if (fq == 0) ssp[(size_t)row * 16 + u.pn * 4 + wc] = ss; }
    }
};
typedef EpiResidT<false> EpiResid;
template <bool MOE> struct EpiSwiGLU {
    static constexpr bool PERM = true, AFTER_DRAIN = false, RSLDS = false; static constexpr int NSTORES = 8;
    bf16_t* O; int ld; const float* rsrc;
    __device__ __forceinline__ void operator()(const f32x4 (&acc)[2][2][4][2], const Unit& u, int wr, int wc, int fr, int fq) const {
        int frl = fr, fql = fq; asm volatile("" : "+v"(frl), "+v"(fql));
        const int rloc = wr * 64 + frl, col0 = u.pn * HALF + wc * 32 + 8 * fql;
        float rsv[8];
        if constexpr (MOE) {
#pragma unroll
            for (int i = 0; i < 8; ++i) rsv[i] = rsrc[u.pm * BM + rloc + (i >> 2) * HALF + (i & 3) * 16]; }
        else rs8_from_ssp(rsrc, u.pm * BM + rloc, fql, rsv);
#pragma unroll
        for (int ai = 0; ai < 2; ++ai)
#pragma unroll
            for (int m = 0; m < 4; ++m) { const int r = rloc + ai * HALF + m * 16;
                const float rs = rsv[ai * 4 + m], c1 = -1.4426950408889634f * rs, ik2 = __builtin_amdgcn_rcpf(rs * rs);
                f32x2 o[4];
#pragma unroll
                for (int n = 0; n < 2; ++n)
#pragma unroll
                    for (int hh = 0; hh < 2; ++hh) { const f32x4 g4 = acc[ai][0][m][n], u4 = acc[ai][1][m][n]; const f32x2 G = {g4[2 * hh], g4[2 * hh + 1]}, U = {u4[2 * hh], u4[2 * hh + 1]}; o[n * 2 + hh] = swiglu2(G, U, c1, ik2); }
                u32x4 w; w.x = cvt_pk_bf16(o[0][0], o[0][1]); w.y = cvt_pk_bf16(o[1][0], o[1][1]); w.z = cvt_pk_bf16(o[2][0], o[2][1]); w.w = cvt_pk_bf16(o[3][0], o[3][1]);
                *(u32x4*)(O + (size_t)(u.po * BM + r) * ld + col0) = w; }
    }
};
template <bool MOE, bool OUT8 = true> struct EpiSwiGLU8T {
    static constexpr bool PERM = true, AFTER_DRAIN = false, RSLDS = true; static constexpr int NSTORES = 8;
    unsigned char* O; int ld; const float* rsrc; float wsc;
    __device__ __forceinline__ void rs_first(const Unit& u, PG8_LAS float* dst, int tid) const { RsAhead r; rs_issue<MOE>(rsrc, u.pm * BM, tid, r); rs_commit<MOE, 0>(dst, tid, r); }
    __device__ __forceinline__ void operator()(const f32x4 (&acc)[2][2][4][2], const Unit& u, int wr, int wc, int fr, int fq, const PG8_LAS float* rs_cur, PG8_LAS float* rs_nxt, const Unit& nxt, bool has_next, int tid) const {
        typedef unsigned u32x2v __attribute__((ext_vector_type(2)));
        int tidl = tid; asm volatile("" : "+v"(tidl));
        RsAhead rn; rs_issue<MOE>(rsrc, (has_next ? nxt.pm : u.pm) * BM, tidl, rn);
        int frl = fr, fql = fq; asm volatile("" : "+v"(frl), "+v"(fql));
        const int rloc = (u.hm == 2 ? HALF : 0) + wr * 64 + frl, col0 = u.pn * HALF + wc * 32 + 8 * fql;
        float rsv[8];
#pragma unroll
        for (int i = 0; i < 8; ++i) rsv[i] = rs_cur[rloc + (i & 3) * 16 + ((i >= 4 && !u.hm) ? HALF : 0)];
#pragma unroll
        for (int ai = 0; ai < 2; ++ai)
#pragma unroll
            for (int m = 0; m < 4; ++m) { if (ai && u.hm) continue; const int r = rloc + ai * HALF + m * 16;
                const float rs = rsv[ai * 4 + m] * wsc, c1 = -1.4426950408889634f * rs, ik2 = __builtin_amdgcn_rcpf(rs * rs * (OUT8 ? 16.0f : 1.0f));
                f32x2 o[4];
#pragma unroll
                for (int n = 0; n < 2; ++n)
#pragma unroll
                    for (int hh = 0; hh < 2; ++hh) { const f32x4 g4 = acc[ai][0][m][n], u4 = acc[ai][1][m][n]; const f32x2 G = {g4[2 * hh], g4[2 * hh + 1]}, U = {u4[2 * hh], u4[2 * hh + 1]}; o[n * 2 + hh] = swiglu2(G, U, c1, ik2); }
                if constexpr (OUT8) { u32x2v w; w.x = pk4f8(o[0][0], o[0][1], o[1][0], o[1][1]); w.y = pk4f8(o[2][0], o[2][1], o[3][0], o[3][1]);
                    *(u32x2v*)(O + (size_t)(u.po * BM + r) * ld + col0) = w; }
                else { u32x4 w; w.x = cvt_pk_bf16(o[0][0], o[0][1]); w.y = cvt_pk_bf16(o[1][0], o[1][1]); w.z = cvt_pk_bf16(o[2][0], o[2][1]); w.w = cvt_pk_bf16(o[3][0], o[3][1]);
                    *(u32x4*)((bf16_t*)O + (size_t)(u.po * BM + r) * ld + col0) = w; } }
        rs_commit<MOE, NSTORES>(rs_nxt, tidl, rn);
    }
};
typedef EpiSwiGLU8T<true> EpiSwiGLU8;
struct EpiStore {
    static constexpr bool PERM = true, AFTER_DRAIN = false, RSLDS = false; static constexpr int NSTORES = 16;
    bf16_t* O; int ld; float sc;
    __device__ __forceinline__ void operator()(const f32x4 (&acc)[2][2][4][2], const Unit& u, int wr, int wc, int fr, int fq) const {
        int frl = fr, fql = fq; asm volatile("" : "+v"(frl), "+v"(fql));
        const int row0 = u.po * BM + (u.hm == 2 ? HALF : 0) + wr * 64 + frl, col0 = u.pn * BM + (u.hn == 2 ? HALF : 0) + wc * 32 + 8 * fql;
#pragma unroll
        for (int ai = 0; ai < 2; ++ai)
#pragma unroll
            for (int m = 0; m < 4; ++m) { if (ai && u.hm) continue; bf16_t* rowp = O + (size_t)(row0 + ai * HALF + m * 16) * ld + col0;
#pragma unroll
                for (int bj = 0; bj < 2; ++bj) { if (bj && u.hn) continue; const f32x4 v0 = acc[ai][bj][m][0] * sc, v1 = acc[ai][bj][m][1] * sc;
                    u32x4 w; w.x = cvt_pk_bf16(v0[0], v0[1]); w.y = cvt_pk_bf16(v0[2], v0[3]); w.z = cvt_pk_bf16(v1[0], v1[1]); w.w = cvt_pk_bf16(v1[2], v1[3]);
                    *(u32x4*)(rowp + bj * HALF) = w; } }
    }
};
struct MoeOrder {
    int t_lo, nT, nN, nBper, G, c; const PG8_LAS int* tile_expert; bool a_local, o_local; int WGM, smax;
    __device__ bool next(int i, Unit& u) const {
        const int nwg = nT * nN; int L; if (!tail_split(i, G, c, nwg, smax, L, u.hm, u.hn)) return false;
        { const int q = nwg / NXCD, r = nwg % NXCD, xcd = L % NXCD, off = L / NXCD; L = (xcd < r ? xcd * (q + 1) : r * (q + 1) + (xcd - r) * q) + off; }
        const int nig = WGM * nN, gid = L / nig, fm = gid * WGM, gsz = (nT - fm) < WGM ? (nT - fm) : WGM, rem = L % nig;
        const int pmi = fm + rem % gsz, pn = rem / gsz, t = t_lo + pmi, e = tile_expert[t];
        u.pn = pn; u.bn = e * nBper + pn; u.pm = a_local ? pmi : t; u.po = o_local ? pmi : t; return true;
    }
    __device__ __forceinline__ void a_ready(const Unit&) const {}
    __device__ __forceinline__ void done(const Unit&) const {}
};
template <class Epi, class Sched, bool ALIGN_EPI = false, bool SP2 = false, bool FP8 = false>
__device__ __forceinline__ void gemm_phase(PG8_LAS unsigned char* lds, const Gemm g, const Sched& S, const Epi& E, const int tid  ) {
    const int wid = __builtin_amdgcn_readfirstlane(tid >> 6), lane = tid & 63, wr = wid >> 2, wc = wid & 3, fr = lane & 15, fq = lane >> 4;
    const int K = g.K, nt = K / BK;
    unsigned voffA[2], voffB[2];
#pragma unroll
    for (int i = 0; i < 2; ++i) { int R, C; stage_rc(tid * 16 + i * 8192, R, C); const int Rb = Epi::PERM ? ((R & ~31) + perm32(R & 31)) : R;
        voffA[i] = (unsigned)(R * K + C) * 2u; voffB[i] = (unsigned)(Rb * K + C) * 2u; }
    const size_t kstep = (size_t)(BK * 2);
    const size_t hstep = (size_t)HALF * K * 2;
    const size_t tstep = 2 * hstep;
    const unsigned ldsw = (unsigned)wid * 1024u;
    const int aoff = lds_byte(wr * 64 + fr, fq * 8), boff = lds_byte(wc * 32 + fr, fq * 8);
#define PG8_SA(b, h) (((b) * 2 + (h)) * HTB)
#define PG8_SB(b, h) ((4 + (b) * 2 + (h)) * HTB)
#define PG8_STAGE(bufoff, gbase, voff) do { const char* gb_ = (const char*)(gbase); asm volatile("" : "+s"(gb_));   \
        _Pragma("unroll") for (int _i = 0; _i < 2; ++_i) { unsigned vo_ = (voff)[_i]; asm volatile("" : "+v"(vo_)); \
        __builtin_amdgcn_global_load_lds((const unsigned*)(gb_ + vo_), (PG8_LAS unsigned*)(lds + (bufoff) + ldsw + _i * 8192), 16, 0, 0); } } while (0)
#define PG8_LDA(dst, b, h) do { _Pragma("unroll") for (int m = 0; m < 4; ++m) _Pragma("unroll") for (int k = 0; k < 2; ++k) dst[m][k] = *(const PG8_LAS bf16x8*)(lds + PG8_SA(b, h) + aoff + m * 2048 + k * 1024); } while (0)
#define PG8_LDB(dst, b, h) do { _Pragma("unroll") for (int n = 0; n < 2; ++n) _Pragma("unroll") for (int k = 0; k < 2; ++k) dst[n][k] = *(const PG8_LAS bf16x8*)(lds + PG8_SB(b, h) + boff + n * 2048 + k * 1024); } while (0)
#define PG8_MMA(ai, bj, At, Bt) do { __builtin_amdgcn_s_setprio(1); _Pragma("unroll") for (int m = 0; m < 4; ++m) _Pragma("unroll") for (int n = 0; n < 2; ++n) { \
        if constexpr (FP8) acc[ai][bj][m][n] = __builtin_amdgcn_mfma_scale_f32_16x16x128_f8f6f4(cat8(Bt[n][0], Bt[n][1]), cat8(At[m][0], At[m][1]), acc[ai][bj][m][n], 0, 0, 0, 0, 0, 0); \
        else { _Pragma("unroll") for (int k = 0; k < 2; ++k) acc[ai][bj][m][n] = __builtin_amdgcn_mfma_f32_16x16x32_bf16(Bt[n][k], At[m][k], acc[ai][bj][m][n], 0, 0, 0); } } __builtin_amdgcn_s_setprio(0); } while (0)
#define PG8_WAIT_V(n) asm volatile("s_waitcnt vmcnt(" #n ")" ::: "memory")
#define PG8_WAIT_L(n) asm volatile("s_waitcnt lgkmcnt(" #n ")" ::: "memory")
#define PG8_WAIT_VP() do { if (peel) asm volatile("s_waitcnt vmcnt(%0)" :: "n"(8 + (Epi::NSTORES > 0 ? Epi::NSTORES : 0)) : "memory"); else PG8_WAIT_V(8); } while (0)
#define PG8_BAR __builtin_amdgcn_s_barrier()
#define PG8_SCHED __builtin_amdgcn_sched_barrier(0)
    constexpr bool PRE = SP2 && Epi::NSTORES > 0 && Epi::NSTORES <= 55;
    bool pre = false;
    Unit cur, nxt; int ui = 0;
    if (!S.next(0, cur)) return;
    PG8_LAS float* rsb = (PG8_LAS float*)(lds + STAGE_BYTES + 12288);
    if constexpr (Epi::RSLDS) E.rs_first(cur, rsb, tid);
    f32x4 acc[2][2][4][2];
#pragma unroll
    for (int a = 0; a < 2; ++a)
#pragma unroll
        for (int b = 0; b < 2; ++b)
#pragma unroll
            for (int m = 0; m < 4; ++m)
#pragma unroll
                for (int n = 0; n < 2; ++n) acc[a][b][m][n] = (f32x4){0.f, 0.f, 0.f, 0.f};
    bf16x8 At[4][2], B0[2][2], B1[2][2];
    const char* cA = (const char*)g.A + (size_t)cur.pm * tstep + (cur.hm == 2 ? hstep : 0); const char* cB = (const char*)g.Bt + (size_t)cur.bn * tstep + (cur.hn == 2 ? hstep : 0);
    S.a_ready(cur);
    if constexpr (SP2) {
        PG8_STAGE(PG8_SB(0, 0), cB, voffB); PG8_STAGE(PG8_SB(0, 1), cB + hstep, voffB); PG8_STAGE(PG8_SA(0, 0), cA, voffA); PG8_STAGE(PG8_SA(0, 1), cA + hstep, voffA);
        if (wr == 1) PG8_BAR;
        PG8_WAIT_V(2); PG8_BAR;
        PG8_STAGE(PG8_SB(1, 0), cB + kstep, voffB); PG8_STAGE(PG8_SA(1, 0), cA + kstep, voffA); PG8_STAGE(PG8_SB(1, 1), cB + hstep + kstep, voffB);
        PG8_WAIT_V(6); PG8_BAR;
    } else {
        PG8_STAGE(PG8_SB(0, 0), cB, voffB); PG8_STAGE(PG8_SA(0, 0), cA, voffA); PG8_STAGE(PG8_SB(0, 1), cB + hstep, voffB); PG8_STAGE(PG8_SA(0, 1), cA + hstep, voffA);
        if (wr == 1) PG8_BAR;
        PG8_WAIT_V(4); PG8_BAR;
        PG8_STAGE(PG8_SB(1, 0), cB + kstep, voffB); PG8_STAGE(PG8_SA(1, 0), cA + kstep, voffA); PG8_STAGE(PG8_SB(1, 1), cB + hstep + kstep, voffB);
        PG8_WAIT_V(6); PG8_BAR;
    }
    for (;;) {
        const bool has_next = S.next(ui + 1, nxt);
        const char* nA = has_next ? (const char*)g.A + (size_t)nxt.pm * tstep + (nxt.hm == 2 ? hstep : 0) : cA; const char* nB = has_next ? (const char*)g.Bt + (size_t)nxt.bn * tstep + (nxt.hn == 2 ? hstep : 0) : cB;
        for (int t = 0; t < nt; t += 2) {
            const bool last = (t == nt - 2);
            const char* a1 = cA + (size_t)(t + 1) * kstep;
            const char* a2 = last ? nA : cA + (size_t)(t + 2) * kstep; const char* b2 = last ? nB : cB + (size_t)(t + 2) * kstep;
            const char* a3 = a2 + kstep; const char* b3 = b2 + kstep;
            if (last && has_next) S.a_ready(nxt);
            if constexpr (SP2) {
            const bool peel = PRE && pre && t == 0;
            PG8_LDB(B0, 0, 0); PG8_LDB(B1, 0, 1); PG8_SCHED; PG8_LDA(At, 0, 0); if (!peel) PG8_STAGE(PG8_SA(1, 1), a1 + hstep, voffA);
            PG8_WAIT_VP(); PG8_WAIT_L(0); PG8_BAR; PG8_MMA(0, 0, At, B0); if (!cur.hn) PG8_MMA(0, 1, At, B1); PG8_BAR; PG8_SCHED;
            PG8_LDA(At, 0, 1); PG8_STAGE(PG8_SB(0, 0), b2, voffB); PG8_STAGE(PG8_SB(0, 1), b2 + hstep, voffB); PG8_STAGE(PG8_SA(0, 0), a2, voffA);
            PG8_WAIT_VP(); PG8_WAIT_L(0); PG8_BAR; if (!cur.hm) { PG8_MMA(1, 0, At, B0); if (!cur.hn) PG8_MMA(1, 1, At, B1); } PG8_BAR; PG8_SCHED;
            PG8_LDB(B0, 1, 0); PG8_LDB(B1, 1, 1); PG8_SCHED; PG8_LDA(At, 1, 0); PG8_STAGE(PG8_SA(0, 1), a2 + hstep, voffA);
            PG8_WAIT_VP(); PG8_WAIT_L(0); PG8_BAR; PG8_MMA(0, 0, At, B0); if (!cur.hn) PG8_MMA(0, 1, At, B1); PG8_BAR; PG8_SCHED;
            PG8_LDA(At, 1, 1); PG8_STAGE(PG8_SB(1, 0), b3, voffB); PG8_STAGE(PG8_SB(1, 1), b3 + hstep, voffB); PG8_STAGE(PG8_SA(1, 0), a3, voffA);
            PG8_WAIT_V(8); PG8_WAIT_L(0); PG8_BAR; if (!cur.hm) { PG8_MMA(1, 0, At, B0); if (!cur.hn) PG8_MMA(1, 1, At, B1); } PG8_BAR; PG8_SCHED;
            } else {
            PG8_LDB(B0, 0, 0); PG8_SCHED; PG8_LDA(At, 0, 0); PG8_STAGE(PG8_SA(1, 1), a1 + hstep, voffA);
            PG8_WAIT_L(8); PG8_BAR; PG8_WAIT_L(0); PG8_MMA(0, 0, At, B0); PG8_BAR; PG8_SCHED;
            PG8_LDB(B1, 0, 1); PG8_STAGE(PG8_SB(0, 0), b2, voffB);
            PG8_BAR; PG8_WAIT_L(0); PG8_MMA(0, 1, At, B1); PG8_BAR;
            PG8_LDA(At, 0, 1); PG8_STAGE(PG8_SA(0, 0), a2, voffA);
            PG8_BAR; PG8_WAIT_L(0); PG8_MMA(1, 0, At, B0); PG8_BAR; PG8_SCHED;
            PG8_STAGE(PG8_SB(0, 1), b2 + hstep, voffB);
            PG8_WAIT_V(6); PG8_BAR; PG8_MMA(1, 1, At, B1); PG8_BAR;
            PG8_LDB(B0, 1, 0); PG8_SCHED; PG8_LDA(At, 1, 0); PG8_STAGE(PG8_SA(0, 1), a2 + hstep, voffA);
            PG8_WAIT_L(8); PG8_BAR; PG8_WAIT_L(0); PG8_MMA(0, 0, At, B0); PG8_BAR; PG8_SCHED;
            PG8_LDB(B1, 1, 1); PG8_STAGE(PG8_SB(1, 0), b3, voffB);
            PG8_BAR; PG8_WAIT_L(0); PG8_MMA(0, 1, At, B1); PG8_BAR;
            PG8_LDA(At, 1, 1); PG8_STAGE(PG8_SA(1, 0), a3, voffA);
            PG8_BAR; PG8_WAIT_L(0); PG8_MMA(1, 0, At, B0); PG8_BAR; PG8_SCHED;
            PG8_STAGE(PG8_SB(1, 1), b3 + hstep, voffB);
            PG8_WAIT_V(6); PG8_BAR; PG8_MMA(1, 1, At, B1); PG8_BAR;
            }
        }
        if constexpr (PRE) { if (has_next) PG8_STAGE(PG8_SA(1, 1), nA + kstep + hstep, voffA); pre = has_next; }
        if constexpr (ALIGN_EPI) { if (wr == 0) PG8_BAR; }
        if constexpr (!Epi::AFTER_DRAIN) {
            if constexpr (Epi::RSLDS) E(acc, cur, wr, wc, fr, fq, rsb + (ui & 1) * 256, rsb + ((ui & 1) ^ 1) * 256, nxt, has_next, tid); else E(acc, cur, wr, wc, fr, fq);
            S.done(cur); }
        if (!has_next) break;
#pragma unroll
        for (int a = 0; a < 2; ++a)
#pragma unroll
            for (int b = 0; b < 2; ++b)
#pragma unroll
                for (int m = 0; m < 4; ++m)
#pragma unroll
                    for (int n = 0; n < 2; ++n) acc[a][b][m][n] = (f32x4){0.f, 0.f, 0.f, 0.f};
        cur = nxt; cA = nA; cB = nB; ++ui;
        if constexpr (ALIGN_EPI) { if (wr == 1) PG8_BAR; }
    }
    PG8_WAIT_V(0);
    if constexpr (!ALIGN_EPI) { if (wr == 0) PG8_BAR; }
    PG8_BAR;
    if constexpr (Epi::AFTER_DRAIN) { E.fused(acc, cur, wr, wc, fr, fq, lds, wid, lane); S.done(cur); }
#undef PG8_SA
#undef PG8_SB
#undef PG8_STAGE
#undef PG8_LDA
#undef PG8_LDB
#undef PG8_MMA
#undef PG8_WAIT_V
#undef PG8_WAIT_L
#undef PG8_WAIT_VP
#undef PG8_BAR
#undef PG8_SCHED
}
}

constexpr int NWAVES = 8, NTHR = 512;
#ifndef FFN8_UP
#define FFN8_UP 2
#endif
constexpr int M = 32768, D = 1024, T = 4096, NBATCH = 8, PW = 3840, FF = 3584;
constexpr size_t MiB = 1u << 20;
constexpr size_t WS_CTL = 0, CTL_ZERO_BYTES = 1 * MiB;
constexpr size_t WS_SSP = 1 * MiB;
constexpr size_t WS_ROUTE = 3 * MiB;
constexpr size_t WS_LORA = 4 * MiB;
constexpr size_t WS_ROT = 5 * MiB;
constexpr size_t WS_W_EIN = 8 * MiB, WS_W_EOUT = WS_W_EIN + (size_t)PW * D * 2, WS_W_FGU = WS_W_EOUT + 2 * MiB, WS_W_FDN = WS_W_FGU + 14 * MiB,
                 WS_W_OIN = WS_W_FDN + 7 * MiB, WS_W_OOUT = WS_W_OIN + (size_t)PW * D * 2;
static_assert(WS_W_OOUT + 2 * MiB == 48 * MiB, "weight map");
constexpr size_t WS_HB0 = 48 * MiB, WS_HB1 = 112 * MiB, WS_RP = 176 * MiB, WS_RX = 416 * MiB;
constexpr size_t WS_PRET = WS_RP, WS_PRW = WS_RP + 128 * MiB;
constexpr size_t WS_YRAW = WS_HB0;
constexpr size_t WS_W_MGU = 8 * MiB, WS_W_MDN = 64 * MiB;
constexpr int MOE_ROWS = 67584, MOE_TILES = 264;
constexpr size_t WS_HMID = 176 * MiB, WS_XG = 407 * MiB, WS_END = 539 * MiB;
constexpr size_t WS_XG8 = 100 * MiB;
constexpr size_t WS_HBG = WS_HMID;
static_assert(WS_W_MGU + (size_t)5 * 2 * FF * D <= WS_W_OOUT, "experts 0..4 are converted while W_out of layer 1 is still live");
static_assert(WS_W_MGU + (size_t)8 * 2 * FF * D <= WS_W_MDN && WS_W_MDN + (size_t)8 * FF * D <= WS_XG8 && WS_XG8 + (size_t)MOE_ROWS * D <= WS_HMID, "moe fp8 map");
static_assert(WS_HMID + (size_t)MOE_TILES * 256 * FF <= WS_XG && WS_XG + (size_t)MOE_ROWS * D * 2 <= WS_END, "moe map");
constexpr size_t RT_E01 = 0, RT_W0 = 128 * 1024, RT_RS = 256 * 1024, RT_POS0 = 384 * 1024, RT_POS1 = 512 * 1024, RT_RSG = 640 * 1024, RT_CNT = 920 * 1024, RT_TILE_E = 936 * 1024, RT_META = 944 * 1024;
constexpr int CW_BAR = 4096;
constexpr int RING_BYTES = 131072, LDSCTL_OFF = RING_BYTES, MISC_OFF = LDSCTL_OFF + 320, LDS_BYTES = 147456;

#define GAS __attribute__((address_space(1)))
#define LAS __attribute__((address_space(3)))
typedef unsigned short bf16;
typedef unsigned v4u __attribute__((ext_vector_type(4)));
typedef unsigned v2u __attribute__((ext_vector_type(2)));
typedef float f32x4 __attribute__((ext_vector_type(4)));
typedef short bf16x8 __attribute__((ext_vector_type(8)));
typedef GAS unsigned gu32;
#define LDS_WAIT() asm volatile("s_waitcnt lgkmcnt(0)" ::: "memory")
#define VM_WAIT() asm volatile("s_waitcnt vmcnt(0)" ::: "memory")
#define WG_SYNC() __syncthreads()
#define LDS_SYNC() do { asm volatile("s_waitcnt lgkmcnt(0)" ::: "memory"); __builtin_amdgcn_s_barrier(); asm volatile("" ::: "memory"); } while (0)
__device__ __forceinline__ float bflo(unsigned u) { return __uint_as_float(u << 16); }
__device__ __forceinline__ float bfhi(unsigned u) { return __uint_as_float(u & 0xffff0000u); }
__device__ __forceinline__ float bf2f(bf16 u) { return __uint_as_float((unsigned)u << 16); }
typedef float f32x2n __attribute__((ext_vector_type(2)));
typedef __bf16 bfx2n __attribute__((ext_vector_type(2)));
__device__ __forceinline__ unsigned pk2(float lo, float hi) { const f32x2n v = {lo, hi}; return __builtin_bit_cast(unsigned, __builtin_convertvector(v, bfx2n)); }
__device__ __forceinline__ void unpack8(const v4u w, float (&f)[8]) { f[0] = bflo(w.x); f[1] = bfhi(w.x); f[2] = bflo(w.y); f[3] = bfhi(w.y); f[4] = bflo(w.z); f[5] = bfhi(w.z); f[6] = bflo(w.w); f[7] = bfhi(w.w); }
__device__ __forceinline__ v4u pack8(const float (&f)[8]) { v4u w; w.x = pk2(f[0], f[1]); w.y = pk2(f[2], f[3]); w.z = pk2(f[4], f[5]); w.w = pk2(f[6], f[7]); return w; }
__device__ __forceinline__ float fsig(float x) { return __builtin_amdgcn_rcpf(1.0f + __builtin_amdgcn_exp2f(-1.4426950408889634f * x)); }
__device__ __forceinline__ float fexp(float x) { return __builtin_amdgcn_exp2f(1.4426950408889634f * x); }
__device__ __forceinline__ float log_sigmoid(float x) { return fminf(x, 0.f) - 0.6931471805599453f * __builtin_amdgcn_logf(1.0f + __builtin_amdgcn_exp2f(-1.4426950408889634f * fabsf(x))); }
#define DPPF(old, v, ctrl, rmask, bc) __builtin_bit_cast(float, __builtin_amdgcn_update_dpp(__builtin_bit_cast(int, (float)(old)), __builtin_bit_cast(int, (float)(v)), (ctrl), (rmask), 0xf, (bc)))
__device__ __forceinline__ float wave_scan_add(float v) {
    v += DPPF(0.f, v, 0x111, 0xf, true); v += DPPF(0.f, v, 0x112, 0xf, true); v += DPPF(0.f, v, 0x114, 0xf, true); v += DPPF(0.f, v, 0x118, 0xf, true);
    v += DPPF(0.f, v, 0x142, 0xa, false); v += DPPF(0.f, v, 0x143, 0xc, false); return v;
}
__device__ __forceinline__ float wave_scan_max(float v) {
    const float NI = -__builtin_inff();
    v = fmaxf(v, DPPF(NI, v, 0x111, 0xf, false)); v = fmaxf(v, DPPF(NI, v, 0x112, 0xf, false)); v = fmaxf(v, DPPF(NI, v, 0x114, 0xf, false)); v = fmaxf(v, DPPF(NI, v, 0x118, 0xf, false));
    v = fmaxf(v, DPPF(NI, v, 0x142, 0xa, false)); v = fmaxf(v, DPPF(NI, v, 0x143, 0xc, false)); return v;
}
__device__ __forceinline__ float lane63(float v) { return __builtin_bit_cast(float, __builtin_amdgcn_readlane(__builtin_bit_cast(int, v), 63)); }
__device__ __forceinline__ float wave_sum(float v) { return lane63(wave_scan_add(v)); }
#define XB_TMO      128
#define XB_XCNT(j)  (256  + 64 * (j))
#define XB_XSUB(j)  (1280 + 64 * (j))
#define XB_XGEN(j)  (2304 + 64 * (j))
#define XB_TOP      3328
#define XB_TOPGEN   3392
#define XCD_BAR_WORDS 3456
#define XB_SPIN_CAP (1u << 18)

__device__ __forceinline__ unsigned xb_ld(unsigned* p)              { return __hip_atomic_load(p, __ATOMIC_RELAXED, __HIP_MEMORY_SCOPE_AGENT); }
__device__ __forceinline__ unsigned xb_add(unsigned* p, unsigned v) { return __hip_atomic_fetch_add(p, v, __ATOMIC_RELAXED, __HIP_MEMORY_SCOPE_AGENT); }
__device__ __forceinline__ unsigned xb_xcc_id() { return (unsigned)__builtin_amdgcn_s_getreg((3 << 11) | 20) & 0xFu; }
#define XB_SPIN(cond, bar) do { unsigned _sp = 0; while (cond) { __builtin_amdgcn_s_sleep(1); \
    if ((++_sp & 255u) == 0u) { if (xb_ld(&(bar)[XB_TMO])) break; if (_sp > XB_SPIN_CAP) { atomicAdd(&(bar)[XB_TMO], 1u); break; } } } } while (0)

struct XcdBarrier {
    unsigned* bar; unsigned x, wid;
    volatile LAS unsigned* st;
};

__device__ __forceinline__ unsigned xb_lane_id() { unsigned l; asm volatile("v_mbcnt_lo_u32_b32 %0, -1, 0\n\tv_mbcnt_hi_u32_b32 %0, -1, %0" : "=v"(l)); return l; }
__device__ __forceinline__ bool xb_lane0() { return xb_lane_id() == 0u; }
__device__ __forceinline__ XcdBarrier xcd_barrier_post(unsigned* bar, volatile LAS unsigned* st, unsigned wid) {
    XcdBarrier b; b.bar = bar; b.x = xb_xcc_id(); b.st = st; b.wid = wid;
    if (wid == 0u && xb_lane0()) (void)xb_add(&bar[XB_XCNT(b.x)], 1u);
    return b;
}
__device__ __forceinline__ void xcd_barrier_complete(unsigned* bar, unsigned x, unsigned& nloc, unsigned& nx) {
    const unsigned G = gridDim.x * gridDim.y * gridDim.z;
    unsigned sum, cnt, mine, sp = 0u;
    for (;;) {
        sum = 0u; cnt = 0u; mine = 0u;
#pragma unroll
        for (unsigned j = 0; j < 16; ++j) { const unsigned c = xb_ld(&bar[XB_XCNT(j)]); sum += c; cnt += (c > 0u) ? 1u : 0u; mine = (j == x) ? c : mine; }
        if (sum == G) break;
        __builtin_amdgcn_s_sleep(1);
        if ((++sp & 255u) == 0u) { if (xb_ld(&bar[XB_TMO])) break; if (sp > XB_SPIN_CAP) { atomicAdd(&bar[XB_TMO], 1u); break; } }
    }
    nloc = mine > 0u ? mine : 1u; nx = cnt > 0u ? cnt : 1u;
}

__device__ __forceinline__ void xcd_barrier(const XcdBarrier& b) {
    asm volatile("s_waitcnt vmcnt(0)" ::: "memory");
    __syncthreads();
    if (b.wid == 0u && xb_lane0()) {
        unsigned* bar = b.bar;
        __builtin_amdgcn_s_waitcnt(0);
        unsigned nloc = b.st[0], nx = b.st[1];
        if (nloc == 0u) { xcd_barrier_complete(bar, b.x, nloc, nx); b.st[0] = nloc; b.st[1] = nx; }
        const unsigned old = xb_add(&bar[XB_XSUB(b.x)], 1u);
        const unsigned gen = old / nloc;
        if (old + 1u == (gen + 1u) * nloc) {
            __builtin_amdgcn_fence(__ATOMIC_RELEASE, "agent");
            asm volatile("s_waitcnt vmcnt(0)" ::: "memory");
            const unsigned og = xb_add(&bar[XB_TOP], 1u);
            const unsigned tg = og / nx;
            if (og + 1u == (tg + 1u) * nx) xb_add(&bar[XB_TOPGEN], 1u);
            else XB_SPIN(xb_ld(&bar[XB_TOPGEN]) == tg, bar);
            __builtin_amdgcn_fence(__ATOMIC_ACQUIRE, "agent");
            xb_add(&bar[XB_XGEN(b.x)], 1u);
            asm volatile("s_waitcnt vmcnt(0)" ::: "memory");
        } else {
            XB_SPIN(xb_ld(&bar[XB_XGEN(b.x)]) == gen, bar);
            __builtin_amdgcn_fence(__ATOMIC_ACQUIRE, "agent");
            asm volatile("s_waitcnt vmcnt(0)" ::: "memory");
        }
    }
    __syncthreads();
}

enum { I_X = 0, I_EN1G, I_EWIN, I_CONVW, I_CONVB, I_GATEB, I_MLNG, I_GLAUP, I_GLAB, I_GLANG, I_EWOUT, I_EN2G, I_FFG, I_FFU, I_FFD,
       I_ON1G, I_OWIN, I_RETNG, I_RWMU, I_RWWUP, I_RWW0, I_RWAUP, I_RWA0, I_RWGUP, I_RWKK, I_RWKA, I_RWRK, I_RWLNG, I_RWLNB, I_OWOUT, I_ON2G, I_ROUTER, I_MG, I_MU, I_MD, I_FNG, N_IN };
struct Args { const float* in[N_IN]; float* out; unsigned char* ws; int ph_lo, ph_hi; };
struct Ctx { int tid, lane, wid, G, bid, vb; LAS unsigned char* lds; };

__device__ __forceinline__ void tr_item(const float* W, int K, int N, int nblk, bf16* WT, int mode, const float* gain, LAS float* scr, int item, int lane) {
    const int kb = item / nblk, nb = item % nblk, k0 = 64 * kb, n0 = 32 * nb;
    const int nn = n0 + (lane & 31); const bool ok = nn < N;
    const int c = lane & 7;
    f32x4 ga = {1.f, 1.f, 1.f, 1.f}, gb = ga; if (gain) { ga = *(const GAS f32x4*)(gain + k0 + 8 * c); gb = *(const GAS f32x4*)(gain + k0 + 8 * c + 4); }
    float wv[32];
#pragma unroll
    for (int i = 0; i < 32; ++i) { const int kk = 2 * i + (lane >> 5); wv[i] = ok ? W[(size_t)(k0 + kk) * N + nn] : 0.f; }
#pragma unroll
    for (int i = 0; i < 32; ++i) { const int kk = 2 * i + (lane >> 5); scr[kk * 33 + (lane & 31)] = wv[i]; }
    LDS_WAIT(); asm volatile("" ::: "memory");
#pragma unroll
    for (int j = 0; j < 4; ++j) { const int n = (lane >> 3) + 8 * j; const LAS float* s = scr + (8 * c) * 33 + n;
        v4u o; o.x = pk2(s[0 * 33] * ga[0], s[1 * 33] * ga[1]); o.y = pk2(s[2 * 33] * ga[2], s[3 * 33] * ga[3]); o.z = pk2(s[4 * 33] * gb[0], s[5 * 33] * gb[1]); o.w = pk2(s[6 * 33] * gb[2], s[7 * 33] * gb[3]);
        const int ncol = n0 + n; const int drow = mode == 0 ? ncol : ((ncol >> 7) * 256 + (mode == 2 ? 128 : 0) + (ncol & 127));
        *(GAS v4u*)(WT + (size_t)drow * K + k0 + 8 * c) = o; }
    LDS_WAIT(); asm volatile("" ::: "memory");
}
__device__ __forceinline__ void tr_item8(const float* W, int K, int N, int nblk, unsigned char* WT, int mode, const float* gain, LAS float* scr, int item, int lane) {
    const int kb = item / nblk, nb = item % nblk, k0 = 64 * kb, n0 = 32 * nb;
    const int nn = n0 + (lane & 31); const bool ok = nn < N;
    const int c = lane & 3;
    f32x4 g4[4];
#pragma unroll
    for (int q = 0; q < 4; ++q) { g4[q] = (f32x4){256.f, 256.f, 256.f, 256.f}; if (gain) g4[q] = *(const GAS f32x4*)(gain + k0 + 16 * c + 4 * q) * 256.0f; }
    float wv[32];
#pragma unroll
    for (int i = 0; i < 32; ++i) { const int kk = 2 * i + (lane >> 5); wv[i] = ok ? W[(size_t)(k0 + kk) * N + nn] : 0.f; }
#pragma unroll
    for (int i = 0; i < 32; ++i) { const int kk = 2 * i + (lane >> 5); scr[kk * 33 + (lane & 31)] = wv[i]; }
    LDS_WAIT(); asm volatile("" ::: "memory");
#pragma unroll
    for (int j = 0; j < 2; ++j) { const int n = (lane >> 2) + 16 * j; const LAS float* s = scr + (16 * c) * 33 + n;
        v4u o; o.x = pg8::pk4f8(s[0 * 33] * g4[0][0], s[1 * 33] * g4[0][1], s[2 * 33] * g4[0][2], s[3 * 33] * g4[0][3]); o.y = pg8::pk4f8(s[4 * 33] * g4[1][0], s[5 * 33] * g4[1][1], s[6 * 33] * g4[1][2], s[7 * 33] * g4[1][3]);
        o.z = pg8::pk4f8(s[8 * 33] * g4[2][0], s[9 * 33] * g4[2][1], s[10 * 33] * g4[2][2], s[11 * 33] * g4[2][3]); o.w = pg8::pk4f8(s[12 * 33] * g4[3][0], s[13 * 33] * g4[3][1], s[14 * 33] * g4[3][2], s[15 * 33] * g4[3][3]);
        const int ncol = n0 + n; const int drow = mode == 0 ? ncol : ((ncol >> 7) * 256 + (mode == 2 ? 128 : 0) + (ncol & 127));
        *(GAS v4u*)(WT + (size_t)drow * K + k0 + 16 * c) = o; }
    LDS_WAIT(); asm volatile("" ::: "memory");
}
struct TrJob { const float* W; int K, N, nblk; bf16* WT; int mode; const float* gain; };
__device__ __forceinline__ void tr_run(const TrJob& j, LAS float* scr, int gw, int NGW, int lane) {
    const int nitems = (j.K / 64) * j.nblk;
    for (int it = gw; it < nitems; it += NGW) tr_item(j.W, j.K, j.N, j.nblk, j.WT, j.mode, j.gain, scr, it, lane);
}
struct TrJob8 { const float* W; int K, N, nblk; unsigned char* WT; int mode; const float* gain; };
__device__ __forceinline__ void tr_run8(const TrJob8& j, LAS float* scr, int gw, int NGW, int lane) {
    const int nitems = (j.K / 64) * j.nblk;
    for (int it = gw; it < nitems; it += NGW) tr_item8(j.W, j.K, j.N, j.nblk, j.WT, j.mode, j.gain, scr, it, lane);
}
__device__ __forceinline__ void layer_weights_late(const Args& A, const Ctx& C, int gw, int NGW) {
    LAS float* scr = (LAS float*)(C.lds + C.wid * 16384); unsigned char* ws = A.ws;
    { TrJob j{A.in[I_EWOUT], D, D, D / 32, (bf16*)(ws + WS_W_EOUT), 0, nullptr}; tr_run(j, scr, gw, NGW, C.lane); }
#if FFN8_UP
    { TrJob8 j{A.in[I_FFG], D, FF, FF / 32, ws + WS_W_FGU, 1, A.in[I_EN2G]}; tr_run8(j, scr, gw, NGW, C.lane); }
    { TrJob8 j{A.in[I_FFU], D, FF, FF / 32, ws + WS_W_FGU, 2, A.in[I_EN2G]}; tr_run8(j, scr, gw, NGW, C.lane); }
#if FFN8_UP == 2
    { TrJob8 j{A.in[I_FFD], FF, D, D / 32, ws + WS_W_FDN, 0, nullptr}; tr_run8(j, scr, gw, NGW, C.lane); }
#else
    { TrJob j{A.in[I_FFD], FF, D, D / 32, (bf16*)(ws + WS_W_FDN), 0, nullptr}; tr_run(j, scr, gw, NGW, C.lane); }
#endif
#else
    { TrJob j{A.in[I_FFG], D, FF, FF / 32, (bf16*)(ws + WS_W_FGU), 1, A.in[I_EN2G]}; tr_run(j, scr, gw, NGW, C.lane); }
    { TrJob j{A.in[I_FFU], D, FF, FF / 32, (bf16*)(ws + WS_W_FGU), 2, A.in[I_EN2G]}; tr_run(j, scr, gw, NGW, C.lane); }
    { TrJob8 j{A.in[I_FFD], FF, D, D / 32, ws + WS_W_FDN, 0, nullptr}; tr_run8(j, scr, gw, NGW, C.lane); }
#endif
    { TrJob j{A.in[I_OWIN], D, PW, PW / 32, (bf16*)(ws + WS_W_OIN), 0, A.in[I_ON1G]}; tr_run(j, scr, gw, NGW, C.lane); }
    { TrJob j{A.in[I_OWOUT], D, D, D / 32, (bf16*)(ws + WS_W_OOUT), 0, nullptr}; tr_run(j, scr, gw, NGW, C.lane); }
}
__device__ __forceinline__ void p0_prologue(const Args& A, const Ctx& C) {
    LAS float* scr = (LAS float*)(C.lds + C.wid * 16384);
    const int gw = C.bid * NWAVES + C.wid, NGW = C.G * NWAVES;
    unsigned char* ws = A.ws;
    { TrJob j{A.in[I_EWIN], D, 3608, PW / 32, (bf16*)(ws + WS_W_EIN), 0, A.in[I_EN1G]}; tr_run(j, scr, gw, NGW, C.lane); }
    if (C.G != 256) layer_weights_late(A, C, gw, NGW);
    { TrJob j{A.in[I_RWWUP], 64, 512, 16, (bf16*)(ws + WS_LORA), 0, nullptr}; tr_run(j, scr, gw, NGW, C.lane); }
    { TrJob j{A.in[I_RWAUP], 64, 512, 16, (bf16*)(ws + WS_LORA + 65536), 0, nullptr}; tr_run(j, scr, gw, NGW, C.lane); }
    { TrJob j{A.in[I_RWGUP], 128, 512, 16, (bf16*)(ws + WS_LORA + 131072), 0, nullptr}; tr_run(j, scr, gw, NGW, C.lane); }
    { unsigned* tcs = (unsigned*)(ws + WS_ROT);
      for (int e = C.bid * NTHR + C.tid; e < T * 64; e += C.G * NTHR) { const int t = e >> 6, i = e & 63;
          const float inv = exp2f(-(float)(2 * i) * (1.0f / 128.0f) * 13.287712379549449f);
          double rev = (double)((float)t * inv) * 0.15915494309189535; rev -= __builtin_rint(rev); const float fr = (float)rev;
          tcs[e] = pk2(__builtin_amdgcn_cosf(fr), __builtin_amdgcn_sinf(fr)); } }
    { const float* x = A.in[I_X]; bf16* xb = (bf16*)(ws + WS_HB0); float* ssp = (float*)(ws + WS_SSP);
      const int rpw = M / C.G, mb = C.vb * rpw;
      for (int i0 = C.wid; i0 < rpw; i0 += 2 * NWAVES) { const int m0 = mb + i0; f32x4 v[2][4];
#pragma unroll
          for (int r = 0; r < 2; ++r) { const int mr = (i0 + r * NWAVES < rpw) ? m0 + r * NWAVES : m0; const GAS f32x4* xr = (const GAS f32x4*)(x + (size_t)mr * D) + C.lane;
#pragma unroll
              for (int j = 0; j < 4; ++j) v[r][j] = xr[64 * j]; }
#pragma unroll
          for (int r = 0; r < 2; ++r) { const int m = m0 + r * NWAVES; if (i0 + r * NWAVES >= rpw) break; GAS v2u* o8 = (GAS v2u*)(xb + (size_t)m * D) + C.lane; float s = 0.f;
#pragma unroll
              for (int j = 0; j < 4; ++j) { const f32x4 t = v[r][j]; s += (t[0] * t[0] + t[1] * t[1]) + (t[2] * t[2] + t[3] * t[3]); v2u w; w.x = pk2(t[0], t[1]); w.y = pk2(t[2], t[3]); o8[64 * j] = w; }
              s = wave_sum(s);
              if (C.lane < 16) ssp[(size_t)m * 16 + C.lane] = C.lane == 0 ? s : 0.f; } } }
}
__device__ __forceinline__ void moe_weights(const Args& A, const Ctx& C, unsigned gu_mask, unsigned d_mask, int gw, int NGW) {
    LAS float* scr = (LAS float*)(C.lds + C.wid * 16384);
    for (int e = 0; e < 8; ++e) {
        if ((gu_mask >> e) & 1u) {
            { TrJob8 j{A.in[I_MG] + (size_t)e * D * FF, D, FF, FF / 32, A.ws + WS_W_MGU + (size_t)e * 2 * FF * D, 1, A.in[I_ON2G]}; tr_run8(j, scr, gw, NGW, C.lane); }
            { TrJob8 j{A.in[I_MU] + (size_t)e * D * FF, D, FF, FF / 32, A.ws + WS_W_MGU + (size_t)e * 2 * FF * D, 2, A.in[I_ON2G]}; tr_run8(j, scr, gw, NGW, C.lane); } }
        if ((d_mask >> e) & 1u) { TrJob8 j{A.in[I_MD] + (size_t)e * FF * D, FF, D, D / 32, A.ws + WS_W_MDN + (size_t)e * D * FF, 0, nullptr}; tr_run8(j, scr, gw, NGW, C.lane); } }
}

template <int KS, bool SWA = false, bool SWB = false> __device__ __forceinline__ f32x4 mma_rows(const LAS unsigned char* A, int lda, int m0, const LAS unsigned char* Bt, int ldb, int n0, f32x4 acc, int lane) {
    const int r = lane & 15, q = lane >> 4;
    const int sa = SWA ? (((m0 + r) >> 3) & 7) : 0, sb = SWB ? (((n0 + r) >> 3) & 7) : 0;
#pragma unroll
    for (int ks = 0; ks < KS; ++ks) {
        const bf16x8 a = *(const LAS bf16x8*)(A + (m0 + r) * lda + (((ks * 4 + q) ^ sa) * 16));
        const bf16x8 b = *(const LAS bf16x8*)(Bt + (n0 + r) * ldb + (((ks * 4 + q) ^ sb) * 16));
        acc = __builtin_amdgcn_mfma_f32_16x16x32_bf16(a, b, acc, 0, 0, 0);
    }
    return acc;
}
struct MixArgs {
    const bf16* P; int pitch;
    bf16* out;
    const float *convw, *convb, *gateb, *normg;
    const float *gup, *gb;
    float* snap;
    const unsigned* rcs;
};
__device__ __forceinline__ void scatter8x2(LAS unsigned char* base, int ld, int col0, int j0, const v4u a, const v4u b) {
    const unsigned aa[4] = {a.x, a.y, a.z, a.w}, bb[4] = {b.x, b.y, b.z, b.w};
    const int js = j0 ^ (((col0 >> 3) & 7) << 3);
#pragma unroll
    for (int i = 0; i < 8; ++i) { const unsigned lo = (aa[i >> 1] >> (16 * (i & 1))) & 0xffffu, hi = (bb[i >> 1] >> (16 * (i & 1))) & 0xffffu; *(LAS unsigned*)(base + (col0 + i) * ld + 2 * js) = lo | (hi << 16); }
}
template <int KIND>
__device__ __forceinline__ void mixer_unit(const MixArgs& X, const Ctx& C, int b, int h, int seg, int nseg, int pass) {
    constexpr int L = 64, DK = (KIND == 1) ? 64 : 128, DV = 128;
    constexpr int LDK = (DK + 8) * 2, LDL = (L + 8) * 2;
    constexpr int OFF_Q = 0, SZ_Q = L * LDK, OFF_K = OFF_Q + SZ_Q, OFF_KT = OFF_K + SZ_Q, SZ_KT = DK * LDL, OFF_PM = OFF_KT + SZ_KT, SZ_PM = L * LDL, OFF_VT = OFF_PM + SZ_PM, SZ_VT = DV * LDL,
                  OFF_ST = OFF_VT + SZ_VT, SZ_ST = DV * LDK, OFF_SC = OFF_ST + SZ_ST, SCB = (KIND == 1) ? 24576 : 8192, OFF_HS = 0;
    constexpr int HSLD = 132;
    static_assert(OFF_SC + SCB <= RING_BYTES && L * HSLD * 4 <= ((KIND == 1) ? OFF_VT : OFF_KT), "mixer LDS map");
    constexpr int SC_U = 0, SC_MM = 64, SC_RS = 128, SC_EM = 192, SC_CS = 256, SC_DEN = 320, SC_NV = 384, SC_CD = 512, SC_TAB = 576;
    constexpr int SC_LA = 0, LALD = 65, SC_GUP = SC_LA + 64 * LALD, SC_GB = SC_GUP + 1024, SC_GG = SC_GB + 64, SC_GS = SC_GG + 64;
    static_assert((SC_GS + 64) * 4 <= 24576 && (SC_TAB + 1280) * 4 <= 8192, "scalar region");
    LAS unsigned char* lds = C.lds;
    LAS unsigned char* Qs = lds + OFF_Q; LAS unsigned char* Ks = lds + OFF_K; LAS unsigned char* Kt = lds + OFF_KT; LAS unsigned char* Vt = lds + OFF_VT;
    LAS unsigned char* St = lds + OFF_ST; LAS unsigned char* Pm = lds + OFF_PM; LAS float* SC = (LAS float*)(lds + OFF_SC); LAS float* Hs = (LAS float*)(lds + OFF_HS);
    int tid = C.tid; asm volatile("" : "+v"(tid));
    const int lane = tid & 63, wid = C.wid, q4 = lane >> 4, r16 = lane & 15;
    const bf16* P = X.P; const int pitch = X.pitch;
    const float qscale = (KIND == 1) ? 0.125f : 0.08838834764831845f;
    const int c0 = (64 * seg) / nseg, c1 = (64 * (seg + 1)) / nseg;
    const bool full = pass == 1;
    constexpr int SNAP_F = (DK / 16) * 512 * 4 + 256;
    float* snap_base = X.snap + (size_t)((b * 4 + h) * nseg) * SNAP_F;
    LDS_SYNC();
    for (int i = tid; i < SZ_ST / 4; i += NTHR) ((LAS unsigned*)St)[i] = 0u;
    LAS float* NG = (LAS float*)(lds + LDSCTL_OFF + 8192);
    {
        const float ngv = X.normg[h * 128 + (tid & 127)]; float t0 = 0.f, t1 = 0.f, t2 = 0.f;
        if (KIND == 0) { const int k = (tid >> 7) & 3, c = tid & 127, tb = tid & 255; t0 = X.convw[k * 1024 + h * 128 + c]; t1 = X.convw[k * 1024 + 512 + h * 128 + c]; t2 = X.convb[(tb >> 7) * 512 + h * 128 + (tb & 127)]; }
        if (KIND == 1) { t0 = X.gup[(tid >> 6) * 256 + h * 64 + (tid & 63)]; t1 = X.gup[((tid + 512) >> 6) * 256 + h * 64 + (tid & 63)]; t2 = X.gb[h * 64 + (tid & 63)]; }
        if (tid < 128) NG[tid] = ngv;
        if (KIND == 0) { if (tid < 128) SC[SC_NV + tid] = 0.f; SC[SC_TAB + tid] = t0; SC[SC_TAB + 512 + tid] = t1; if (tid < 256) SC[SC_TAB + 1024 + tid] = t2; }
        if (KIND == 1) { SC[SC_GUP + tid] = t0; SC[SC_GUP + 512 + tid] = t1; if (tid < 64) SC[SC_GB + tid] = t2; } }
    float lg2 = 0.f;
    if (KIND == 2) lg2 = log2f(1.0f - exp2f(-5.0f - (float)h));
    float mprev = -1e30f, fsum = 0.f;
    constexpr int NST = DK / 16;
    f32x4 accs[NST];
#pragma unroll
    for (int i = 0; i < NST; ++i) accs[i] = (f32x4){0.f, 0.f, 0.f, 0.f};
    const int s_dkt = (DK == 64) ? (wid >> 1) : wid, s_et0 = (DK == 64) ? 4 * (wid & 1) : 0;
    constexpr int NOT = 4;
    const int o_rt = wid >> 1, o_et0 = 4 * (wid & 1);
    const int cc = tid & 15, r0 = tid >> 4, j0 = 2 * r0;
    const int ei = tid >> 3, esub = tid & 7;
    v4u pq[5], pk[5], pv[2], pe_cur[2];
    v4u pcs[2][2];
    v4u pgl[2]; unsigned pgi = 0u, pgf = 0u;
    float gb_i = 0.f, gb_f = 0.f; if (KIND == 0) { gb_i = X.gateb[h]; gb_f = X.gateb[4 + h]; }
#define MIX_LOAD(c_, full_) do { const int t0_ = (c_) * L; const size_t g0_ = (size_t)b * T + t0_; \
        if (KIND == 0) { \
            if (wid == 0) { pgi = P[(g0_ + lane + lz) * pitch + 2048 + h]; pgf = P[(g0_ + lane + lz) * pitch + 2052 + h]; } } \
        if (KIND == 2) { const int s_ = ccv >> 3, c8_ = ccv & 7; \
            _Pragma("unroll") for (int rr = 0; rr < 2; ++rr) { const int j = j0v + rr; \
                { const bf16* src = P + (g0_ + j) * pitch + s_ * 512 + h * 128 + 8 * c8_; pq[2 * rr] = *(const GAS v4u*)src; pq[2 * rr + 1] = *(const GAS v4u*)(src + 64);   \
                    const GAS v4u* pc_ = (const GAS v4u*)(X.rcs + (size_t)(t0_ + j) * 64 + 8 * c8_); pcs[rr][0] = pc_[0]; pcs[rr][1] = pc_[1]; } \
                pv[rr] = *(const GAS v4u*)(P + (g0_ + j) * pitch + 1024 + h * 128 + 8 * ccv); } } \
        if (KIND == 1) { const int s_ = tid >> 8, jp_ = 2 * ((tid >> 3) & 31) + lz, c8_ = (tid & 7) + lz; \
            { _Pragma("unroll") for (int rr = 0; rr < 2; ++rr) pq[rr] = *(const GAS v4u*)(P + (g0_ + jp_ + rr) * pitch + 2056 + 256 * s_ + h * 64 + 8 * c8_); } \
            _Pragma("unroll") for (int rr = 0; rr < 2; ++rr) pv[rr] = *(const GAS v4u*)(P + (g0_ + j0v + rr) * pitch + 2568 + h * 128 + 8 * ccv); \
            const GAS v4u* gp_ = (const GAS v4u*)(P + (g0_ + lane + lz) * pitch + 3592); pgl[0] = gp_[0]; pgl[1] = gp_[1]; } \
    } while (0)
#define MIX_LOAD_NOW(c_, full_) do { const int t0_ = (c_) * L; \
        if (KIND == 0) { \
            _Pragma("unroll") for (int k = 0; k < 5; ++k) { const int tt = t0_ + j0v - 3 + k; const bool okr = tt >= 0; const size_t ro = ((size_t)b * T + (okr ? tt : 0)) * pitch + h * 128 + 8 * ccv; \
                { pq[k] = *(const GAS v4u*)(P + ro); if (!okr) pq[k] = (v4u){0u, 0u, 0u, 0u}; } \
                pk[k] = *(const GAS v4u*)(P + ro + 512); if (!okr) pk[k] = (v4u){0u, 0u, 0u, 0u}; } \
            _Pragma("unroll") for (int rr = 0; rr < 2; ++rr) pv[rr] = *(const GAS v4u*)(P + ((size_t)b * T + t0_ + j0v + rr) * pitch + 1024 + h * 128 + 8 * ccv); } \
    } while (0)
#define MIX_LOAD_E(c_) do { const size_t g0_ = (size_t)b * T + (c_) * L; const int eo_ = (KIND == 1) ? 3080 : 1536; const GAS v4u* ep_ = (const GAS v4u*)(P + (g0_ + eiv) * pitch + eo_ + h * 128 + 16 * esubv); pe_cur[0] = ep_[0]; pe_cur[1] = ep_[1]; } while (0)
    { int lz = 0; asm volatile("" : "+v"(lz)); const int j0v = j0 + lz, ccv = cc + lz; MIX_LOAD(c0, full); }
    if (KIND == 1) { for (int i = tid; i < 64; i += NTHR) SC[SC_GS + i] = 0.f; }
    if (pass == 1) {
        f32x4 nsv[NST], nax = {0.f, 0.f, 0.f, 0.f}; float nm = 0.f, nF = 0.f, nnv = 0.f;
#define MIX_FOLD_LOAD(j_) do { const float* sp_ = snap_base + (size_t)(j_) * SNAP_F; const float* aux_ = sp_ + NST * 2048; \
            _Pragma("unroll") for (int x = 0; x < NST; ++x) nsv[x] = *(const GAS f32x4*)(sp_ + (x * 512 + tid) * 4); \
            if (KIND == 0) { nm = aux_[128]; nF = aux_[129]; nnv = aux_[tid & 127]; } \
            if (KIND == 1) nax = *(const GAS f32x4*)(aux_ + 16 * s_dkt + 4 * q4); } while (0)
        if (seg > 0) MIX_FOLD_LOAD(0);
        for (int j = 0; j < seg; ++j) {
            f32x4 csv[NST]; const f32x4 cax = nax; const float cm = nm, cF = nF, cnv = nnv;
#pragma unroll
            for (int x = 0; x < NST; ++x) csv[x] = nsv[x];
            { const int jn_ = (j + 1 < seg) ? j + 1 : j; MIX_FOLD_LOAD(jn_); }
            float fa = 1.f, fb = 1.f;
            if (KIND == 0) { const float mn = fmaxf(mprev + cF, cm); fa = fexp(mprev + cF - mn); fb = fexp(cm - mn); mprev = mn; }
            if (KIND == 2) fa = __builtin_amdgcn_exp2f(lg2 * (float)(64 * ((64 * (j + 1)) / nseg - (64 * j) / nseg)));
#pragma unroll
            for (int x = 0; x < NST; ++x) { f32x4 a = accs[x];
                if (KIND == 1) {
#pragma unroll
                    for (int r = 0; r < 4; ++r) a[r] *= fexp(cax[r]);
                } else a = a * fa;
                accs[x] = a + csv[x] * fb; }
            if (KIND == 0 && tid < 128) SC[SC_NV + tid] = fa * SC[SC_NV + tid] + fb * cnv; }
#undef MIX_FOLD_LOAD
#pragma unroll
        for (int x = 0; x < NST; ++x) { const int e = 16 * (s_et0 + x) + r16; v2u w; w.x = pk2(accs[x][0], accs[x][1]); w.y = pk2(accs[x][2], accs[x][3]);
            *(LAS v2u*)(St + e * LDK + 2 * (16 * s_dkt + 4 * q4)) = w; }
    }
    LDS_SYNC();

    for (int c = c0; c < c1; ++c) {
        const int t0 = c * L; const size_t grow0 = (size_t)b * T + t0;
        int lz = 0; asm volatile("" : "+v"(lz));
        const int j0v = j0 + lz, ccv = cc + lz, eiv = ei + lz, esubv = esub + lz, lv = lane + lz, q4v = lv >> 4, r16v = lv & 15;
        MIX_LOAD_NOW(c, full);
        MIX_LOAD_E(c);
        if (KIND == 0) {
            if (wid == 0) {
                const float ip = bf2f((bf16)pgi) + gb_i, fp = bf2f((bf16)pgf) + gb_f;
                const float bs = wave_scan_add(log_sigmoid(fp));
                const float u = ip - bs, am = wave_scan_max(u);
                const float Mi = fmaxf(mprev, am), g = lane63(bs), Ml = lane63(Mi);
                SC[SC_U + lane] = u; SC[SC_MM + lane] = Mi; SC[SC_RS + lane] = fexp(mprev - Mi); SC[SC_EM + lane] = fexp(-(bs + Mi)); SC[SC_CS + lane] = fexp(u - Ml);
                if (lane == 0) SC[SC_CD] = fexp(mprev - Ml);
                mprev = g + Ml; fsum += g; }
            LDS_SYNC();
        }
        if (KIND == 1) {
            float gl[16]; { float t8[8]; unpack8(pgl[0], t8);
#pragma unroll
                for (int i = 0; i < 8; ++i) gl[i] = t8[i]; unpack8(pgl[1], t8);
#pragma unroll
                for (int i = 0; i < 8; ++i) gl[8 + i] = t8[i]; }
#pragma unroll
            for (int k = 0; k < 8; ++k) { const int d = lz + wid * 8 + k; float z = SC[SC_GB + d];
#pragma unroll
                for (int r = 0; r < 16; ++r) z += gl[r] * SC[SC_GUP + r * 64 + d];
                const float v = wave_scan_add(log_sigmoid(z) * (1.0f / 16.0f));
                SC[SC_LA + lane * LALD + d] = v; if (lane == 63) { SC[SC_GG + d] = v; SC[SC_GS + d] += v; } }
            LDS_SYNC();
        }
        {
        if (KIND == 0) {
            v4u kt2[2];
#pragma unroll
            for (int rr = 0; rr < 2; ++rr) { const int j = j0 + rr;
#pragma unroll
                for (int s = 0; s < 2; ++s) {
                    if (s == 0 && !full) continue;
                    float acc[8];
#pragma unroll
                    for (int i = 0; i < 8; ++i) acc[i] = SC[lz + SC_TAB + 1024 + s * 128 + 8 * cc + i];
#pragma unroll
                    for (int k = 0; k < 4; ++k) { float xv[8]; unpack8(s == 0 ? pq[rr + k] : pk[rr + k], xv);
#pragma unroll
                        for (int i = 0; i < 8; ++i) acc[i] += xv[i] * SC[lz + SC_TAB + (s * 4 + k) * 128 + 8 * cc + i]; }
#pragma unroll
                    for (int i = 0; i < 8; ++i) acc[i] = acc[i] * fsig(acc[i]);
                    if (s == 0) {
#pragma unroll
                        for (int i = 0; i < 8; ++i) acc[i] *= qscale;
                        *(LAS v4u*)(Qs + j * LDK + 16 * cc) = pack8(acc);
                    } else {
                        *(LAS v4u*)(Ks + j * LDK + 16 * cc) = pack8(acc);
                        const float cs = SC[SC_CS + j];
#pragma unroll
                        for (int i = 0; i < 8; ++i) acc[i] *= cs;
                        kt2[rr] = pack8(acc);
                    }
                    __builtin_amdgcn_sched_barrier(0);
                } }
            scatter8x2(Kt, LDL, 8 * cc, j0, kt2[0], kt2[1]); scatter8x2(Vt, LDL, 8 * cc, j0, pv[0], pv[1]);
        }
        if (KIND == 2) {
            const int s = cc >> 3, c8 = cc & 7; v4u kt1[2], kt2[2];
#pragma unroll
            for (int rr = 0; rr < 2; ++rr) { const int j = j0 + rr;
                if (full || s == 1) {
                    float x1[8], x2[8]; unpack8(pq[2 * rr], x1); unpack8(pq[2 * rr + 1], x2);
                    const unsigned csw[8] = {pcs[rr][0].x, pcs[rr][0].y, pcs[rr][0].z, pcs[rr][0].w, pcs[rr][1].x, pcs[rr][1].y, pcs[rr][1].z, pcs[rr][1].w};
                    float o1[8], o2[8];
#pragma unroll
                    for (int i = 0; i < 8; ++i) { const float cv = bflo(csw[i]), sv = bfhi(csw[i]); o1[i] = x1[i] * cv - x2[i] * sv; o2[i] = x1[i] * sv + x2[i] * cv; }
                    if (s == 0) {
#pragma unroll
                        for (int i = 0; i < 8; ++i) { o1[i] *= qscale; o2[i] *= qscale; }
                        *(LAS v4u*)(Qs + j * LDK + 16 * c8) = pack8(o1); *(LAS v4u*)(Qs + j * LDK + 128 + 16 * c8) = pack8(o2);
                    } else {
                        *(LAS v4u*)(Ks + j * LDK + 16 * c8) = pack8(o1); *(LAS v4u*)(Ks + j * LDK + 128 + 16 * c8) = pack8(o2);
                        const float cs = __builtin_amdgcn_exp2f(lg2 * (float)(L - 1 - j));
#pragma unroll
                        for (int i = 0; i < 8; ++i) { o1[i] *= cs; o2[i] *= cs; }
                        kt1[rr] = pack8(o1); kt2[rr] = pack8(o2);
                    } }
                __builtin_amdgcn_sched_barrier(0); }
            if (s == 1) { scatter8x2(Kt, LDL, 8 * c8, j0, kt1[0], kt1[1]); scatter8x2(Kt, LDL, 64 + 8 * c8, j0, kt2[0], kt2[1]); }
            scatter8x2(Vt, LDL, 8 * cc, j0, pv[0], pv[1]);
        }
        if (KIND == 1) {
            { const int sk = tid >> 8, jp = 2 * ((tid >> 3) & 31), c8 = tid & 7; v4u kw[2];
              if (full || sk == 1) {
#pragma unroll
                  for (int rr = 0; rr < 2; ++rr) { const int j = jp + rr; float xv[8]; unpack8(pq[rr], xv);
#pragma unroll
                      for (int i = 0; i < 8; ++i) { const float bvv = SC[SC_LA + j * LALD + 8 * c8 + i]; xv[i] *= (sk == 0) ? qscale * fexp(bvv) : fexp(-bvv); }
                      kw[rr] = pack8(xv);
                      *(LAS v4u*)((sk == 0 ? Qs : Ks) + j * LDK + 16 * c8) = kw[rr]; }
                  if (sk == 1) scatter8x2(Kt, LDL, 8 * c8, jp, kw[0], kw[1]); } }
            scatter8x2(Vt, LDL, 8 * cc, j0, pv[0], pv[1]);
        }
        }
        { const int cn_ = (c + 1 < c1) ? c + 1 : c; MIX_LOAD(cn_, full); }
        LDS_SYNC();
        f32x4 acco[NOT];
        if (full) {
            const int jt = wid >> 1;
#pragma unroll
            for (int x = 0; x < 2; ++x) { const int it = 2 * (wid & 1) + x;
                f32x4 s = (f32x4){0.f, 0.f, 0.f, 0.f};
                if (jt <= it) s = mma_rows<DK / 32>(Ks, LDK, 16 * jt, Qs, LDK, 16 * it, s, lv);
                const int i = 16 * it + r16v, j0 = 16 * jt + 4 * q4v; float p[4];
#pragma unroll
                for (int r = 0; r < 4; ++r) { const int j = j0 + r; float dcy;
                    if (KIND == 0) dcy = fexp(SC[SC_U + j] - SC[SC_MM + i]); else if (KIND == 2) dcy = __builtin_amdgcn_exp2f(lg2 * (float)(i - j)); else dcy = 1.f;
                    p[r] = (j <= i) ? s[r] * dcy : 0.f; }
                v2u w; w.x = pk2(p[0], p[1]); w.y = pk2(p[2], p[3]); *(LAS v2u*)(Pm + i * LDL + 2 * j0) = w; }
#pragma unroll
            for (int x = 0; x < NOT; ++x) { acco[x] = mma_rows<DK / 32>(Qs, LDK, 16 * o_rt, St, LDK, 16 * (o_et0 + x), (f32x4){0.f, 0.f, 0.f, 0.f}, lv);
                if (KIND != 1) {
#pragma unroll
                    for (int r = 0; r < 4; ++r) { const int i = 16 * o_rt + 4 * q4v + r; const float rs = (KIND == 0) ? SC[SC_RS + i] : __builtin_amdgcn_exp2f(lg2 * (float)(i + 1)); acco[x][r] *= rs; } }
                if (x & 1) asm volatile("" ::: "memory"); }
        }
        LDS_SYNC();
        if (full) {
#pragma unroll
            for (int x = 0; x < NOT; ++x) { acco[x] = mma_rows<L / 32, false, true>(Pm, LDL, 16 * o_rt, Vt, LDL, 16 * (o_et0 + x), acco[x], lv); if (x & 1) asm volatile("" ::: "memory"); }
            if (KIND == 0) { const int i = tid >> 3, sub = tid & 7; float pvv[8]; unpack8(*(const LAS v4u*)(Pm + i * LDL + 16 * sub), pvv);
                float ps = ((pvv[0] + pvv[1]) + (pvv[2] + pvv[3])) + ((pvv[4] + pvv[5]) + (pvv[6] + pvv[7])); float qn = 0.f;
#pragma unroll
                for (int hh = 0; hh < 2; ++hh) { float qv[8]; unpack8(*(const LAS v4u*)(Qs + i * LDK + 32 * sub + 16 * hh), qv);
#pragma unroll
                    for (int e = 0; e < 8; ++e) qn += qv[e] * SC[SC_NV + 16 * sub + 8 * hh + e]; }
                float v = ps + SC[SC_RS + i] * qn; v += __shfl_xor(v, 1); v += __shfl_xor(v, 2); v += __shfl_xor(v, 4);
                if (sub == 0) SC[SC_DEN + i] = v; }
        }
        { float pre = 1.f; if (KIND == 0) pre = SC[SC_CD]; if (KIND == 2) pre = __builtin_amdgcn_exp2f(lg2 * (float)L);
#pragma unroll
          for (int x = 0; x < NST; ++x) { f32x4 a = accs[x] * pre; a = mma_rows<L / 32, true, true>(Kt, LDL, 16 * s_dkt, Vt, LDL, 16 * (s_et0 + x), a, lv);
              if (KIND == 1) {
#pragma unroll
                  for (int r = 0; r < 4; ++r) a[r] *= fexp(SC[SC_GG + 16 * s_dkt + 4 * q4v + r]); }
              accs[x] = a; if (x & 1) asm volatile("" ::: "memory"); } }
        LDS_SYNC();
        if (full) {
#pragma unroll
            for (int x = 0; x < NOT; ++x)
#pragma unroll
                for (int r = 0; r < 4; ++r) { const int i = 16 * o_rt + 4 * q4v + r, e = 16 * (o_et0 + x) + r16v; float v = acco[x][r];
                    if (KIND == 0) v = v * __builtin_amdgcn_rcpf(fmaxf(fabsf(SC[SC_DEN + i]), SC[SC_EM + i]));
                    Hs[i * HSLD + e] = v; }
        }
        if (KIND == 0 && tid < 128) { float s = 0.f;
#pragma unroll
            for (int k = 0; k < 8; ++k) { float kv[8]; unpack8(*(const LAS v4u*)(Kt + tid * LDL + 16 * k), kv); s += ((kv[0] + kv[1]) + (kv[2] + kv[3])) + ((kv[4] + kv[5]) + (kv[6] + kv[7])); }
            SC[SC_NV + tid] = SC[SC_CD] * SC[SC_NV + tid] + s; }
#pragma unroll
        for (int x = 0; x < NST; ++x) { const int e = 16 * (s_et0 + x) + r16v; v2u w; w.x = pk2(accs[x][0], accs[x][1]); w.y = pk2(accs[x][2], accs[x][3]);
            *(LAS v2u*)(St + e * LDK + 2 * (16 * s_dkt + 4 * q4v)) = w; }
        LDS_SYNC();
        if (full) {
            const size_t row = grow0 + ei; float o[16];
#pragma unroll
            for (int k = 0; k < 4; ++k) { const f32x4 a = *(const LAS f32x4*)(Hs + ei * HSLD + 16 * esub + 4 * k); o[4 * k] = a[0]; o[4 * k + 1] = a[1]; o[4 * k + 2] = a[2]; o[4 * k + 3] = a[3]; }
            float gt[16]; { float t8[8]; unpack8(pe_cur[0], t8);
#pragma unroll
                for (int e = 0; e < 8; ++e) gt[e] = t8[e]; unpack8(pe_cur[1], t8);
#pragma unroll
                for (int e = 0; e < 8; ++e) gt[8 + e] = t8[e]; }
            if (KIND == 0) {
#pragma unroll
                for (int e = 0; e < 16; ++e) o[e] *= fsig(gt[e]); }
            float sm = 0.f;
            if (KIND != 1) {
#pragma unroll
                for (int e = 0; e < 16; ++e) sm += o[e];
                sm += __shfl_xor(sm, 1); sm += __shfl_xor(sm, 2); sm += __shfl_xor(sm, 4); }
            const float mean = sm * (1.0f / 128.0f); float vs = 0.f;
#pragma unroll
            for (int e = 0; e < 16; ++e) { o[e] -= mean; vs += o[e] * o[e]; }
            vs += __shfl_xor(vs, 1); vs += __shfl_xor(vs, 2); vs += __shfl_xor(vs, 4);
            const float rinv = __builtin_amdgcn_rsqf(vs * (1.0f / 128.0f) + 1e-6f);
            const int ocol = ((KIND == 1) ? 512 : 0) + h * 128 + 16 * esub;
#pragma unroll
            for (int e = 0; e < 16; ++e) { float v = o[e] * rinv * NG[lz + 16 * esub + e]; if (KIND != 0) v *= gt[e] * fsig(gt[e]); o[e] = v; }
            float lo8[8], hi8[8];
#pragma unroll
            for (int e = 0; e < 8; ++e) { lo8[e] = o[e]; hi8[e] = o[8 + e]; }
            GAS v4u* dst = (GAS v4u*)(X.out + row * 1024 + ocol); dst[0] = pack8(lo8); dst[1] = pack8(hi8);
            LDS_SYNC();
        }
    }
    if (pass == 0) {
        float* sp = snap_base + (size_t)seg * SNAP_F; float* aux = sp + NST * 2048;
#pragma unroll
        for (int x = 0; x < NST; ++x) *(GAS f32x4*)(sp + (x * 512 + tid) * 4) = accs[x];
        if (KIND == 0) { if (tid < 128) aux[tid] = SC[SC_NV + tid]; if (tid == 0) { aux[128] = mprev; aux[129] = fsum; } }
        if (KIND == 1) { if (tid < 64) aux[tid] = SC[SC_GS + tid]; }
    }
#undef MIX_LOAD
#undef MIX_LOAD_NOW
#undef MIX_LOAD_E
}

typedef short s16x4 __attribute__((ext_vector_type(4)));
#define DPP_ADD(v, ctrl) ((v) + __builtin_bit_cast(float, __builtin_amdgcn_update_dpp(0, __builtin_bit_cast(int, (v)), (ctrl), 0xf, 0xf, true)))
__device__ __forceinline__ float row16_sum(float v) { v = DPP_ADD(v, 0xB1); v = DPP_ADD(v, 0x4E); v = DPP_ADD(v, 0x141); v = DPP_ADD(v, 0x140); return v; }
__device__ __forceinline__ float row16_scan(float v) { v = DPP_ADD(v, 0x111); v = DPP_ADD(v, 0x112); v = DPP_ADD(v, 0x114); v = DPP_ADD(v, 0x118); return v; }
__device__ __forceinline__ f32x4 mfma32(bf16x8 a, bf16x8 b, f32x4 c) { return __builtin_amdgcn_mfma_f32_16x16x32_bf16(a, b, c, 0, 0, 0); }
__device__ __forceinline__ f32x4 mfma16(s16x4 a, s16x4 b, f32x4 c) { bf16x8 a8, b8; a8[0] = a[0]; a8[1] = a[1]; a8[2] = a[2]; a8[3] = a[3]; a8[4] = 0; a8[5] = 0; a8[6] = 0; a8[7] = 0;
    b8[0] = b[0]; b8[1] = b[1]; b8[2] = b[2]; b8[3] = b[3]; b8[4] = 0; b8[5] = 0; b8[6] = 0; b8[7] = 0; return mfma32(a8, b8, c); }
__device__ __forceinline__ s16x4 pk4(float a, float b, float c, float d) { v2u w; w.x = pk2(a, b); w.y = pk2(c, d); return __builtin_bit_cast(s16x4, w); }
__device__ __forceinline__ s16x4 pk4v(f32x4 v) { return pk4(v[0], v[1], v[2], v[3]); }
__device__ __forceinline__ bf16x8 cat8(s16x4 lo, s16x4 hi) { bf16x8 r; r[0] = lo[0]; r[1] = lo[1]; r[2] = lo[2]; r[3] = lo[3]; r[4] = hi[0]; r[5] = hi[1]; r[6] = hi[2]; r[7] = hi[3]; return r; }
constexpr int RW_REC = 11520;
constexpr int RWO_FU = 0, RWO_FS = 2048, RWO_FY = 6144, RWO_W2 = 8192, RWO_W4 = 8704, RWO_VC = 9216, RWO_G = 11264;
constexpr size_t WS_CHD_A = WS_RP, WS_CHD_B = WS_RX, WS_RWG2 = WS_RX + 68 * MiB, WS_RWBON = WS_RX + 100 * MiB;
static_assert(5 * 2048 * (size_t)RW_REC <= 128 * MiB && 3 * 2048 * (size_t)RW_REC <= 68 * MiB && WS_RWBON + MiB <= WS_END, "rwkv map");
__device__ __forceinline__ unsigned char* rw_record(unsigned char* ws, int b, int h, int c) {
    return b < 5 ? ws + WS_CHD_A + (size_t)((b * 8 + h) * 256 + c) * RW_REC : ws + WS_CHD_B + (size_t)(((b - 5) * 8 + h) * 256 + c) * RW_REC;
}
struct RwArgs {
    const bf16* PRW;
    const float *mu, *w0, *a0, *kk_w, *ka_w, *rk_w, *lng, *lnb;
    const bf16 *WupT, *AupT, *GupT;
    bf16* G; float* bonus;
    unsigned char* ws;
    float* yraw;
    bf16* out;
};
__device__ __forceinline__ void shift4(const bf16* PRW, const float* mu, size_t row, int t, int c, float (&o)[4]) {
    const v2u cur = *(const GAS v2u*)(PRW + row * 1792 + c); v2u prv; prv.x = 0u; prv.y = 0u;
    if (t > 0) prv = *(const GAS v2u*)(PRW + (row - 1) * 1792 + c);
    const f32x4 m = *(const GAS f32x4*)(mu + c);
    const float cu[4] = {bflo(cur.x), bfhi(cur.x), bflo(cur.y), bfhi(cur.y)}, pr[4] = {bflo(prv.x), bfhi(prv.x), bflo(prv.y), bfhi(prv.y)};
#pragma unroll
    for (int i = 0; i < 4; ++i) o[i] = cu[i] + (pr[i] - cu[i]) * m[i];
}
constexpr int RW_RAWLD = 3072 + 16;
__device__ __forceinline__ void shift4_lds(const LAS unsigned char* RAW, const LAS float* PAR, int tok16, int t, int arr, int c, float (&o)[4]) {
    const LAS unsigned char* rp = RAW + (tok16 + 1) * RW_RAWLD + arr * 1024 + c * 2;
    const v2u cur = *(const LAS v2u*)rp; v2u prv = *(const LAS v2u*)(rp - RW_RAWLD); if (t == 0) { prv.x = 0u; prv.y = 0u; }
    const f32x4 m = *(const LAS f32x4*)(PAR + arr * 512 + c);
    const float cu[4] = {bflo(cur.x), bfhi(cur.x), bflo(cur.y), bfhi(cur.y)}, pr[4] = {bflo(prv.x), bfhi(prv.x), bflo(prv.y), bfhi(prv.y)};
#pragma unroll
    for (int i = 0; i < 4; ++i) o[i] = cu[i] + (pr[i] - cu[i]) * m[i];
}
__device__ __forceinline__ void rwkv_prep_unit(const RwArgs& X, const Ctx& C, int unit, bool fill_par) {
    constexpr int LD64 = (64 + 8) * 2, LD128 = (128 + 8) * 2;
    LAS unsigned char* TD = C.lds; LAS unsigned char* XA = TD + 64 * LD64; LAS unsigned char* SG = XA + 64 * LD64;
    LAS float* PAR = (LAS float*)(C.lds + 36864);
    LAS unsigned char* RAW = C.lds + 36864 + 16384;
    int tid = C.tid; asm volatile("" : "+v"(tid));
    const int lane = tid & 63, wid = C.wid, q4_ = lane >> 4, r16_ = lane & 15;
    const size_t row0 = (size_t)unit * 64; const int tb = (unit * 64) & (T - 1), bat = unit >> 6;
    WG_SYNC();
    if (fill_par) { float pv[8]; pv[0] = X.mu[tid]; pv[1] = X.mu[512 + tid]; pv[2] = X.mu[1024 + tid]; pv[3] = X.w0[tid]; pv[4] = X.a0[tid]; pv[5] = X.kk_w[tid]; pv[6] = X.ka_w[tid]; pv[7] = X.rk_w[tid];
#pragma unroll
        for (int k = 0; k < 8; ++k) PAR[512 * k + tid] = pv[k]; }
    v4u cuw[4], prw[4];
#pragma unroll
    for (int k = 0; k < 4; ++k) { const int task = tid + NTHR * k, tok = task >> 5, ch = task & 31; const int c = 1536 + 8 * ch; const size_t row = row0 + tok; const int t = tb + tok;
        cuw[k] = *(const GAS v4u*)(X.PRW + row * 1792 + c); prw[k] = *(const GAS v4u*)(X.PRW + (t > 0 ? row - 1 : row) * 1792 + c); }
#pragma unroll
    for (int k = 0; k < 4; ++k) { const int task = tid + NTHR * k, tok = task >> 5, ch = task & 31;
        const int c = 1536 + 8 * ch; const int t = tb + tok;
        float cu[8], pr[8]; unpack8(cuw[k], cu); unpack8(prw[k], pr);
        if (!(t > 0)) {
#pragma unroll
            for (int i = 0; i < 8; ++i) pr[i] = 0.f; }
        float o[8]; const f32x4 mu0 = *(const GAS f32x4*)(X.mu + c), mu1 = *(const GAS f32x4*)(X.mu + c + 4);
#pragma unroll
        for (int i = 0; i < 8; ++i) { const float xs = cu[i] + (pr[i] - cu[i]) * (i < 4 ? mu0[i & 3] : mu1[i & 3]);
            const float r = __builtin_amdgcn_rcpf(1.0f + __builtin_amdgcn_exp2f((ch < 8 ? 2.885390081777927f : -1.4426950408889634f) * xs));
            o[i] = ch < 8 ? 1.0f - 2.0f * r : (ch < 16 ? xs : r); }
        const v4u w = pack8(o);
        if (ch < 8) *(LAS v4u*)(TD + tok * LD64 + 16 * ch) = w; else if (ch < 16) *(LAS v4u*)(XA + tok * LD64 + 16 * (ch - 8)) = w; else *(LAS v4u*)(SG + tok * LD128 + 16 * (ch - 16)) = w; }
    WG_SYNC();
    const s16x4 Ic = pk4(4 * q4_ + 0 == r16_ ? 1.f : 0.f, 4 * q4_ + 1 == r16_ ? 1.f : 0.f, 4 * q4_ + 2 == r16_ ? 1.f : 0.f, 4 * q4_ + 3 == r16_ ? 1.f : 0.f);
    const f32x4 Z4 = (f32x4){0.f, 0.f, 0.f, 0.f};
    bf16x8 fw[2], fa[2], fg[4];
#define RW_LDF(ct_) do { const size_t rb_ = (size_t)(64 * wid + 16 * (ct_) + r16); \
        _Pragma("unroll") for (int ks = 0; ks < 2; ++ks) { fw[ks] = *(const GAS bf16x8*)(X.WupT + rb_ * 64 + ks * 32 + 8 * q4); fa[ks] = *(const GAS bf16x8*)(X.AupT + rb_ * 64 + ks * 32 + 8 * q4); } \
        _Pragma("unroll") for (int ks = 0; ks < 4; ++ks) fg[ks] = *(const GAS bf16x8*)(X.GupT + rb_ * 128 + ks * 32 + 8 * q4); } while (0)
    { const int r16 = r16_, q4 = q4_; RW_LDF(0); }
#pragma unroll 1
    for (int tt = 0; tt < 4; ++tt) {
        int r16 = r16_, q4 = q4_; asm volatile("" : "+v"(r16), "+v"(q4));
        const int tok = 16 * tt + r16; const size_t row = row0 + tok; const int t = tb + tok;
        unsigned char* rec = rw_record(X.ws, bat, wid, (tb >> 4) + tt);
        LDS_SYNC();
        for (int pc = wid; pc < 51; pc += NWAVES) { const int rr_ = pc / 3, pp_ = pc - 3 * rr_;
            __builtin_amdgcn_global_load_lds((const unsigned*)((const unsigned char*)X.PRW + ((long)row0 + 16 * tt - 1 + rr_) * 3584 + pp_ * 1024 + lane * 16), (LAS unsigned*)(RAW + rr_ * RW_RAWLD + pp_ * 1024), 16, 0, 0); }
        asm volatile("s_waitcnt vmcnt(0)" ::: "memory");
        LDS_SYNC();
        float ss = 0.f;
#pragma unroll
        for (int ct = 0; ct < 4; ++ct) { const int c0 = 64 * wid + 16 * ct + 4 * q4; float xk[4]; shift4_lds(RAW, PAR, r16, t, 1, c0, xk);
            const f32x4 kw = *(const LAS f32x4*)(PAR + 5 * 512 + c0);
#pragma unroll
            for (int i = 0; i < 4; ++i) { const float v = xk[i] * kw[i]; ss += v * v; } }
        ss += __shfl_xor(ss, 16); ss += __shfl_xor(ss, 32);
        const float invn = 1.0f / fmaxf(sqrtf(ss), 1e-12f);
        float bon = 0.f;
        s16x4 fA[4], fBi[4], fKi[4], fR[4];
        bf16x8 tbd[2], tba[2], tbg[4];
#pragma unroll
        for (int ks = 0; ks < 2; ++ks) { tbd[ks] = *(const LAS bf16x8*)(TD + tok * LD64 + (ks * 32 + 8 * q4) * 2); tba[ks] = *(const LAS bf16x8*)(XA + tok * LD64 + (ks * 32 + 8 * q4) * 2); }
#pragma unroll
        for (int ks = 0; ks < 4; ++ks) tbg[ks] = *(const LAS bf16x8*)(SG + tok * LD128 + (ks * 32 + 8 * q4) * 2);
#pragma unroll
        for (int ct = 0; ct < 4; ++ct) {
            const int cb = 64 * wid + 16 * ct, c0 = cb + 4 * q4;
            f32x4 cw = Z4, ca = Z4, cg = Z4;
#pragma unroll
            for (int ks = 0; ks < 2; ++ks) { cw = mfma32(fw[ks], tbd[ks], cw); ca = mfma32(fa[ks], tba[ks], ca); }
#pragma unroll
            for (int ks = 0; ks < 4; ++ks) cg = mfma32(fg[ks], tbg[ks], cg);
            asm volatile("" : "+v"(cw), "+v"(ca), "+v"(cg));
            RW_LDF((ct + 1) & 3);
            const f32x4 w0v = *(const LAS f32x4*)(PAR + 3 * 512 + c0), a0v = *(const LAS f32x4*)(PAR + 4 * 512 + c0), kaw = *(const LAS f32x4*)(PAR + 6 * 512 + c0), rkw = *(const LAS f32x4*)(PAR + 7 * 512 + c0), kw = *(const LAS f32x4*)(PAR + 5 * 512 + c0);
            float xr[4], xk[4], xv[4]; shift4_lds(RAW, PAR, r16, t, 0, c0, xr); shift4_lds(RAW, PAR, r16, t, 1, c0, xk); shift4_lds(RAW, PAR, r16, t, 2, c0, xv);
            { v2u w; w.x = pk2(cg[0], cg[1]); w.y = pk2(cg[2], cg[3]); *(GAS v2u*)(X.G + row * 512 + c0) = w; }
            { const f32x4 vc = mfma16(pk4(xv[0], xv[1], xv[2], xv[3]), Ic, Z4); *(GAS s16x4*)(rec + RWO_VC + 512 * ct + lane * 8) = pk4v(vc); }
            float pa[4], pbi[4], pki[4], pr[4], pbh[4], pkh[4]; f32x4 g15;
#pragma unroll
            for (int i = 0; i < 4; ++i) { const float z = w0v[i] + cw[i];
                const float e = 0.6065306597126334f * fsig(z);
                const float a = fsig(a0v[i] + ca[i]);
                const float kkv = xk[i] * kw[i] * invn, khv = xk[i] * (1.0f + (a - 1.0f) * kaw[i]), bbv = kkv * a;
                bon += xr[i] * khv * rkw[i];
                const float cs = row16_scan(e);
                const float gi = fexp(cs), gt = __builtin_amdgcn_rcpf(gi);
                const float gsh = __builtin_bit_cast(float, __builtin_amdgcn_update_dpp(0, __builtin_bit_cast(int, gt), 0x111, 0xf, 0xf, true));
                const float gp = r16 == 0 ? 1.0f : gsh;
                const float gl15 = __builtin_bit_cast(float, __builtin_amdgcn_update_dpp(0, __builtin_bit_cast(int, gt), 0x15F, 0xf, 0xf, true));
                const float gl = gi * gl15;
                pa[i] = -kkv * gp; pbi[i] = bbv * gi; pki[i] = khv * gi; pr[i] = xr[i] * gt; pbh[i] = bbv * gl; pkh[i] = khv * gl; g15[i] = gl15; }
            fA[ct] = pk4(pa[0], pa[1], pa[2], pa[3]); fBi[ct] = pk4(pbi[0], pbi[1], pbi[2], pbi[3]); fKi[ct] = pk4(pki[0], pki[1], pki[2], pki[3]);
            fR[ct] = pk4(pr[0], pr[1], pr[2], pr[3]);
            { const s16x4 bhc = pk4v(mfma16(pk4(pbh[0], pbh[1], pbh[2], pbh[3]), Ic, Z4)), khc = pk4v(mfma16(pk4(pkh[0], pkh[1], pkh[2], pkh[3]), Ic, Z4));
              *(GAS bf16x8*)(rec + RWO_FS + 1024 * ct + lane * 16) = cat8(bhc, khc); }
            if (r16 == 0) *(GAS f32x4*)(rec + RWO_G + (16 * ct + 4 * q4) * 4) = g15;
        }
        bon += __shfl_xor(bon, 16); bon += __shfl_xor(bon, 32);
        if (q4 == 0) X.bonus[row * 8 + wid] = bon;
        f32x4 nA = Z4, nC = Z4, mkaA = Z4, mkaC = Z4, mbrA = Z4, mkrA = Z4;
#pragma unroll
        for (int ks = 0; ks < 2; ++ks) { const bf16x8 a8 = cat8(fA[2 * ks], fA[2 * ks + 1]), bi8 = cat8(fBi[2 * ks], fBi[2 * ks + 1]), ki8 = cat8(fKi[2 * ks], fKi[2 * ks + 1]), r8 = cat8(fR[2 * ks], fR[2 * ks + 1]);
            nA = mfma32(bi8, a8, nA); nC = mfma32(a8, bi8, nC); mkaA = mfma32(ki8, a8, mkaA); mkaC = mfma32(a8, ki8, mkaC); mbrA = mfma32(bi8, r8, mbrA); mkrA = mfma32(ki8, r8, mkrA); }
#pragma unroll
        for (int j = 0; j < 4; ++j) { const int o = 4 * q4 + j;
            if (!(o < r16)) { nA[j] = 0.f; mkaA[j] = 0.f; } if (!(r16 < o)) { nC[j] = 0.f; mkaC[j] = 0.f; } if (!(o <= r16)) { mbrA[j] = 0.f; mkrA[j] = 0.f; } }
        s16x4 Ta;
        { const s16x4 Na = pk4v(nA), Nc = pk4v(nC);
          const f32x4 n2c = mfma16(Na, Nc, Z4), n2a = mfma16(Nc, Na, Z4); const s16x4 N2a = pk4v(n2a), N2c = pk4v(n2c);
          const f32x4 n4c = mfma16(N2a, N2c, Z4), n4a = mfma16(N2c, N2a, Z4); const s16x4 N4a = pk4v(n4a), N4c = pk4v(n4c);
          const f32x4 n8c = mfma16(N4a, N4c, Z4);
          f32x4 f0 = nA, f1 = n2c, f2 = n4c, f3 = n8c;
#pragma unroll
          for (int j = 0; j < 4; ++j) if (4 * q4 + j == r16) { f0[j] += 1.f; f1[j] += 1.f; f2[j] += 1.f; f3[j] += 1.f; }
          const f32x4 p1 = mfma16(pk4v(f1), pk4v(f0), Z4);
          const f32x4 p2 = mfma16(pk4v(f2), pk4v(p1), Z4);
          const f32x4 p3 = mfma16(pk4v(f3), pk4v(p2), Z4);
          Ta = pk4v(p3); }
        const s16x4 MbrA = pk4v(mbrA), MkaC = pk4v(mkaC);
        { const f32x4 w2a = mfma16(MkaC, Ta, Z4), w2c = mfma16(Ta, MkaC, Z4);
          const f32x4 w4a = mfma16(pk4v(w2c), MbrA, mkrA);
          *(GAS s16x4*)(rec + RWO_W2 + lane * 8) = pk4v(w2a); *(GAS s16x4*)(rec + RWO_W4 + lane * 8) = pk4v(w4a); }
        s16x4 w1a[4], w3a[4];
#pragma unroll
        for (int ct = 0; ct < 4; ++ct) { const s16x4 Ac = pk4v(mfma16(fA[ct], Ic, Z4));
            const f32x4 x1a = mfma16(Ac, Ta, Z4), x1c = mfma16(Ta, Ac, Z4);
            f32x4 r0; { const v2u w = __builtin_bit_cast(v2u, fR[ct]); r0[0] = bflo(w.x); r0[1] = bfhi(w.x); r0[2] = bflo(w.y); r0[3] = bfhi(w.y); }
            const f32x4 x3a = mfma16(pk4v(x1c), MbrA, r0);
            w1a[ct] = pk4v(x1a); w3a[ct] = pk4v(x3a); }
#pragma unroll
        for (int ks = 0; ks < 2; ++ks) { *(GAS bf16x8*)(rec + RWO_FU + 1024 * ks + lane * 16) = cat8(w1a[2 * ks], w1a[2 * ks + 1]); *(GAS bf16x8*)(rec + RWO_FY + 1024 * ks + lane * 16) = cat8(w3a[2 * ks], w3a[2 * ks + 1]); }
    }
#undef RW_LDF
}
__device__ __forceinline__ void rwkv_scan(const RwArgs& X, const Ctx& C) {
    constexpr int SLOT = 12288, RING = 8, AHEAD = 6;
    const int lane = C.lane, q4 = lane >> 4, r16 = lane & 15, wid = C.wid;
    for (int v = C.vb; v < 256; v += C.G) { if ((v & 31) >= 8) continue; const int b = v >> 5, h = v & 31;
        const unsigned char* rec0 = rw_record(X.ws, b, h, 0);
        __syncthreads();
        if (wid >= 4) {
            const int lw = wid - 4;
#define RW_DMA(c_) do { const unsigned char* r_ = rec0 + (size_t)(c_) * RW_REC; LAS unsigned char* s_ = C.lds + ((c_) & (RING - 1)) * SLOT; \
                _Pragma("unroll") for (int p_ = 0; p_ < 3; ++p_) __builtin_amdgcn_global_load_lds((const unsigned*)(r_ + (lw + 4 * p_) * 1024 + lane * 16), (LAS unsigned*)(s_ + (lw + 4 * p_) * 1024), 16, 0, 0); } while (0)
            for (int c = 0; c < AHEAD; ++c) RW_DMA(c);
            for (int c = 0; c < 256; ++c) {
                if (c + AHEAD < 256) { RW_DMA(c + AHEAD); asm volatile("s_waitcnt vmcnt(18)" ::: "memory"); }
                else asm volatile("s_waitcnt vmcnt(0)" ::: "memory");
                __builtin_amdgcn_s_barrier();
            }
#undef RW_DMA
        } else {
            const int rg = wid;
            f32x4 S[4];
#pragma unroll
            for (int i = 0; i < 4; ++i) S[i] = (f32x4){0.f, 0.f, 0.f, 0.f};
            for (int c = 0; c < 256; ++c) {
                asm volatile("s_waitcnt lgkmcnt(0)" ::: "memory");
                __builtin_amdgcn_s_barrier();
                asm volatile("" ::: "memory");
                const LAS unsigned char* r = C.lds + (c & (RING - 1)) * SLOT;
                const bf16x8 fu0 = *(const LAS bf16x8*)(r + RWO_FU + lane * 16), fu1 = *(const LAS bf16x8*)(r + RWO_FU + 1024 + lane * 16);
                const bf16x8 fy0 = *(const LAS bf16x8*)(r + RWO_FY + lane * 16), fy1 = *(const LAS bf16x8*)(r + RWO_FY + 1024 + lane * 16);
                const bf16x8 fs0 = *(const LAS bf16x8*)(r + RWO_FS + lane * 16), fs1 = *(const LAS bf16x8*)(r + RWO_FS + 1024 + lane * 16), fs2 = *(const LAS bf16x8*)(r + RWO_FS + 2048 + lane * 16), fs3 = *(const LAS bf16x8*)(r + RWO_FS + 3072 + lane * 16);
                const s16x4 w2 = *(const LAS s16x4*)(r + RWO_W2 + lane * 8), w4 = *(const LAS s16x4*)(r + RWO_W4 + lane * 8), vc = *(const LAS s16x4*)(r + RWO_VC + 512 * rg + lane * 8);
                const f32x4 g0 = *(const LAS f32x4*)(r + RWO_G + (4 * q4) * 4), g1 = *(const LAS f32x4*)(r + RWO_G + (16 + 4 * q4) * 4), g2 = *(const LAS f32x4*)(r + RWO_G + (32 + 4 * q4) * 4), g3 = *(const LAS f32x4*)(r + RWO_G + (48 + 4 * q4) * 4);
                const bf16x8 s0 = cat8(pk4v(S[0]), pk4v(S[1])), s1 = cat8(pk4v(S[2]), pk4v(S[3]));
                f32x4 U = mfma16(w2, vc, (f32x4){0.f, 0.f, 0.f, 0.f}); U = mfma32(fu0, s0, U); U = mfma32(fu1, s1, U);
                f32x4 Y = mfma16(w4, vc, (f32x4){0.f, 0.f, 0.f, 0.f}); Y = mfma32(fy0, s0, Y); Y = mfma32(fy1, s1, Y);
                const bf16x8 uv = cat8(pk4v(U), vc);
                S[0] = mfma32(fs0, uv, S[0] * g0); S[1] = mfma32(fs1, uv, S[1] * g1); S[2] = mfma32(fs2, uv, S[2] * g2); S[3] = mfma32(fs3, uv, S[3] * g3);
                float* yp = X.yraw + ((size_t)b * T + (size_t)c * 16 + 4 * q4) * 512 + h * 64 + 16 * rg + r16;
                yp[0] = Y[0]; yp[512] = Y[1]; yp[1024] = Y[2]; yp[1536] = Y[3];
            }
        }
    }
}
__device__ __forceinline__ void rwkv_finish(const RwArgs& X, const Ctx& C) {
    const int gw = C.bid * NWAVES + C.wid, NGW = C.G * NWAVES, lane = C.lane, c = 8 * lane;
    float lg[8], lb[8], mv[8];
#pragma unroll
    for (int i = 0; i < 8; ++i) { lg[i] = X.lng[c + i]; lb[i] = X.lnb[c + i]; mv[i] = X.mu[1024 + c + i]; }
    const int rpw = M / C.G, mb = C.vb * rpw;
    for (int i0 = C.wid; i0 < rpw; i0 += 2 * NWAVES) { const int m0 = mb + i0;
        f32x4 yl[2][2]; v4u vw[2], pw[2], gw4[2]; float bsr[2];
#pragma unroll
        for (int r = 0; r < 2; ++r) { const int m = (i0 + r * NWAVES < rpw) ? m0 + r * NWAVES : m0; const size_t o = (size_t)m * 512 + c;
            yl[r][0] = *(const GAS f32x4*)(X.yraw + o); yl[r][1] = *(const GAS f32x4*)(X.yraw + o + 4);
            vw[r] = *(const GAS v4u*)(X.PRW + (size_t)m * 1792 + 1024 + c);
            { const bool hp = (m & (T - 1)) != 0; pw[r] = *(const GAS v4u*)(X.PRW + (size_t)(hp ? m - 1 : m) * 1792 + 1024 + c); if (!hp) pw[r] = (v4u){0u, 0u, 0u, 0u}; }
            gw4[r] = *(const GAS v4u*)(X.G + o); bsr[r] = X.bonus[(size_t)m * 8 + (lane >> 3)]; }
#pragma unroll
        for (int r = 0; r < 2; ++r) { const int m = m0 + r * NWAVES; if (i0 + r * NWAVES >= rpw) break;
            float y[8] = {yl[r][0][0], yl[r][0][1], yl[r][0][2], yl[r][0][3], yl[r][1][0], yl[r][1][1], yl[r][1][2], yl[r][1][3]}, v[8], pv[8], g[8];
            unpack8(vw[r], v); unpack8(pw[r], pv); unpack8(gw4[r], g); const float bs = bsr[r];
            float sm = 0.f;
#pragma unroll
            for (int i = 0; i < 8; ++i) { sm += y[i]; v[i] = v[i] + (pv[i] - v[i]) * mv[i]; }
            sm += __shfl_xor(sm, 1); sm += __shfl_xor(sm, 2); sm += __shfl_xor(sm, 4);
            const float mean = sm * (1.0f / 64.0f); float vs = 0.f;
#pragma unroll
            for (int i = 0; i < 8; ++i) { y[i] -= mean; vs += y[i] * y[i]; }
            vs += __shfl_xor(vs, 1); vs += __shfl_xor(vs, 2); vs += __shfl_xor(vs, 4);
            const float rinv = __builtin_amdgcn_rsqf(vs * (1.0f / 64.0f) + 64e-5f);
            float ov[8];
#pragma unroll
            for (int i = 0; i < 8; ++i) ov[i] = (y[i] * rinv * lg[i] + lb[i] + bs * v[i]) * g[i];
            *(GAS v4u*)(X.out + (size_t)m * 1024 + 512 + c) = pack8(ov); } }
}

__device__ __forceinline__ void route_tokens(const Args& A, const Ctx& C) {
    unsigned char* rt = A.ws + WS_ROUTE;
    int* e01 = (int*)(rt + RT_E01); float* w0a = (float*)(rt + RT_W0); float* rsa = (float*)(rt + RT_RS); int* cnt = (int*)(rt + RT_CNT);
    LAS float* Rg = (LAS float*)C.lds;
    LAS int* lcnt = (LAS int*)(C.lds + 32768);
    const float* h = A.out; const float* rw = A.in[I_ROUTER]; const float* g2 = A.in[I_ON2G];
    WG_SYNC();
    for (int i = C.tid; i < 8192; i += NTHR) Rg[(i & 7) * 1024 + (i >> 3)] = rw[i] * g2[i >> 3];
    for (int blk = C.vb; blk < 256; blk += C.G) {
        if (C.tid < 8) lcnt[C.tid] = 0;
        WG_SYNC();
        f32x4 xn[4]; { const GAS f32x4* xr0 = (const GAS f32x4*)(h + (size_t)(blk * 128 + C.wid * 16) * D) + C.lane;
#pragma unroll
            for (int j = 0; j < 4; ++j) xn[j] = xr0[64 * j]; }
        int res_e = 0; float res_w = 0.f, res_r = 0.f;
        for (int k = 0; k < 16; ++k) { const int m = blk * 128 + C.wid * 16 + k;
            f32x4 xc[4];
#pragma unroll
            for (int j = 0; j < 4; ++j) xc[j] = xn[j];
            if (k + 1 < 16) { const GAS f32x4* xr1 = (const GAS f32x4*)(h + (size_t)(m + 1) * D) + C.lane;
#pragma unroll
                for (int j = 0; j < 4; ++j) xn[j] = xr1[64 * j]; }
            float ss = 0.f; float lg[8];
#pragma unroll
            for (int e = 0; e < 8; ++e) lg[e] = 0.f;
#pragma unroll
            for (int j = 0; j < 4; ++j) { const f32x4 v = xc[j]; ss += (v[0] * v[0] + v[1] * v[1]) + (v[2] * v[2] + v[3] * v[3]);
#pragma unroll
                for (int e = 0; e < 8; ++e) { const f32x4 r = *(const LAS f32x4*)(Rg + e * 1024 + 4 * C.lane + 256 * j); lg[e] += (v[0] * r[0] + v[1] * r[1]) + (v[2] * r[2] + v[3] * r[3]); } }
            ss = wave_sum(ss);
#pragma unroll
            for (int e = 0; e < 8; ++e) lg[e] = wave_sum(lg[e]);
            const float rs = 1.0f / sqrtf(ss * (1.0f / 1024.0f) + 1e-6f);
            int b0 = 0; float v0 = lg[0];
#pragma unroll
            for (int e = 1; e < 8; ++e) if (lg[e] > v0) { v0 = lg[e]; b0 = e; }
            int b1 = (b0 + 1) & 7; float v1 = -3.0e38f;
#pragma unroll
            for (int e = 0; e < 8; ++e) if (e != b0 && lg[e] > v1) { v1 = lg[e]; b1 = e; }
            if (C.lane == k) { res_e = b0 | (b1 << 8); res_w = 1.0f / (1.0f + expf((v1 - v0) * rs)); res_r = rs; }
            if (C.lane == 0) { atomicAdd((int*)&lcnt[b0], 1); atomicAdd((int*)&lcnt[b1], 1); } }
        if (C.lane < 16) { const int m = blk * 128 + C.wid * 16 + C.lane; e01[m] = res_e; w0a[m] = res_w; rsa[m] = res_r; }
        WG_SYNC();
        if (C.tid < 8) cnt[blk * 8 + C.tid] = lcnt[C.tid];
        WG_SYNC();
    }
}
__device__ __forceinline__ void route_gather(const Args& A, const Ctx& C) {
    unsigned char* rt = A.ws + WS_ROUTE;
    const int* e01 = (const int*)(rt + RT_E01); const float* rsa = (const float*)(rt + RT_RS); const int* cnt = (const int*)(rt + RT_CNT);
    int* pos0 = (int*)(rt + RT_POS0); int* pos1 = (int*)(rt + RT_POS1); float* rsg = (float*)(rt + RT_RSG); int* tile_e = (int*)(rt + RT_TILE_E); int* meta = (int*)(rt + RT_META);
    const bf16* hb = (const bf16*)(A.ws + WS_HBG); unsigned char* xg = A.ws + WS_XG8;
    LAS int* sh = (LAS int*)C.lds;
    WG_SYNC();
    for (int blk = C.vb; blk < 256; blk += C.G) {
        if (C.tid < 24) sh[C.tid] = 0;
        WG_SYNC();
        { int cv[4];
#pragma unroll
          for (int j = 0; j < 4; ++j) cv[j] = cnt[C.tid + NTHR * j];
          int tot = 0, before = 0;
#pragma unroll
          for (int j = 0; j < 4; ++j) { tot += cv[j]; if ((C.tid >> 3) + 64 * j < blk) before += cv[j]; }
          atomicAdd((int*)&sh[C.tid & 7], tot); atomicAdd((int*)&sh[16 + (C.tid & 7)], before); }
        WG_SYNC();
        if (C.tid == 0) { int s = 0; for (int e = 0; e < 8; ++e) { sh[8 + e] = s; s += (sh[e] + 255) & ~255; }
            if (blk == 0) { meta[0] = s / 256; int t = 0; for (int e = 0; e < 8; ++e) { const int nt = (sh[e] + 255) / 256; for (int i = 0; i < nt; ++i) tile_e[t++] = e; } for (; t < MOE_TILES + 8; ++t) tile_e[t] = 0; } }
        WG_SYNC();
        int my0 = 0, my1 = 0;
        if (C.tid < 128) { const int m = blk * 128 + C.tid; const int ee = e01[m]; const int b0 = ee & 255, b1 = ee >> 8;
            for (int e = 0; e < 8; ++e) { const bool has = (b0 == e) || (b1 == e); const unsigned long long bal = __ballot(has);
                const int below = __popcll(bal & ((1ull << C.lane) - 1ull)); const int wtot = __popcll(bal);
                if (C.lane == 0) sh[512 + C.wid * 8 + e] = wtot;
                if (b0 == e) my0 = below; if (b1 == e) my1 = below; } }
        WG_SYNC();
        if (C.tid < 128) { const int m = blk * 128 + C.tid; const int ee = e01[m]; const int b0 = ee & 255, b1 = ee >> 8;
            const int p0 = sh[8 + b0] + sh[16 + b0] + (C.wid == 1 ? sh[512 + b0] : 0) + my0, p1 = sh[8 + b1] + sh[16 + b1] + (C.wid == 1 ? sh[512 + b1] : 0) + my1;
            pos0[m] = p0; pos1[m] = p1; sh[32 + 2 * C.tid] = p0; sh[32 + 2 * C.tid + 1] = p1; const float rs = rsa[m]; rsg[p0] = rs; rsg[p1] = rs; }
        WG_SYNC();
        for (int k = 0; k < 32; k += 4) { v4u t0[4], t1[4];
#pragma unroll
            for (int q = 0; q < 4; ++q) { const int s = C.wid * 32 + k + q, m = blk * 128 + (s >> 1); const GAS v4u* src = (const GAS v4u*)(hb + (size_t)m * D) + C.lane; t0[q] = src[0]; t1[q] = src[64]; }
#pragma unroll
            for (int q = 0; q < 4; ++q) { const int p = sh[32 + C.wid * 32 + k + q]; GAS v2u* dst = (GAS v2u*)(xg + (size_t)p * D) + C.lane; const v4u a = t0[q], b = t1[q]; v2u oa, ob;
                oa.x = pg8::pk4f8(bflo(a.x), bfhi(a.x), bflo(a.y), bfhi(a.y)); oa.y = pg8::pk4f8(bflo(a.z), bfhi(a.z), bflo(a.w), bfhi(a.w));
                ob.x = pg8::pk4f8(bflo(b.x), bfhi(b.x), bflo(b.y), bfhi(b.y)); ob.y = pg8::pk4f8(bflo(b.z), bfhi(b.z), bflo(b.w), bfhi(b.w));
                dst[0] = oa; dst[64] = ob; } }
        WG_SYNC();
    }
}
__device__ __forceinline__ void final_combine(const Args& A, const Ctx& C) {
    unsigned char* rt = A.ws + WS_ROUTE;
    const float* w0a = (const float*)(rt + RT_W0); const int* pos0 = (const int*)(rt + RT_POS0); const int* pos1 = (const int*)(rt + RT_POS1);
    const bf16* y = (const bf16*)(A.ws + WS_XG); const float* fg = A.in[I_FNG]; float* out = A.out;
    const int gw = C.bid * NWAVES + C.wid, NGW = C.G * NWAVES;
    f32x4 gv[4];
#pragma unroll
    for (int j = 0; j < 4; ++j) gv[j] = *(const GAS f32x4*)(fg + 4 * C.lane + 256 * j);
    const int rpw = M / C.G, mb = C.vb * rpw;
    for (int i0 = C.wid; i0 < rpw; i0 += 2 * NWAVES) { const int m0 = mb + i0;
        f32x4 hv[2][4]; v2u ya[2][4], yb[2][4]; float w0r[2];
#pragma unroll
        for (int r = 0; r < 2; ++r) { const int m = (i0 + r * NWAVES < rpw) ? m0 + r * NWAVES : m0; w0r[r] = w0a[m]; const int p0 = pos0[m], p1 = pos1[m];
            const GAS f32x4* hr = (const GAS f32x4*)(out + (size_t)m * D) + C.lane; const GAS v2u* y0 = (const GAS v2u*)(y + (size_t)p0 * D) + C.lane; const GAS v2u* y1 = (const GAS v2u*)(y + (size_t)p1 * D) + C.lane;
#pragma unroll
            for (int j = 0; j < 4; ++j) { hv[r][j] = hr[64 * j]; ya[r][j] = y0[64 * j]; yb[r][j] = y1[64 * j]; } }
#pragma unroll
        for (int r = 0; r < 2; ++r) { const int m = m0 + r * NWAVES; if (i0 + r * NWAVES >= rpw) break; const float w0 = w0r[r], w1 = 1.0f - w0; f32x4 v[4]; float ss = 0.f;
#pragma unroll
            for (int j = 0; j < 4; ++j) { const f32x4 h4 = hv[r][j]; const v2u a = ya[r][j], b = yb[r][j];
                f32x4 o; o[0] = h4[0] + w0 * bflo(a.x) + w1 * bflo(b.x); o[1] = h4[1] + w0 * bfhi(a.x) + w1 * bfhi(b.x); o[2] = h4[2] + w0 * bflo(a.y) + w1 * bflo(b.y); o[3] = h4[3] + w0 * bfhi(a.y) + w1 * bfhi(b.y);
                v[j] = o; ss += (o[0] * o[0] + o[1] * o[1]) + (o[2] * o[2] + o[3] * o[3]); }
            ss = wave_sum(ss); const float rs = 1.0f / sqrtf(ss * (1.0f / 1024.0f) + 1e-6f);
            GAS f32x4* hw = (GAS f32x4*)(out + (size_t)m * D) + C.lane;
#pragma unroll
            for (int j = 0; j < 4; ++j) hw[64 * j] = v[j] * rs * gv[j]; } }
}

#ifndef MK_SPLIT
#define MK_SPLIT 0
#endif
constexpr int N_PHASES = 17;
#ifndef WGM_WIDE
#define WGM_WIDE 4
#endif
#ifndef WGM_NARROW
#define WGM_NARROW 4
#endif
#ifndef P2_ML
#define P2_ML 4
#endif
#ifndef MOEW_REP
#define MOEW_REP 1
#endif
#ifndef PROBE_REPEAT
#define PROBE_REPEAT 0u
#endif
#ifndef PROBE_SKIP
#define PROBE_SKIP 0u
#endif
#define NREP(k) ((((unsigned)(PROBE_SKIP)) >> (k)) & 1u ? 0 : ((((unsigned)(PROBE_REPEAT)) >> (k)) & 1u ? 2 : 1))
__device__ __forceinline__ int seg4(int s) { return s <= 0 ? 0 : s == 1 ? 25 : s == 2 ? 42 : s == 3 ? 55 : 64; }
__device__ __forceinline__ int seg4g(int s) { return s <= 0 ? 0 : s == 1 ? 25 : s == 2 ? 42 : s == 3 ? 55 : 64; }
__device__ __forceinline__ int seg8(int s) { return s <= 0 ? 0 : s == 1 ? 20 : s == 2 ? 34 : s == 3 ? 44 : s == 4 ? 51 : s == 5 ? 56 : s == 6 ? 60 : s == 7 ? 62 : 64; }

__global__ void __launch_bounds__(NTHR, 2) fwd_kernel(Args args) {
    extern __shared__ __attribute__((aligned(16))) unsigned char lds_raw[];
    Ctx C; C.lds = (LAS unsigned char*)lds_raw; C.tid = threadIdx.x; C.lane = C.tid & 63; C.wid = __builtin_amdgcn_readfirstlane(C.tid >> 6); C.G = gridDim.x; C.bid = blockIdx.x; C.vb = (C.G == 256) ? ((C.bid & 7) * 32 + (C.bid >> 3)) : C.bid;
    volatile LAS unsigned* MISC = (volatile LAS unsigned*)(C.lds + MISC_OFF);
    for (int u = C.tid; u < (LDS_BYTES - LDSCTL_OFF) / 4; u += NTHR) ((LAS unsigned*)(C.lds + LDSCTL_OFF))[u] = 0u;
    __syncthreads();
    unsigned char* ws = args.ws;
    XcdBarrier bar = xcd_barrier_post((unsigned*)(ws + WS_CTL) + CW_BAR, MISC + 8, (unsigned)C.wid);
    const int lo = args.ph_lo, hi = args.ph_hi;
#define IN(k) (lo <= (k) && (k) < hi)
#define PHASE_TID() do { int t_ = C.wid * 64 + (int)xb_lane_id(); C.tid = t_; C.lane = t_ & 63; } while (0)
#define SEAM(k) do { if (IN(k) && IN((k) + 1)) xcd_barrier(bar); } while (0)
    float* ssp = (float*)(ws + WS_SSP);
    bf16* HB0 = (bf16*)(ws + WS_HB0); bf16* HB1 = (bf16*)(ws + WS_HB1); bf16* RP = (bf16*)(ws + WS_RP);

    if (IN(0)) for (int rep_ = 0; rep_ < NREP(0); ++rep_) { if (rep_) WG_SYNC(); PHASE_TID(); p0_prologue(args, C); } SEAM(0);
#ifdef XBAR_EXTRA
    for (int q_ = 0; q_ < XBAR_EXTRA; ++q_) xcd_barrier(bar);
#endif
    if (IN(1)) for (int rep_ = 0; rep_ < NREP(1); ++rep_) { if (rep_) WG_SYNC(); PHASE_TID(); pg8::Gemm g{HB0, (const bf16*)(ws + WS_W_EIN), M, PW, D}; pg8::StaticOrder S; S.init(M, PW, C.G, C.bid, WGM_WIDE, 2);
        pg8::EpiProj E{RP, PW, RP, PW, 1 << 30, ssp};
        pg8::gemm_phase<pg8::EpiProj, pg8::StaticOrder, true, true>(C.lds, g, S, E, C.tid); } SEAM(1);
    if (IN(2)) for (int rep_ = 0; rep_ < NREP(2); ++rep_) { if (rep_) WG_SYNC(); PHASE_TID(); MixArgs X{}; X.P = RP; X.pitch = PW; X.out = HB1; X.convw = args.in[I_CONVW]; X.convb = args.in[I_CONVB]; X.gateb = args.in[I_GATEB]; X.gup = args.in[I_GLAUP]; X.gb = args.in[I_GLAB];
        for (int pass = 0; pass < 2; ++pass) { int late_j = -1;
            for (int u = C.vb; u < 256; u += C.G) { const int bb = u >> 5, r = u & 31;
                if (r < 4 * P2_ML) { const int hh = r / P2_ML, sg = r - P2_ML * hh; X.normg = args.in[I_MLNG]; X.snap = (float*)(ws + WS_RX); if (pass == 1 || sg < P2_ML - 1) mixer_unit<0>(X, C, bb, hh, sg, P2_ML, pass); else late_j = bb * 8 + hh; }
                else { const int v = r - 4 * P2_ML, hh = v / (8 - P2_ML), sg = v - (8 - P2_ML) * hh; X.normg = args.in[I_GLANG]; X.snap = (float*)(ws + WS_RX + 16 * MiB); if (pass == 1 || sg < 7 - P2_ML) mixer_unit<1>(X, C, bb, hh, sg, 8 - P2_ML, pass); else late_j = bb * 8 + 4 + hh; } }
            if (pass == 0 && C.G == 256 && late_j >= 0) { WG_SYNC(); layer_weights_late(args, C, late_j * NWAVES + C.wid, 64 * NWAVES); }
            if (pass == 0) xcd_barrier(bar); } } SEAM(2);
    if (IN(3)) for (int rep_ = 0; rep_ < NREP(3); ++rep_) { if (rep_) WG_SYNC(); PHASE_TID(); pg8::Gemm g{HB1, (const bf16*)(ws + WS_W_EOUT), M, D, D}; pg8::StaticOrder S; S.init(M, D, C.G, C.bid, WGM_NARROW, 1);
#if FFN8_UP
        pg8::EpiResidT<true> E{args.in[I_X], args.out, HB0, ssp, 1.0f};
        pg8::gemm_phase<pg8::EpiResidT<true>, pg8::StaticOrder, true, true>(C.lds, g, S, E, C.tid); } SEAM(3);
#else
        pg8::EpiResid E{args.in[I_X], args.out, HB0, ssp, 1.0f};
        pg8::gemm_phase<pg8::EpiResid, pg8::StaticOrder, true, true>(C.lds, g, S, E, C.tid); } SEAM(3);
#endif
#if FFN8_UP
    if (IN(4)) for (int rep_ = 0; rep_ < NREP(4); ++rep_) { if (rep_) WG_SYNC(); PHASE_TID(); int k8 = D / 2; asm volatile("" : "+s"(k8)); pg8::Gemm g{HB0, (const bf16*)(ws + WS_W_FGU), M, 2 * FF, k8}; pg8::StaticOrder S; S.init(M, 2 * FF, C.G, C.bid, WGM_WIDE, 2);
#if FFN8_UP == 2
        pg8::EpiSwiGLU8T<false, true> E{(unsigned char*)RP, FF, ssp, 1.0f / 256.0f};
        pg8::gemm_phase<pg8::EpiSwiGLU8T<false, true>, pg8::StaticOrder, true, true, true>(C.lds, g, S, E, C.tid); } SEAM(4);
    if (IN(5)) for (int rep_ = 0; rep_ < NREP(5); ++rep_) { if (rep_) WG_SYNC(); PHASE_TID(); int k8 = FF / 2; asm volatile("" : "+s"(k8)); pg8::Gemm g{RP, (const bf16*)(ws + WS_W_FDN), M, D, k8}; pg8::StaticOrder S; S.init(M, D, C.G, C.bid, WGM_NARROW, 1);
        pg8::EpiResid E{args.out, args.out, HB0, ssp, 1.0f / 4096.0f};
        pg8::gemm_phase<pg8::EpiResid, pg8::StaticOrder, true, true, true>(C.lds, g, S, E, C.tid); } SEAM(5);
#else
        pg8::EpiSwiGLU8T<false, false> E{(unsigned char*)RP, FF, ssp, 1.0f / 256.0f};
        pg8::gemm_phase<pg8::EpiSwiGLU8T<false, false>, pg8::StaticOrder, true, true, true>(C.lds, g, S, E, C.tid); } SEAM(4);
    if (IN(5)) for (int rep_ = 0; rep_ < NREP(5); ++rep_) { if (rep_) WG_SYNC(); PHASE_TID(); pg8::Gemm g{RP, (const bf16*)(ws + WS_W_FDN), M, D, FF}; pg8::StaticOrder S; S.init(M, D, C.G, C.bid, WGM_NARROW, 1);
        pg8::EpiResid E{args.out, args.out, HB0, ssp, 1.0f};
        pg8::gemm_phase<pg8::EpiResid, pg8::StaticOrder, true, true>(C.lds, g, S, E, C.tid); } SEAM(5);
#endif
#else
    if (IN(4)) for (int rep_ = 0; rep_ < NREP(4); ++rep_) { if (rep_) WG_SYNC(); PHASE_TID(); pg8::Gemm g{HB0, (const bf16*)(ws + WS_W_FGU), M, 2 * FF, D}; pg8::StaticOrder S; S.init(M, 2 * FF, C.G, C.bid, WGM_WIDE, 2);
        pg8::EpiSwiGLU8T<false> E{(unsigned char*)RP, FF, ssp, 1.0f};
        pg8::gemm_phase<pg8::EpiSwiGLU8T<false>, pg8::StaticOrder, true, true>(C.lds, g, S, E, C.tid); } SEAM(4);
    if (IN(5)) for (int rep_ = 0; rep_ < NREP(5); ++rep_) { if (rep_) WG_SYNC(); PHASE_TID(); int k8 = FF / 2; asm volatile("" : "+s"(k8)); pg8::Gemm g{RP, (const bf16*)(ws + WS_W_FDN), M, D, k8}; pg8::StaticOrder S; S.init(M, D, C.G, C.bid, WGM_NARROW, 1);
        pg8::EpiResid E{args.out, args.out, HB0, ssp, 1.0f / 4096.0f};
        pg8::gemm_phase<pg8::EpiResid, pg8::StaticOrder, true, true, true>(C.lds, g, S, E, C.tid); } SEAM(5);
#endif
    if (IN(6)) for (int rep_ = 0; rep_ < NREP(6); ++rep_) { if (rep_) WG_SYNC(); PHASE_TID(); pg8::Gemm g{HB0, (const bf16*)(ws + WS_W_OIN), M, PW, D}; pg8::StaticOrder S; S.init(M, PW, C.G, C.bid, WGM_WIDE, 2);
        pg8::EpiProj E{(bf16*)(ws + WS_PRET), 2048, (bf16*)(ws + WS_PRW), 1792, 8, ssp};
        pg8::gemm_phase<pg8::EpiProj, pg8::StaticOrder, true, true>(C.lds, g, S, E, C.tid); } SEAM(6);
    if (IN(7)) for (int rep_ = 0; rep_ < NREP(7); ++rep_) { if (rep_) WG_SYNC(); PHASE_TID(); MixArgs X{}; X.P = (const bf16*)(ws + WS_PRET); X.pitch = 2048; X.out = HB1; X.normg = args.in[I_RETNG]; X.rcs = (const unsigned*)(ws + WS_ROT);
        X.snap = (float*)(ws + WS_RX + 32 * MiB);
        for (int pass = 0; pass < 2; ++pass) {
            for (int u = C.vb; u < 256; u += C.G) { const int bb = u >> 5, hh = (u >> 3) & 3, sg = u & 7; if (pass == 1 || sg < 7) mixer_unit<2>(X, C, bb, hh, sg, 8, pass); }
            if (pass == 0) xcd_barrier(bar); } } SEAM(7);
    RwArgs RW{}; RW.PRW = (const bf16*)(ws + WS_PRW); RW.mu = args.in[I_RWMU]; RW.w0 = args.in[I_RWW0]; RW.a0 = args.in[I_RWA0]; RW.kk_w = args.in[I_RWKK]; RW.ka_w = args.in[I_RWKA]; RW.rk_w = args.in[I_RWRK];
    RW.lng = args.in[I_RWLNG]; RW.lnb = args.in[I_RWLNB]; RW.WupT = (const bf16*)(ws + WS_LORA); RW.AupT = (const bf16*)(ws + WS_LORA + 65536); RW.GupT = (const bf16*)(ws + WS_LORA + 131072);
    RW.G = (bf16*)(ws + WS_RWG2); RW.bonus = (float*)(ws + WS_RWBON); RW.ws = ws; RW.yraw = (float*)(ws + WS_YRAW); RW.out = HB1;
    if (IN(8)) for (int rep_ = 0; rep_ < NREP(8); ++rep_) { if (rep_) WG_SYNC(); PHASE_TID(); for (int u = 2 * C.vb; u < M / 64; u += 2 * C.G) { rwkv_prep_unit(RW, C, u, true); rwkv_prep_unit(RW, C, u + 1, false); } } SEAM(8);
    if (IN(9)) for (int rep_ = 0; rep_ < NREP(9); ++rep_) { if (rep_) WG_SYNC(); PHASE_TID(); rwkv_scan(RW, C);
        if (C.G == 256 && (C.vb & 31) >= 8) { const int j_ = (C.vb >> 5) * 24 + (C.vb & 31) - 8; WG_SYNC(); moe_weights(args, C, 0x1fu, 0u, j_ * NWAVES + C.wid, 192 * NWAVES); } } SEAM(9);
    if (IN(10)) for (int rep_ = 0; rep_ < NREP(10); ++rep_) { if (rep_) WG_SYNC(); PHASE_TID(); rwkv_finish(RW, C); } SEAM(10);
    if (IN(11)) for (int rep_ = 0; rep_ < NREP(11); ++rep_) { if (rep_) WG_SYNC(); PHASE_TID(); pg8::Gemm g{HB1, (const bf16*)(ws + WS_W_OOUT), M, D, D}; pg8::StaticOrder S; S.init(M, D, C.G, C.bid, WGM_NARROW, 1);
        pg8::EpiResid E{args.out, args.out, (bf16*)(ws + WS_HBG), ssp, 1.0f};
        pg8::gemm_phase<pg8::EpiResid, pg8::StaticOrder, true, true>(C.lds, g, S, E, C.tid); } SEAM(11);
    if (IN(12)) for (int rep_ = 0; rep_ < NREP(12); ++rep_) { if (rep_) WG_SYNC(); PHASE_TID(); route_tokens(args, C); WG_SYNC(); moe_weights(args, C, C.G == 256 ? 0x20u : 0x3fu, 0x0fu, C.bid * NWAVES + C.wid, C.G * NWAVES); } SEAM(12);
    if (IN(13)) for (int rep_ = 0; rep_ < NREP(13); ++rep_) { if (rep_) WG_SYNC(); PHASE_TID(); route_gather(args, C); WG_SYNC(); moe_weights(args, C, 0xc0u, 0xf0u, C.bid * NWAVES + C.wid, C.G * NWAVES); } SEAM(13);
    {
        const int* meta = (const int*)(ws + WS_ROUTE + RT_META); const int* tile_e = (const int*)(ws + WS_ROUTE + RT_TILE_E); const float* rsg = (const float*)(ws + WS_ROUTE + RT_RSG);
        LAS int* te_lds = (LAS int*)(C.lds + LDSCTL_OFF + 4096);
        bf16* Y = (bf16*)(ws + WS_XG); unsigned char* XG8 = ws + WS_XG8; unsigned char* HM = ws + WS_HMID;
        if (IN(14)) for (int rep_ = 0; rep_ < NREP(14); ++rep_) { if (rep_) WG_SYNC(); PHASE_TID(); for (int i_ = C.tid; i_ < MOE_TILES + 8; i_ += NTHR) te_lds[i_] = tile_e[i_]; WG_SYNC(); const int nt = meta[0];
            int k8 = D / 2; asm volatile("" : "+s"(k8));
            pg8::Gemm g{(const bf16*)XG8, (const bf16*)(ws + WS_W_MGU), 0, 0, k8}; pg8::MoeOrder S{0, nt, 2 * FF / 256, 2 * FF / 256, C.G, C.bid, te_lds, false, true, WGM_WIDE, 2};
            pg8::EpiSwiGLU8 E{HM, FF, rsg, 1.0f / 256.0f};
            pg8::gemm_phase<pg8::EpiSwiGLU8, pg8::MoeOrder, true, true, true>(C.lds, g, S, E, C.tid); } SEAM(14);
        if (IN(15)) for (int rep_ = 0; rep_ < NREP(15); ++rep_) { if (rep_) WG_SYNC(); PHASE_TID(); for (int i_ = C.tid; i_ < MOE_TILES + 8; i_ += NTHR) te_lds[i_] = tile_e[i_]; WG_SYNC(); const int nt = meta[0];
            int k8 = FF / 2; asm volatile("" : "+s"(k8));
            pg8::Gemm g{(const bf16*)HM, (const bf16*)(ws + WS_W_MDN), 0, 0, k8}; pg8::MoeOrder S{0, nt, D / 256, D / 256, C.G, C.bid, te_lds, true, false, WGM_NARROW, 4};
            pg8::EpiStore E{Y, D, 1.0f / 4096.0f};
            pg8::gemm_phase<pg8::EpiStore, pg8::MoeOrder, true, true, true>(C.lds, g, S, E, C.tid); } SEAM(15);
    }
    if (IN(16)) for (int rep_ = 0; rep_ < NREP(16); ++rep_) { if (rep_) WG_SYNC(); PHASE_TID(); final_combine(args, C); }
#undef IN
#undef SEAM
}

extern "C" void kernel_launch(void* const* d_in, const int* in_sizes, int n_in, void* d_out, int out_size, void* d_ws, size_t ws_size, hipStream_t stream) {
    static int grid = 0;
    if (grid == 0) {
        if (n_in != N_IN || in_sizes[0] != M * D || out_size != M * D || ws_size < WS_END) { fprintf(stderr, "kernel_launch: unexpected shapes (n_in %d, ws %zu < %zu?)\n", n_in, ws_size, (size_t)WS_END); grid = -1; return; }
        int dev = 0, cus = 0;
        if (hipGetDevice(&dev) != hipSuccess || hipDeviceGetAttribute(&cus, hipDeviceAttributeMultiprocessorCount, dev) != hipSuccess) { grid = -1; return; }
        if (hipFuncSetAttribute((const void*)fwd_kernel, hipFuncAttributeMaxDynamicSharedMemorySize, LDS_BYTES) != hipSuccess) { fprintf(stderr, "kernel_launch: hipFuncSetAttribute failed\n"); grid = -1; return; }
        int per_cu = 0;
        if (hipOccupancyMaxActiveBlocksPerMultiprocessor(&per_cu, (const void*)fwd_kernel, NTHR, LDS_BYTES) != hipSuccess || per_cu < 1) { fprintf(stderr, "kernel_launch: occupancy query says %d\n", per_cu); }
        (void)hipGetLastError();
        grid = cus;
    }
    if (grid < 0) return;
    (void)hipMemsetAsync((char*)d_ws + WS_CTL, 0, CTL_ZERO_BYTES, stream);
    Args a{};
    for (int i = 0; i < N_IN; ++i) a.in[i] = (const float*)d_in[i];
    a.out = (float*)d_out; a.ws = (unsigned char*)d_ws;
#if MK_SPLIT
    for (int p = 0; p < N_PHASES; ++p) { a.ph_lo = p; a.ph_hi = p + 1; hipLaunchKernelGGL(fwd_kernel, dim3(grid), dim3(NTHR), LDS_BYTES, stream, a); }
#else
    a.ph_lo = 0; a.ph_hi = N_PHASES;
    hipLaunchKernelGGL(fwd_kernel, dim3(grid), dim3(NTHR), LDS_BYTES, stream, a);
#endif
}
```

```cpp
#include <hip/hip_runtime.h>
#include <cstdio>
#include <cstdint>
namespace pg8 {
#define PG8_LAS __attribute__((address_space(3)))
typedef unsigned short bf16_t;
typedef short bf16x8 __attribute__((ext_vector_type(8)));
typedef float f32x4 __attribute__((ext_vector_type(4)));
typedef unsigned u32x4 __attribute__((ext_vector_type(4)));
constexpr int BM = 256, BK = 64, HALF = 128, HTB = HALF * BK * 2  , STAGE_BYTES = 8 * HTB, NXCD = 8;

__host__ __device__ __forceinline__ int lds_byte(int r, int c) { const int st = (r >> 4) * 2 + (c >> 5), rr = r & 15, cc = c & 31, ob = rr * 64 + cc * 2; return st * 1024 + (ob ^ (((ob >> 9) & 1) << 5)); }
__host__ __device__ __forceinline__ void stage_rc(int b, int& R, int& C) { const int st = b / 1024, sb = b % 1024, swz = sb ^ (((sb >> 9) & 1) << 5); R = (st >> 1) * 16 + swz / 64; C = (st & 1) * 32 + (swz % 64) / 2; }
__host__ __device__ __forceinline__ int perm32(int rho) { const int n = rho >> 4, i = rho & 15; return 8 * (i >> 2) + 4 * n + (i & 3); }

struct Unit { int pm, pn, bn, po, hm, hn; };
__host__ __device__ __forceinline__ bool tail_split(int i, int G, int c, int nwg, int smax, int& L, int& hm, int& hn) {
    const int F = nwg / G, R = nwg - F * G; hm = 0; hn = 0;
    if (i < F) { L = i * G + c; return true; }
    if (i > F || R == 0) return false;
    const int sh = (smax >= 4 && 4 * R <= G) ? 2 : ((smax >= 2 && 2 * R <= G) ? 1 : 0);
    if (c >= (R << sh)) return false;
    const int pc = c & ((1 << sh) - 1); L = F * G + (c >> sh);
    if (sh >= 1) hm = 1 + (pc & 1); if (sh == 2) hn = 1 + (pc >> 1);
    return true;
}
struct Gemm { const bf16_t* A; const bf16_t* Bt; int M, N, K; };

struct StaticOrder {
    int nM, nN, nwg, G, c, WGM, smax;
    __host__ __device__ void init(int M, int N, int G_, int c_, int wgm, int smax_) { nM = M / BM; nN = N / BM; nwg = nM * nN; G = G_; c = c_; WGM = wgm; smax = smax_; }
    __host__ __device__ bool next(int i, Unit& u) const {
        int L; if (!tail_split(i, G, c, nwg, smax, L, u.hm, u.hn)) return false;
        int wgid = L; { const int q = nwg / NXCD, r = nwg % NXCD, xcd = wgid % NXCD, off = wgid / NXCD; wgid = (xcd < r ? xcd * (q + 1) : r * (q + 1) + (xcd - r) * q) + off; }
        const int nig = WGM * nN, gid = wgid / nig, fm = gid * WGM, gsz = (nM - fm) < WGM ? (nM - fm) : WGM;
        u.pm = fm + ((wgid % nig) % gsz); u.pn = (wgid % nig) / gsz; u.bn = u.pn; u.po = u.pm; return true;
    }
    __device__ __forceinline__ void a_ready(const Unit&) const {}
    __device__ __forceinline__ void done(const Unit&) const {}
};

__device__ __forceinline__ unsigned cvt_pk_bf16(float lo, float hi) { unsigned r; asm volatile("v_cvt_pk_bf16_f32 %0, %1, %2" : "=v"(r) : "v"(lo), "v"(hi)); return r; }
typedef float f32x2 __attribute__((ext_vector_type(2)));
typedef int i32x4 __attribute__((ext_vector_type(4)));
typedef int i32x8 __attribute__((ext_vector_type(8)));
__device__ __forceinline__ unsigned pk4f8(float a, float b, float c, float d) {
    a = __builtin_amdgcn_fmed3f(a, -448.f, 448.f); b = __builtin_amdgcn_fmed3f(b, -448.f, 448.f); c = __builtin_amdgcn_fmed3f(c, -448.f, 448.f); d = __builtin_amdgcn_fmed3f(d, -448.f, 448.f);
    int w = __builtin_amdgcn_cvt_pk_fp8_f32(a, b, 0, false); w = __builtin_amdgcn_cvt_pk_fp8_f32(c, d, w, true); return (unsigned)w; }
__device__ __forceinline__ i32x8 cat8(bf16x8 a, bf16x8 b) { const i32x4 x = __builtin_bit_cast(i32x4, a), y = __builtin_bit_cast(i32x4, b); return __builtin_shufflevector(x, y, 0, 1, 2, 3, 4, 5, 6, 7); }
constexpr float RMS_EPS = 1e-6f;
__device__ __forceinline__ float rs_from_ssp(const float* ssp, int row) {
    const f32x4* p = (const f32x4*)(ssp + (size_t)row * 16);
    const f32x4 a = p[0], b = p[1], c = p[2], d = p[3];
    const float s = ((a[0] + a[1]) + (a[2] + a[3])) + ((b[0] + b[1]) + (b[2] + b[3])) + ((c[0] + c[1]) + (c[2] + c[3])) + ((d[0] + d[1]) + (d[2] + d[3]));
    return __builtin_amdgcn_rsqf(s * (1.0f / 1024.0f) + RMS_EPS);
}
__device__ __forceinline__ void rs8_from_ssp(const float* ssp, int row0, int fq, float (&rs)[8]) {
    f32x4 p[8];
#pragma unroll
    for (int i = 0; i < 8; ++i) p[i] = *(const f32x4*)(ssp + (size_t)(row0 + (i >> 2) * HALF + (i & 3) * 16) * 16 + 4 * fq);
#pragma unroll
    for (int i = 0; i < 8; ++i) { float t = (p[i][0] + p[i][1]) + (p[i][2] + p[i][3]); t += __shfl_xor(t, 16); t += __shfl_xor(t, 32); rs[i] = __builtin_amdgcn_rsqf(t * (1.0f / 1024.0f) + RMS_EPS); }
}
struct RsAhead { f32x4 a, b; float s; };
template <bool DIRECT> __device__ __forceinline__ void rs_issue(const float* src, int rowbase, int tid, RsAhead& r) {
    if constexpr (DIRECT) { const float* p = src + rowbase + (tid & 255); asm volatile("global_load_dword %0, %1, off" : "=v"(r.s) : "v"(p) : "memory"); }
    else { const float* p = src + (size_t)(rowbase + (tid >> 1)) * 16 + 8 * (tid & 1);
        asm volatile("global_load_dwordx4 %0, %2, off\n\tglobal_load_dwordx4 %1, %2, off offset:16" : "=&v"(r.a), "=&v"(r.b) : "v"(p) : "memory"); }
}
template <bool DIRECT, int NST> __device__ __forceinline__ void rs_commit(PG8_LAS float* dst, int tid, RsAhead& r) {
    if constexpr (DIRECT) { asm volatile("s_waitcnt vmcnt(%1)" : "+v"(r.s) : "n"(NST) : "memory"); dst[tid & 255] = r.s; }
    else { asm volatile("s_waitcnt vmcnt(%2)" : "+v"(r.a), "+v"(r.b) : "n"(NST) : "memory");
        float t = ((r.a[0] + r.a[1]) + (r.a[2] + r.a[3])) + ((r.b[0] + r.b[1]) + (r.b[2] + r.b[3])); t += __shfl_xor(t, 1);
        dst[tid >> 1] = __builtin_amdgcn_rsqf(t * (1.0f / 1024.0f) + RMS_EPS); }
}
__device__ __forceinline__ float fast_sigmoid(float x) { return __builtin_amdgcn_rcpf(1.0f + __builtin_amdgcn_exp2f(-1.4426950408889634f * x)); }
__device__ __forceinline__ float fast_silu(float x) { return x * fast_sigmoid(x); }

__device__ __forceinline__ f32x2 swiglu2(f32x2 G, f32x2 U, float c1, float ik2) {
    f32x2 e = G * c1; e[0] = __builtin_amdgcn_exp2f(e[0]); e[1] = __builtin_amdgcn_exp2f(e[1]);
    f32x2 d = e * ik2 + ik2; d[0] = __builtin_amdgcn_rcpf(d[0]); d[1] = __builtin_amdgcn_rcpf(d[1]);
    return (G * U) * d;
}
struct EpiProj {
    static constexpr bool PERM = true, AFTER_DRAIN = false, RSLDS = true; static constexpr int NSTORES = 16;
    bf16_t* O0; int ld0; bf16_t* O1; int ld1; int split; const float* ssp;
    __device__ __forceinline__ void rs_first(const Unit& u, PG8_LAS float* dst, int tid) const { RsAhead r; rs_issue<false>(ssp, u.po * BM, tid, r); rs_commit<false, 0>(dst, tid, r); }
    __device__ __forceinline__ void operator()(const f32x4 (&acc)[2][2][4][2], const Unit& u, int wr, int wc, int fr, int fq, const PG8_LAS float* rs_cur, PG8_LAS float* rs_nxt, const Unit& nxt, bool has_next, int tid) const {
        int frl = fr, fql = fq, tidl = tid; asm volatile("" : "+v"(frl), "+v"(fql), "+v"(tidl));
        RsAhead rn; rs_issue<false>(ssp, (has_next ? nxt.po : u.po) * BM, tidl, rn);
        const int row0 = u.po * BM + (u.hm == 2 ? HALF : 0) + wr * 64 + frl;
        bf16_t* base; int ld, ct;
        if (u.pn < split) { base = O0; ld = ld0; ct = u.pn; } else { base = O1; ld = ld1; ct = u.pn - split; }
        const int col0 = ct * BM + (u.hn == 2 ? HALF : 0) + wc * 32 + 8 * fql;
        float rsv[8];
#pragma unroll
        for (int i = 0; i < 8; ++i) rsv[i] = rs_cur[(u.hm == 2 ? HALF : 0) + wr * 64 + frl + (i >> 2) * HALF + (i & 3) * 16 - ((u.hm == 2 && i >= 4) ? HALF : 0)];
#pragma unroll
        for (int ai = 0; ai < 2; ++ai)
#pragma unroll
            for (int m = 0; m < 4; ++m) { if (ai && u.hm) continue; const int row = row0 + ai * HALF + m * 16; const float rs = rsv[ai * 4 + m]; bf16_t* rowp = base + (size_t)row * ld + col0;
#pragma unroll
                for (int bj = 0; bj < 2; ++bj) { if (bj && u.hn) continue; const f32x4 v0 = acc[ai][bj][m][0] * rs, v1 = acc[ai][bj][m][1] * rs;
                    u32x4 w; w.x = cvt_pk_bf16(v0[0], v0[1]); w.y = cvt_pk_bf16(v0[2], v0[3]); w.z = cvt_pk_bf16(v1[0], v1[1]); w.w = cvt_pk_bf16(v1[2], v1[3]);
                    *(u32x4*)(rowp + bj * HALF) = w; } }
        rs_commit<false, NSTORES>(rs_nxt, tidl, rn);
    }
};
template <bool HB8> struct EpiResidT {
    static constexpr bool PERM = false, AFTER_DRAIN = false, RSLDS = false; static constexpr int NSTORES = -1;
    const float* res; float* Hout; bf16_t* hb; float* ssp; float sc;
    __device__ __forceinline__ void operator()(const f32x4 (&acc)[2][2][4][2], const Unit& u, int wr, int wc, int fr, int fq) const {
        typedef unsigned u32x2v __attribute__((ext_vector_type(2)));
        const int row0 = u.po * BM + wr * 64 + fr, col0 = u.pn * BM + wc * 32 + 4 * fq;
        f32x4 h[2][4][2][2];
#pragma unroll
        for (int q = 0; q < 4; ++q) { const int ai = q >> 1; f32x4 r[2][2][2];
#pragma unroll
            for (int mm = 0; mm < 2; ++mm)
#pragma unroll
                for (int bj = 0; bj < 2; ++bj)
#pragma unroll
                    for (int n = 0; n < 2; ++n) r[mm][bj][n] = *(const f32x4*)(res + (size_t)(row0 + ai * HALF + ((q & 1) * 2 + mm) * 16) * 1024 + col0 + bj * HALF + n * 16);
#pragma unroll
            for (int mm = 0; mm < 2; ++mm)
#pragma unroll
                for (int bj = 0; bj < 2; ++bj)
#pragma unroll
                    for (int n = 0; n < 2; ++n) { f32x4 t = r[mm][bj][n] + acc[ai][bj][(q & 1) * 2 + mm][n] * sc; asm volatile("" : "+v"(t)); h[ai][(q & 1) * 2 + mm][bj][n] = t; }
            __builtin_amdgcn_sched_barrier(0); }
#pragma unroll
        for (int ai = 0; ai < 2; ++ai)
#pragma unroll
            for (int m = 0; m < 4; ++m) { const int row = row0 + ai * HALF + m * 16; const size_t off = (size_t)row * 1024 + col0; float ss = 0.f;
#pragma unroll
                for (int bj = 0; bj < 2; ++bj)
#pragma unroll
                    for (int n = 0; n < 2; ++n) { const size_t o = off + bj * HALF + n * 16; const f32x4 hv = h[ai][m][bj][n];
                        *(f32x4*)(Hout + o) = hv;
                        if constexpr (HB8) *(unsigned*)((unsigned char*)hb + o) = pk4f8(hv[0], hv[1], hv[2], hv[3]);
                        else { u32x2v w; w.x = cvt_pk_bf16(hv[0], hv[1]); w.y = cvt_pk_bf16(hv[2], hv[3]); *(u32x2v*)(hb + o) = w; }
                        ss += (hv[0] * hv[0] + hv[1] * hv[1]) + (hv[2] * hv[2] + hv[3] * hv[3]); }
                ss += __shfl_xor(ss, 16); ss += __shfl_xor(ss, 32);
                if (fq == 0) ssp[(size_t)row * 16 + u.pn * 4 + wc] = ss; }
    }
};
typedef EpiResidT<false> EpiResid;
template <bool MOE> struct EpiSwiGLU {
    static constexpr bool PERM = true, AFTER_DRAIN = false, RSLDS = false; static constexpr int NSTORES = 8;
    bf16_t* O; int ld; const float* rsrc;
    __device__ __forceinline__ void operator()(const f32x4 (&acc)[2][2][4][2], const Unit& u, int wr, int wc, int fr, int fq) const {
        int frl = fr, fql = fq; asm volatile("" : "+v"(frl), "+v"(fql));
        const int rloc = wr * 64 + frl, col0 = u.pn * HALF + wc * 32 + 8 * fql;
        float rsv[8];
        if constexpr (MOE) {
#pragma unroll
            for (int i = 0; i < 8; ++i) rsv[i] = rsrc[u.pm * BM + rloc + (i >> 2) * HALF + (i & 3) * 16]; }
        else rs8_from_ssp(rsrc, u.pm * BM + rloc, fql, rsv);
#pragma unroll
        for (int ai = 0; ai < 2; ++ai)
#pragma unroll
            for (int m = 0; m < 4; ++m) { const int r = rloc + ai * HALF + m * 16;
                const float rs = rsv[ai * 4 + m], c1 = -1.4426950408889634f * rs, ik2 = __builtin_amdgcn_rcpf(rs * rs);
                f32x2 o[4];
#pragma unroll
                for (int n = 0; n < 2; ++n)
#pragma unroll
                    for (int hh = 0; hh < 2; ++hh) { const f32x4 g4 = acc[ai][0][m][n], u4 = acc[ai][1][m][n]; const f32x2 G = {g4[2 * hh], g4[2 * hh + 1]}, U = {u4[2 * hh], u4[2 * hh + 1]}; o[n * 2 + hh] = swiglu2(G, U, c1, ik2); }
                u32x4 w; w.x = cvt_pk_bf16(o[0][0], o[0][1]); w.y = cvt_pk_bf16(o[1][0], o[1][1]); w.z = cvt_pk_bf16(o[2][0], o[2][1]); w.w = cvt_pk_bf16(o[3][0], o[3][1]);
                *(u32x4*)(O + (size_t)(u.po * BM + r) * ld + col0) = w; }
    }
};
template <bool MOE, bool OUT8 = true> struct EpiSwiGLU8T {
    static constexpr bool PERM = true, AFTER_DRAIN = false, RSLDS = true; static constexpr int NSTORES = 8;
    unsigned char* O; int ld; const float* rsrc; float wsc;
    __device__ __forceinline__ void rs_first(const Unit& u, PG8_LAS float* dst, int tid) const { RsAhead r; rs_issue<MOE>(rsrc, u.pm * BM, tid, r); rs_commit<MOE, 0>(dst, tid, r); }
    __device__ __forceinline__ void operator()(const f32x4 (&acc)[2][2][4][2], const Unit& u, int wr, int wc, int fr, int fq, const PG8_LAS float* rs_cur, PG8_LAS float* rs_nxt, const Unit& nxt, bool has_next, int tid) const {
        typedef unsigned u32x2v __attribute__((ext_vector_type(2)));
        int tidl = tid; asm volatile("" : "+v"(tidl));
        RsAhead rn; rs_issue<MOE>(rsrc, (has_next ? nxt.pm : u.pm) * BM, tidl, rn);
        int frl = fr, fql = fq; asm volatile("" : "+v"(frl), "+v"(fql));
        const int rloc = (u.hm == 2 ? HALF : 0) + wr * 64 + frl, col0 = u.pn * HALF + wc * 32 + 8 * fql;
        float rsv[8];
#pragma unroll
        for (int i = 0; i < 8; ++i) rsv[i] = rs_cur[rloc + (i & 3) * 16 + ((i >= 4 && !u.hm) ? HALF : 0)];
#pragma unroll
        for (int ai = 0; ai < 2; ++ai)
#pragma unroll
            for (int m = 0; m < 4; ++m) { if (ai && u.hm) continue; const int r = rloc + ai * HALF + m * 16;
                const float rs = rsv[ai * 4 + m] * wsc, c1 = -1.4426950408889634f * rs, ik2 = __builtin_amdgcn_rcpf(rs * rs * (OUT8 ? 16.0f : 1.0f));
                f32x2 o[4];
#pragma unroll
                for (int n = 0; n < 2; ++n)
#pragma unroll
                    for (int hh = 0; hh < 2; ++hh) { const f32x4 g4 = acc[ai][0][m][n], u4 = acc[ai][1][m][n]; const f32x2 G = {g4[2 * hh], g4[2 * hh + 1]}, U = {u4[2 * hh], u4[2 * hh + 1]}; o[n * 2 + hh] = swiglu2(G, U, c1, ik2); }
                if constexpr (OUT8) { u32x2v w; w.x = pk4f8(o[0][0], o[0][1], o[1][0], o[1][1]); w.y = pk4f8(o[2][0], o[2][1], o[3][0], o[3][1]);
                    *(u32x2v*)(O + (size_t)(u.po * BM + r) * ld + col0) = w; }
                else { u32x4 w; w.x = cvt_pk_bf16(o[0][0], o[0][1]); w.y = cvt_pk_bf16(o[1][0], o[1][1]); w.z = cvt_pk_bf16(o[2][0], o[2][1]); w.w = cvt_pk_bf16(o[3][0], o[3][1]);
                    *(u32x4*)((bf16_t*)O + (size_t)(u.po * BM + r) * ld + col0) = w; } }
        rs_commit<MOE, NSTORES>(rs_nxt, tidl, rn);
    }
};
typedef EpiSwiGLU8T<true> EpiSwiGLU8;
struct EpiStore {
    static constexpr bool PERM = true, AFTER_DRAIN = false, RSLDS = false; static constexpr int NSTORES = 16;
    bf16_t* O; int ld; float sc;
    __device__ __forceinline__ void operator()(const f32x4 (&acc)[2][2][4][2], const Unit& u, int wr, int wc, int fr, int fq) const {
        int frl = fr, fql = fq; asm volatile("" : "+v"(frl), "+v"(fql));
        const int row0 = u.po * BM + (u.hm == 2 ? HALF : 0) + wr * 64 + frl, col0 = u.pn * BM + (u.hn == 2 ? HALF : 0) + wc * 32 + 8 * fql;
#pragma unroll
        for (int ai = 0; ai < 2; ++ai)
#pragma unroll
            for (int m = 0; m < 4; ++m) { if (ai && u.hm) continue; bf16_t* rowp = O + (size_t)(row0 + ai * HALF + m * 16) * ld + col0;
#pragma unroll
                for (int bj = 0; bj < 2; ++bj) { if (bj && u.hn) continue; const f32x4 v0 = acc[ai][bj][m][0] * sc, v1 = acc[ai][bj][m][1] * sc;
                    u32x4 w; w.x = cvt_pk_bf16(v0[0], v0[1]); w.y = cvt_pk_bf16(v0[2], v0[3]); w.z = cvt_pk_bf16(v1[0], v1[1]); w.w = cvt_pk_bf16(v1[2], v1[3]);
                    *(u32x4*)(rowp + bj * HALF) = w; } }
    }
};
struct MoeOrder {
    int t_lo, nT, nN, nBper, G, c; const PG8_LAS int* tile_expert; bool a_local, o_local; int WGM, smax;
    __device__ bool next(int i, Unit& u) const {
        const int nwg = nT * nN; int L; if (!tail_split(i, G, c, nwg, smax, L, u.hm, u.hn)) return false;
        { const int q = nwg / NXCD, r = nwg % NXCD, xcd = L % NXCD, off = L / NXCD; L = (xcd < r ? xcd * (q + 1) : r * (q + 1) + (xcd - r) * q) + off; }
        const int nig = WGM * nN, gid = L / nig, fm = gid * WGM, gsz = (nT - fm) < WGM ? (nT - fm) : WGM, rem = L % nig;
        const int pmi = fm + rem % gsz, pn = rem / gsz, t = t_lo + pmi, e = tile_expert[t];
        u.pn = pn; u.bn = e * nBper + pn; u.pm = a_local ? pmi : t; u.po = o_local ? pmi : t; return true;
    }
    __device__ __forceinline__ void a_ready(const Unit&) const {}
    __device__ __forceinline__ void done(const Unit&) const {}
};
template <class Epi, class Sched, bool ALIGN_EPI = false, bool SP2 = false, bool FP8 = false>
__device__ __forceinline__ void gemm_phase(PG8_LAS unsigned char* lds, const Gemm g, const Sched& S, const Epi& E, const int tid  ) {
    const int wid = __builtin_amdgcn_readfirstlane(tid >> 6), lane = tid & 63, wr = wid >> 2, wc = wid & 3, fr = lane & 15, fq = lane >> 4;
    const int K = g.K, nt = K / BK;
    unsigned voffA[2], voffB[2];
#pragma unroll
    for (int i = 0; i < 2; ++i) { int R, C; stage_rc(tid * 16 + i * 8192, R, C); const int Rb = Epi::PERM ? ((R & ~31) + perm32(R & 31)) : R;
        voffA[i] = (unsigned)(R * K + C) * 2u; voffB[i] = (unsigned)(Rb * K + C) * 2u; }
    const size_t kstep = (size_t)(BK * 2);
    const size_t hstep = (size_t)HALF * K * 2;
    const size_t tstep = 2 * hstep;
    const unsigned ldsw = (unsigned)wid * 1024u;
    const int aoff = lds_byte(wr * 64 + fr, fq * 8), boff = lds_byte(wc * 32 + fr, fq * 8);
#define PG8_SA(b, h) (((b) * 2 + (h)) * HTB)
#define PG8_SB(b, h) ((4 + (b) * 2 + (h)) * HTB)
#define PG8_STAGE(bufoff, gbase, voff) do { const char* gb_ = (const char*)(gbase); asm volatile("" : "+s"(gb_));   \
        _Pragma("unroll") for (int _i = 0; _i < 2; ++_i) { unsigned vo_ = (voff)[_i]; asm volatile("" : "+v"(vo_)); \
        __builtin_amdgcn_global_load_lds((const unsigned*)(gb_ + vo_), (PG8_LAS unsigned*)(lds + (bufoff) + ldsw + _i * 8192), 16, 0, 0); } } while (0)
#define PG8_LDA(dst, b, h) do { _Pragma("unroll") for (int m = 0; m < 4; ++m) _Pragma("unroll") for (int k = 0; k < 2; ++k) dst[m][k] = *(const PG8_LAS bf16x8*)(lds + PG8_SA(b, h) + aoff + m * 2048 + k * 1024); } while (0)
#define PG8_LDB(dst, b, h) do { _Pragma("unroll") for (int n = 0; n < 2; ++n) _Pragma("unroll") for (int k = 0; k < 2; ++k) dst[n][k] = *(const PG8_LAS bf16x8*)(lds + PG8_SB(b, h) + boff + n * 2048 + k * 1024); } while (0)
#define PG8_MMA(ai, bj, At, Bt) do { __builtin_amdgcn_s_setprio(1); _Pragma("unroll") for (int m = 0; m < 4; ++m) _Pragma("unroll") for (int n = 0; n < 2; ++n) { \
        if constexpr (FP8) acc[ai][bj][m][n] = __builtin_amdgcn_mfma_scale_f32_16x16x128_f8f6f4(cat8(Bt[n][0], Bt[n][1]), cat8(At[m][0], At[m][1]), acc[ai][bj][m][n], 0, 0, 0, 0, 0, 0); \
        else { _Pragma("unroll") for (int k = 0; k < 2; ++k) acc[ai][bj][m][n] = __builtin_amdgcn_mfma_f32_16x16x32_bf16(Bt[n][k], At[m][k], acc[ai][bj][m][n], 0, 0, 0); } } __builtin_amdgcn_s_setprio(0); } while (0)
#define PG8_WAIT_V(n) asm volatile("s_waitcnt vmcnt(" #n ")" ::: "memory")
#define PG8_WAIT_L(n) asm volatile("s_waitcnt lgkmcnt(" #n ")" ::: "memory")
#define PG8_WAIT_VP() do { if (peel) asm volatile("s_waitcnt vmcnt(%0)" :: "n"(8 + (Epi::NSTORES > 0 ? Epi::NSTORES : 0)) : "memory"); else PG8_WAIT_V(8); } while (0)
#define PG8_BAR __builtin_amdgcn_s_barrier()
#define PG8_SCHED __builtin_amdgcn_sched_barrier(0)
    constexpr bool PRE = SP2 && Epi::NSTORES > 0 && Epi::NSTORES <= 55;
    bool pre = false;
    Unit cur, nxt; int ui = 0;
    if (!S.next(0, cur)) return;
    PG8_LAS float* rsb = (PG8_LAS float*)(lds + STAGE_BYTES + 12288);
    if constexpr (Epi::RSLDS) E.rs_first(cur, rsb, tid);
    f32x4 acc[2][2][4][2];
#pragma unroll
    for (int a = 0; a < 2; ++a)
#pragma unroll
        for (int b = 0; b < 2; ++b)
#pragma unroll
            for (int m = 0; m < 4; ++m)
#pragma unroll
                for (int n = 0; n < 2; ++n) acc[a][b][m][n] = (f32x4){0.f, 0.f, 0.f, 0.f};
    bf16x8 At[4][2], B0[2][2], B1[2][2];
    const char* cA = (const char*)g.A + (size_t)cur.pm * tstep + (cur.hm == 2 ? hstep : 0); const char* cB = (const char*)g.Bt + (size_t)cur.bn * tstep + (cur.hn == 2 ? hstep : 0);
    S.a_ready(cur);
    if constexpr (SP2) {
        PG8_STAGE(PG8_SB(0, 0), cB, voffB); PG8_STAGE(PG8_SB(0, 1), cB + hstep, voffB); PG8_STAGE(PG8_SA(0, 0), cA, voffA); PG8_STAGE(PG8_SA(0, 1), cA + hstep, voffA);
        if (wr == 1) PG8_BAR;
        PG8_WAIT_V(2); PG8_BAR;
        PG8_STAGE(PG8_SB(1, 0), cB + kstep, voffB); PG8_STAGE(PG8_SA(1, 0), cA + kstep, voffA); PG8_STAGE(PG8_SB(1, 1), cB + hstep + kstep, voffB);
        PG8_WAIT_V(6); PG8_BAR;
    } else {
        PG8_STAGE(PG8_SB(0, 0), cB, voffB); PG8_STAGE(PG8_SA(0, 0), cA, voffA); PG8_STAGE(PG8_SB(0, 1), cB + hstep, voffB); PG8_STAGE(PG8_SA(0, 1), cA + hstep, voffA);
        if (wr == 1) PG8_BAR;
        PG8_WAIT_V(4); PG8_BAR;
        PG8_STAGE(PG8_SB(1, 0), cB + kstep, voffB); PG8_STAGE(PG8_SA(1, 0), cA + kstep, voffA); PG8_STAGE(PG8_SB(1, 1), cB + hstep + kstep, voffB);
        PG8_WAIT_V(6); PG8_BAR;
    }
    for (;;) {
        const bool has_next = S.next(ui + 1, nxt);
        const char* nA = has_next ? (const char*)g.A + (size_t)nxt.pm * tstep + (nxt.hm == 2 ? hstep : 0) : cA; const char* nB = has_next ? (const char*)g.Bt + (size_t)nxt.bn * tstep + (nxt.hn == 2 ? hstep : 0) : cB;
        for (int t = 0; t < nt; t += 2) {
            const bool last = (t == nt - 2);
            const char* a1 = cA + (size_t)(t + 1) * kstep;
            const char* a2 = last ? nA : cA + (size_t)(t + 2) * kstep; const char* b2 = last ? nB : cB + (size_t)(t + 2) * kstep;
            const char* a3 = a2 + kstep; const char* b3 = b2 + kstep;
            if (last && has_next) S.a_ready(nxt);
            if constexpr (SP2) {
            const bool peel = PRE && pre && t == 0;
            PG8_LDB(B0, 0, 0); PG8_LDB(B1, 0, 1); PG8_SCHED; PG8_LDA(At, 0, 0); if (!peel) PG8_STAGE(PG8_SA(1, 1), a1 + hstep, voffA);
            PG8_WAIT_VP(); PG8_WAIT_L(0); PG8_BAR; PG8_MMA(0, 0, At, B0); if (!cur.hn) PG8_MMA(0, 1, At, B1); PG8_BAR; PG8_SCHED;
            PG8_LDA(At, 0, 1); PG8_STAGE(PG8_SB(0, 0), b2, voffB); PG8_STAGE(PG8_SB(0, 1), b2 + hstep, voffB); PG8_STAGE(PG8_SA(0, 0), a2, voffA);
            PG8_WAIT_VP(); PG8_WAIT_L(0); PG8_BAR; if (!cur.hm) { PG8_MMA(1, 0, At, B0); if (!cur.hn) PG8_MMA(1, 1, At, B1); } PG8_BAR; PG8_SCHED;
            PG8_LDB(B0, 1, 0); PG8_LDB(B1, 1, 1); PG8_SCHED; PG8_LDA(At, 1, 0); PG8_STAGE(PG8_SA(0, 1), a2 + hstep, voffA);
            PG8_WAIT_VP(); PG8_WAIT_L(0); PG8_BAR; PG8_MMA(0, 0, At, B0); if (!cur.hn) PG8_MMA(0, 1, At, B1); PG8_BAR; PG8_SCHED;
            PG8_LDA(At, 1, 1); PG8_STAGE(PG8_SB(1, 0), b3, voffB); PG8_STAGE(PG8_SB(1, 1), b3 + hstep, voffB); PG8_STAGE(PG8_SA(1, 0), a3, voffA);
            PG8_WAIT_V(8); PG8_WAIT_L(0); PG8_BAR; if (!cur.hm) { PG8_MMA(1, 0, At, B0); if (!cur.hn) PG8_MMA(1, 1, At, B1); } PG8_BAR; PG8_SCHED;
            } else {
            PG8_LDB(B0, 0, 0); PG8_SCHED; PG8_LDA(At, 0, 0); PG8_STAGE(PG8_SA(1, 1), a1 + hstep, voffA);
            PG8_WAIT_L(8); PG8_BAR; PG8_WAIT_L(0); PG8_MMA(0, 0, At, B0); PG8_BAR; PG8_SCHED;
            PG8_LDB(B1, 0, 1); PG8_STAGE(PG8_SB(0, 0), b2, voffB);
            PG8_BAR; PG8_WAIT_L(0); PG8_MMA(0, 1, At, B1); PG8_BAR;
            PG8_LDA(At, 0, 1); PG8_STAGE(PG8_SA(0, 0), a2, voffA);
            PG8_BAR; PG8_WAIT_L(0); PG8_MMA(1, 0, At, B0); PG8_BAR; PG8_SCHED;
            PG8_STAGE(PG8_SB(0, 1), b2 + hstep, voffB);
            PG8_WAIT_V(6); PG8_BAR; PG8_MMA(1, 1, At, B1); PG8_BAR;
            PG8_LDB(B0, 1, 0); PG8_SCHED; PG8_LDA(At, 1, 0); PG8_STAGE(PG8_SA(0, 1), a2 + hstep, voffA);
            PG8_WAIT_L(8); PG8_BAR; PG8_WAIT_L(0); PG8_MMA(0, 0, At, B0); PG8_BAR; PG8_SCHED;
            PG8_LDB(B1, 1, 1); PG8_STAGE(PG8_SB(1, 0), b3, voffB);
            PG8_BAR; PG8_WAIT_L(0); PG8_MMA(0, 1, At, B1); PG8_BAR;
            PG8_LDA(At, 1, 1); PG8_STAGE(PG8_SA(1, 0), a3, voffA);
            PG8_BAR; PG8_WAIT_L(0); PG8_MMA(1, 0, At, B0); PG8_BAR; PG8_SCHED;
            PG8_STAGE(PG8_SB(1, 1), b3 + hstep, voffB);
            PG8_WAIT_V(6); PG8_BAR; PG8_MMA(1, 1, At, B1); PG8_BAR;
            }
        }
        if constexpr (PRE) { if (has_next) PG8_STAGE(PG8_SA(1, 1), nA + kstep + hstep, voffA); pre = has_next; }
        if constexpr (ALIGN_EPI) { if (wr == 0) PG8_BAR; }
        if constexpr (!Epi::AFTER_DRAIN) {
            if constexpr (Epi::RSLDS) E(acc, cur, wr, wc, fr, fq, rsb + (ui & 1) * 256, rsb + ((ui & 1) ^ 1) * 256, nxt, has_next, tid); else E(acc, cur, wr, wc, fr, fq);
            S.done(cur); }
        if (!has_next) break;
#pragma unroll
        for (int a = 0; a < 2; ++a)
#pragma unroll
            for (int b = 0; b < 2; ++b)
#pragma unroll
                for (int m = 0; m < 4; ++m)
#pragma unroll
                    for (int n = 0; n < 2; ++n) acc[a][b][m][n] = (f32x4){0.f, 0.f, 0.f, 0.f};
        cur = nxt; cA = nA; cB = nB; ++ui;
        if constexpr (ALIGN_EPI) { if (wr == 1) PG8_BAR; }
    }
    PG8_WAIT_V(0);
    if constexpr (!ALIGN_EPI) { if (wr == 0) PG8_BAR; }
    PG8_BAR;
    if constexpr (Epi::AFTER_DRAIN) { E.fused(acc, cur, wr, wc, fr, fq, lds, wid, lane); S.done(cur); }
#undef PG8_SA
#undef PG8_SB
#undef PG8_STAGE
#undef PG8_LDA
#undef PG8_LDB
#undef PG8_MMA
#undef PG8_WAIT_V
#undef PG8_WAIT_L
#undef PG8_WAIT_VP
#undef PG8_BAR
#undef PG8_SCHED
}
}

constexpr int NWAVES = 8, NTHR = 512;
#ifndef FFN8_UP
#define FFN8_UP 2
#endif
constexpr int M = 32768, D = 1024, T = 4096, NBATCH = 8, PW = 3840, FF = 3584;
constexpr size_t MiB = 1u << 20;
constexpr size_t WS_CTL = 0, CTL_ZERO_BYTES = 1 * MiB;
constexpr size_t WS_SSP = 1 * MiB;
constexpr size_t WS_ROUTE = 3 * MiB;
constexpr size_t WS_LORA = 4 * MiB;
constexpr size_t WS_ROT = 5 * MiB;
constexpr size_t WS_W_EIN = 8 * MiB, WS_W_EOUT = WS_W_EIN + (size_t)PW * D * 2, WS_W_FGU = WS_W_EOUT + 2 * MiB, WS_W_FDN = WS_W_FGU + 14 * MiB,
                 WS_W_OIN = WS_W_FDN + 7 * MiB, WS_W_OOUT = WS_W_OIN + (size_t)PW * D * 2;
static_assert(WS_W_OOUT + 2 * MiB == 48 * MiB, "weight map");
constexpr size_t WS_HB0 = 48 * MiB, WS_HB1 = 112 * MiB, WS_RP = 176 * MiB, WS_RX = 416 * MiB;
constexpr size_t WS_PRET = WS_RP, WS_PRW = WS_RP + 128 * MiB;
constexpr size_t WS_YRAW = WS_HB0;
constexpr size_t WS_W_MGU = 8 * MiB, WS_W_MDN = 64 * MiB;
constexpr int MOE_ROWS = 67584, MOE_TILES = 264;
constexpr size_t WS_HMID = 176 * MiB, WS_XG = 407 * MiB, WS_END = 539 * MiB;
constexpr size_t WS_XG8 = 100 * MiB;
constexpr size_t WS_HBG = WS_HMID;
static_assert(WS_W_MGU + (size_t)5 * 2 * FF * D <= WS_W_OOUT, "experts 0..4 are converted while W_out of layer 1 is still live");
static_assert(WS_W_MGU + (size_t)8 * 2 * FF * D <= WS_W_MDN && WS_W_MDN + (size_t)8 * FF * D <= WS_XG8 && WS_XG8 + (size_t)MOE_ROWS * D <= WS_HMID, "moe fp8 map");
static_assert(WS_HMID + (size_t)MOE_TILES * 256 * FF <= WS_XG && WS_XG + (size_t)MOE_ROWS * D * 2 <= WS_END, "moe map");
constexpr size_t RT_E01 = 0, RT_W0 = 128 * 1024, RT_RS = 256 * 1024, RT_POS0 = 384 * 1024, RT_POS1 = 512 * 1024, RT_RSG = 640 * 1024, RT_CNT = 920 * 1024, RT_TILE_E = 936 * 1024, RT_META = 944 * 1024;
constexpr int CW_BAR = 4096;
constexpr int RING_BYTES = 131072, LDSCTL_OFF = RING_BYTES, MISC_OFF = LDSCTL_OFF + 320, LDS_BYTES = 147456;

#define GAS __attribute__((address_space(1)))
#define LAS __attribute__((address_space(3)))
typedef unsigned short bf16;
typedef unsigned v4u __attribute__((ext_vector_type(4)));
typedef unsigned v2u __attribute__((ext_vector_type(2)));
typedef float f32x4 __attribute__((ext_vector_type(4)));
typedef short bf16x8 __attribute__((ext_vector_type(8)));
typedef GAS unsigned gu32;
#define LDS_WAIT() asm volatile("s_waitcnt lgkmcnt(0)" ::: "memory")
#define VM_WAIT() asm volatile("s_waitcnt vmcnt(0)" ::: "memory")
#define WG_SYNC() __syncthreads()
#define LDS_SYNC() do { asm volatile("s_waitcnt lgkmcnt(0)" ::: "memory"); __builtin_amdgcn_s_barrier(); asm volatile("" ::: "memory"); } while (0)
__device__ __forceinline__ float bflo(unsigned u) { return __uint_as_float(u << 16); }
__device__ __forceinline__ float bfhi(unsigned u) { return __uint_as_float(u & 0xffff0000u); }
__device__ __forceinline__ float bf2f(bf16 u) { return __uint_as_float((unsigned)u << 16); }
typedef float f32x2n __attribute__((ext_vector_type(2)));
typedef __bf16 bfx2n __attribute__((ext_vector_type(2)));
__device__ __forceinline__ unsigned pk2(float lo, float hi) { const f32x2n v = {lo, hi}; return __builtin_bit_cast(unsigned, __builtin_convertvector(v, bfx2n)); }
__device__ __forceinline__ void unpack8(const v4u w, float (&f)[8]) { f[0] = bflo(w.x); f[1] = bfhi(w.x); f[2] = bflo(w.y); f[3] = bfhi(w.y); f[4] = bflo(w.z); f[5] = bfhi(w.z); f[6] = bflo(w.w); f[7] = bfhi(w.w); }
__device__ __forceinline__ v4u pack8(const float (&f)[8]) { v4u w; w.x = pk2(f[0], f[1]); w.y = pk2(f[2], f[3]); w.z = pk2(f[4], f[5]); w.w = pk2(f[6], f[7]); return w; }
__device__ __forceinline__ float fsig(float x) { return __builtin_amdgcn_rcpf(1.0f + __builtin_amdgcn_exp2f(-1.4426950408889634f * x)); }
__device__ __forceinline__ float fexp(float x) { return __builtin_amdgcn_exp2f(1.4426950408889634f * x); }
__device__ __forceinline__ float log_sigmoid(float x) { return fminf(x, 0.f) - 0.6931471805599453f * __builtin_amdgcn_logf(1.0f + __builtin_amdgcn_exp2f(-1.4426950408889634f * fabsf(x))); }
#define DPPF(old, v, ctrl, rmask, bc) __builtin_bit_cast(float, __builtin_amdgcn_update_dpp(__builtin_bit_cast(int, (float)(old)), __builtin_bit_cast(int, (float)(v)), (ctrl), (rmask), 0xf, (bc)))
__device__ __forceinline__ float wave_scan_add(float v) {
    v += DPPF(0.f, v, 0x111, 0xf, true); v += DPPF(0.f, v, 0x112, 0xf, true); v += DPPF(0.f, v, 0x114, 0xf, true); v += DPPF(0.f, v, 0x118, 0xf, true);
    v += DPPF(0.f, v, 0x142, 0xa, false); v += DPPF(0.f, v, 0x143, 0xc, false); return v;
}
__device__ __forceinline__ float wave_scan_max(float v) {
    const float NI = -__builtin_inff();
    v = fmaxf(v, DPPF(NI, v, 0x111, 0xf, false)); v = fmaxf(v, DPPF(NI, v, 0x112, 0xf, false)); v = fmaxf(v, DPPF(NI, v, 0x114, 0xf, false)); v = fmaxf(v, DPPF(NI, v, 0x118, 0xf, false));
    v = fmaxf(v, DPPF(NI, v, 0x142, 0xa, false)); v = fmaxf(v, DPPF(NI, v, 0x143, 0xc, false)); return v;
}
__device__ __forceinline__ float lane63(float v) { return __builtin_bit_cast(float, __builtin_amdgcn_readlane(__builtin_bit_cast(int, v), 63)); }
__device__ __forceinline__ float wave_sum(float v) { return lane63(wave_scan_add(v)); }
#define XB_TMO      128
#define XB_XCNT(j)  (256  + 64 * (j))
#define XB_XSUB(j)  (1280 + 64 * (j))
#define XB_XGEN(j)  (2304 + 64 * (j))
#define XB_TOP      3328
#define XB_TOPGEN   3392
#define XCD_BAR_WORDS 3456
#define XB_SPIN_CAP (1u << 18)

__device__ __forceinline__ unsigned xb_ld(unsigned* p)              { return __hip_atomic_load(p, __ATOMIC_RELAXED, __HIP_MEMORY_SCOPE_AGENT); }
__device__ __forceinline__ unsigned xb_add(unsigned* p, unsigned v) { return __hip_atomic_fetch_add(p, v, __ATOMIC_RELAXED, __HIP_MEMORY_SCOPE_AGENT); }
__device__ __forceinline__ unsigned xb_xcc_id() { return (unsigned)__builtin_amdgcn_s_getreg((3 << 11) | 20) & 0xFu; }
#define XB_SPIN(cond, bar) do { unsigned _sp = 0; while (cond) { __builtin_amdgcn_s_sleep(1); \
    if ((++_sp & 255u) == 0u) { if (xb_ld(&(bar)[XB_TMO])) break; if (_sp > XB_SPIN_CAP) { atomicAdd(&(bar)[XB_TMO], 1u); break; } } } } while (0)

struct XcdBarrier {
    unsigned* bar; unsigned x, wid;
    volatile LAS unsigned* st;
};

__device__ __forceinline__ unsigned xb_lane_id() { unsigned l; asm volatile("v_mbcnt_lo_u32_b32 %0, -1, 0\n\tv_mbcnt_hi_u32_b32 %0, -1, %0" : "=v"(l)); return l; }
__device__ __forceinline__ bool xb_lane0() { return xb_lane_id() == 0u; }
__device__ __forceinline__ XcdBarrier xcd_barrier_post(unsigned* bar, volatile LAS unsigned* st, unsigned wid) {
    XcdBarrier b; b.bar = bar; b.x = xb_xcc_id(); b.st = st; b.wid = wid;
    if (wid == 0u && xb_lane0()) (void)xb_add(&bar[XB_XCNT(b.x)], 1u);
    return b;
}
__device__ __forceinline__ void xcd_barrier_complete(unsigned* bar, unsigned x, unsigned& nloc, unsigned& nx) {
    const unsigned G = gridDim.x * gridDim.y * gridDim.z;
    unsigned sum, cnt, mine, sp = 0u;
    for (;;) {
        sum = 0u; cnt = 0u; mine = 0u;
#pragma unroll
        for (unsigned j = 0; j < 16; ++j) { const unsigned c = xb_ld(&bar[XB_XCNT(j)]); sum += c; cnt += (c > 0u) ? 1u : 0u; mine = (j == x) ? c : mine; }
        if (sum == G) break;
        __builtin_amdgcn_s_sleep(1);
        if ((++sp & 255u) == 0u) { if (xb_ld(&bar[XB_TMO])) break; if (sp > XB_SPIN_CAP) { atomicAdd(&bar[XB_TMO], 1u); break; } }
    }
    nloc = mine > 0u ? mine : 1u; nx = cnt > 0u ? cnt : 1u;
}

__device__ __forceinline__ void xcd_barrier(const XcdBarrier& b) {
    asm volatile("s_waitcnt vmcnt(0)" ::: "memory");
    __syncthreads();
    if (b.wid == 0u && xb_lane0()) {
        unsigned* bar = b.bar;
        __builtin_amdgcn_s_waitcnt(0);
        unsigned nloc = b.st[0], nx = b.st[1];
        if (nloc == 0u) { xcd_barrier_complete(bar, b.x, nloc, nx); b.st[0] = nloc; b.st[1] = nx; }
        const unsigned old = xb_add(&bar[XB_XSUB(b.x)], 1u);
        const unsigned gen = old / nloc;
        if (old + 1u == (gen + 1u) * nloc) {
            __builtin_amdgcn_fence(__ATOMIC_RELEASE, "agent");
            asm volatile("s_waitcnt vmcnt(0)" ::: "memory");
            const unsigned og = xb_add(&bar[XB_TOP], 1u);
            const unsigned tg = og / nx;
            if (og + 1u == (tg + 1u) * nx) xb_add(&bar[XB_TOPGEN], 1u);
            else XB_SPIN(xb_ld(&bar[XB_TOPGEN]) == tg, bar);
            __builtin_amdgcn_fence(__ATOMIC_ACQUIRE, "agent");
            xb_add(&bar[XB_XGEN(b.x)], 1u);
            asm volatile("s_waitcnt vmcnt(0)" ::: "memory");
        } else {
            XB_SPIN(xb_ld(&bar[XB_XGEN(b.x)]) == gen, bar);
            __builtin_amdgcn_fence(__ATOMIC_ACQUIRE, "agent");
            asm volatile("s_waitcnt vmcnt(0)" ::: "memory");
        }
    }
    __syncthreads();
}

enum { I_X = 0, I_EN1G, I_EWIN, I_CONVW, I_CONVB, I_GATEB, I_MLNG, I_GLAUP, I_GLAB, I_GLANG, I_EWOUT, I_EN2G, I_FFG, I_FFU, I_FFD,
       I_ON1G, I_OWIN, I_RETNG, I_RWMU, I_RWWUP, I_RWW0, I_RWAUP, I_RWA0, I_RWGUP, I_RWKK, I_RWKA, I_RWRK, I_RWLNG, I_RWLNB, I_OWOUT, I_ON2G, I_ROUTER, I_MG, I_MU, I_MD, I_FNG, N_IN };
struct Args { const float* in[N_IN]; float* out; unsigned char* ws; int ph_lo, ph_hi; };
struct Ctx { int tid, lane, wid, G, bid, vb; LAS unsigned char* lds; };

__device__ __forceinline__ void tr_item(const float* W, int K, int N, int nblk, bf16* WT, int mode, const float* gain, LAS float* scr, int item, int lane) {
    const int kb = item / nblk, nb = item % nblk, k0 = 64 * kb, n0 = 32 * nb;
    const int nn = n0 + (lane & 31); const bool ok = nn < N;
    const int c = lane & 7;
    f32x4 ga = {1.f, 1.f, 1.f, 1.f}, gb = ga; if (gain) { ga = *(const GAS f32x4*)(gain + k0 + 8 * c); gb = *(const GAS f32x4*)(gain + k0 + 8 * c + 4); }
    float wv[32];
#pragma unroll
    for (int i = 0; i < 32; ++i) { const int kk = 2 * i + (lane >> 5); wv[i] = ok ? W[(size_t)(k0 + kk) * N + nn] : 0.f; }
#pragma unroll
    for (int i = 0; i < 32; ++i) { const int kk = 2 * i + (lane >> 5); scr[kk * 33 + (lane & 31)] = wv[i]; }
    LDS_WAIT(); asm volatile("" ::: "memory");
#pragma unroll
    for (int j = 0; j < 4; ++j) { const int n = (lane >> 3) + 8 * j; const LAS float* s = scr + (8 * c) * 33 + n;
        v4u o; o.x = pk2(s[0 * 33] * ga[0], s[1 * 33] * ga[1]); o.y = pk2(s[2 * 33] * ga[2], s[3 * 33] * ga[3]); o.z = pk2(s[4 * 33] * gb[0], s[5 * 33] * gb[1]); o.w = pk2(s[6 * 33] * gb[2], s[7 * 33] * gb[3]);
        const int ncol = n0 + n; const int drow = mode == 0 ? ncol : ((ncol >> 7) * 256 + (mode == 2 ? 128 : 0) + (ncol & 127));
        *(GAS v4u*)(WT + (size_t)drow * K + k0 + 8 * c) = o; }
    LDS_WAIT(); asm volatile("" ::: "memory");
}
__device__ __forceinline__ void tr_item8(const float* W, int K, int N, int nblk, unsigned char* WT, int mode, const float* gain, LAS float* scr, int item, int lane) {
    const int kb = item / nblk, nb = item % nblk, k0 = 64 * kb, n0 = 32 * nb;
    const int nn = n0 + (lane & 31); const bool ok = nn < N;
    const int c = lane & 3;
    f32x4 g4[4];
#pragma unroll
    for (int q = 0; q < 4; ++q) { g4[q] = (f32x4){256.f, 256.f, 256.f, 256.f}; if (gain) g4[q] = *(const GAS f32x4*)(gain + k0 + 16 * c + 4 * q) * 256.0f; }
    float wv[32];
#pragma unroll
    for (int i = 0; i < 32; ++i) { const int kk = 2 * i + (lane >> 5); wv[i] = ok ? W[(size_t)(k0 + kk) * N + nn] : 0.f; }
#pragma unroll
    for (int i = 0; i < 32; ++i) { const int kk = 2 * i + (lane >> 5); scr[kk * 33 + (lane & 31)] = wv[i]; }
    LDS_WAIT(); asm volatile("" ::: "memory");
#pragma unroll
    for (int j = 0; j < 2; ++j) { const int n = (lane >> 2) + 16 * j; const LAS float* s = scr + (16 * c) * 33 + n;
        v4u o; o.x = pg8::pk4f8(s[0 * 33] * g4[0][0], s[1 * 33] * g4[0][1], s[2 * 33] * g4[0][2], s[3 * 33] * g4[0][3]); o.y = pg8::pk4f8(s[4 * 33] * g4[1][0], s[5 * 33] * g4[1][1], s[6 * 33] * g4[1][2], s[7 * 33] * g4[1][3]);
        o.z = pg8::pk4f8(s[8 * 33] * g4[2][0], s[9 * 33] * g4[2][1], s[10 * 33] * g4[2][2], s[11 * 33] * g4[2][3]); o.w = pg8::pk4f8(s[12 * 33] * g4[3][0], s[13 * 33] * g4[3][1], s[14 * 33] * g4[3][2], s[15 * 33] * g4[3][3]);
        const int ncol = n0 + n; const int drow = mode == 0 ? ncol : ((ncol >> 7) * 256 + (mode == 2 ? 128 : 0) + (ncol & 127));
        *(GAS v4u*)(WT + (size_t)drow * K + k0 + 16 * c) = o; }
    LDS_WAIT(); asm volatile("" ::: "memory");
}
struct TrJob { const float* W; int K, N, nblk; bf16* WT; int mode; const float* gain; };
__device__ __forceinline__ void tr_run(const TrJob& j, LAS float* scr, int gw, int NGW, int lane) {
    const int nitems = (j.K / 64) * j.nblk;
    for (int it = gw; it < nitems; it += NGW) tr_item(j.W, j.K, j.N, j.nblk, j.WT, j.mode, j.gain, scr, it, lane);
}
struct TrJob8 { const float* W; int K, N, nblk; unsigned char* WT; int mode; const float* gain; };
__device__ __forceinline__ void tr_run8(const TrJob8& j, LAS float* scr, int gw, int NGW, int lane) {
    const int nitems = (j.K / 64) * j.nblk;
    for (int it = gw; it < nitems; it += NGW) tr_item8(j.W, j.K, j.N, j.nblk, j.WT, j.mode, j.gain, scr, it, lane);
}
__device__ __forceinline__ void layer_weights_late(const Args& A, const Ctx& C, int gw, int NGW) {
    LAS float* scr = (LAS float*)(C.lds + C.wid * 16384); unsigned char* ws = A.ws;
    { TrJob j{A.in[I_EWOUT], D, D, D / 32, (bf16*)(ws + WS_W_EOUT), 0, nullptr}; tr_run(j, scr, gw, NGW, C.lane); }
#if FFN8_UP
    { TrJob8 j{A.in[I_FFG], D, FF, FF / 32, ws + WS_W_FGU, 1, A.in[I_EN2G]}; tr_run8(j, scr, gw, NGW, C.lane); }
    { TrJob8 j{A.in[I_FFU], D, FF, FF / 32, ws + WS_W_FGU, 2, A.in[I_EN2G]}; tr_run8(j, scr, gw, NGW, C.lane); }
#if FFN8_UP == 2
    { TrJob8 j{A.in[I_FFD], FF, D, D / 32, ws + WS_W_FDN, 0, nullptr}; tr_run8(j, scr, gw, NGW, C.lane); }
#else
    { TrJob j{A.in[I_FFD], FF, D, D / 32, (bf16*)(ws + WS_W_FDN), 0, nullptr}; tr_run(j, scr, gw, NGW, C.lane); }
#endif
#else
    { TrJob j{A.in[I_FFG], D, FF, FF / 32, (bf16*)(ws + WS_W_FGU), 1, A.in[I_EN2G]}; tr_run(j, scr, gw, NGW, C.lane); }
    { TrJob j{A.in[I_FFU], D, FF, FF / 32, (bf16*)(ws + WS_W_FGU), 2, A.in[I_EN2G]}; tr_run(j, scr, gw, NGW, C.lane); }
    { TrJob8 j{A.in[I_FFD], FF, D, D / 32, ws + WS_W_FDN, 0, nullptr}; tr_run8(j, scr, gw, NGW, C.lane); }
#endif
    { TrJob j{A.in[I_OWIN], D, PW, PW / 32, (bf16*)(ws + WS_W_OIN), 0, A.in[I_ON1G]}; tr_run(j, scr, gw, NGW, C.lane); }
    { TrJob j{A.in[I_OWOUT], D, D, D / 32, (bf16*)(ws + WS_W_OOUT), 0, nullptr}; tr_run(j, scr, gw, NGW, C.lane); }
}
__device__ __forceinline__ void p0_prologue(const Args& A, const Ctx& C) {
    LAS float* scr = (LAS float*)(C.lds + C.wid * 16384);
    const int gw = C.bid * NWAVES + C.wid, NGW = C.G * NWAVES;
    unsigned char* ws = A.ws;
    { TrJob j{A.in[I_EWIN], D, 3608, PW / 32, (bf16*)(ws + WS_W_EIN), 0, A.in[I_EN1G]}; tr_run(j, scr, gw, NGW, C.lane); }
    if (C.G != 256) layer_weights_late(A, C, gw, NGW);
    { TrJob j{A.in[I_RWWUP], 64, 512, 16, (bf16*)(ws + WS_LORA), 0, nullptr}; tr_run(j, scr, gw, NGW, C.lane); }
    { TrJob j{A.in[I_RWAUP], 64, 512, 16, (bf16*)(ws + WS_LORA + 65536), 0, nullptr}; tr_run(j, scr, gw, NGW, C.lane); }
    { TrJob j{A.in[I_RWGUP], 128, 512, 16, (bf16*)(ws + WS_LORA + 131072), 0, nullptr}; tr_run(j, scr, gw, NGW, C.lane); }
    { unsigned* tcs = (unsigned*)(ws + WS_ROT);
      for (int e = C.bid * NTHR + C.tid; e < T * 64; e += C.G * NTHR) { const int t = e >> 6, i = e & 63;
          const float inv = exp2f(-(float)(2 * i) * (1.0f / 128.0f) * 13.287712379549449f);
          double rev = (double)((float)t * inv) * 0.15915494309189535; rev -= __builtin_rint(rev); const float fr = (float)rev;
          tcs[e] = pk2(__builtin_amdgcn_cosf(fr), __builtin_amdgcn_sinf(fr)); } }
    { const float* x = A.in[I_X]; bf16* xb = (bf16*)(ws + WS_HB0); float* ssp = (float*)(ws + WS_SSP);
      const int rpw = M / C.G, mb = C.vb * rpw;
      for (int i0 = C.wid; i0 < rpw; i0 += 2 * NWAVES) { const int m0 = mb + i0; f32x4 v[2][4];
#pragma unroll
          for (int r = 0; r < 2; ++r) { const int mr = (i0 + r * NWAVES < rpw) ? m0 + r * NWAVES : m0; const GAS f32x4* xr = (const GAS f32x4*)(x + (size_t)mr * D) + C.lane;
#pragma unroll
              for (int j = 0; j < 4; ++j) v[r][j] = xr[64 * j]; }
#pragma unroll
          for (int r = 0; r < 2; ++r) { const int m = m0 + r * NWAVES; if (i0 + r * NWAVES >= rpw) break; GAS v2u* o8 = (GAS v2u*)(xb + (size_t)m * D) + C.lane; float s = 0.f;
#pragma unroll
              for (int j = 0; j < 4; ++j) { const f32x4 t = v[r][j]; s += (t[0] * t[0] + t[1] * t[1]) + (t[2] * t[2] + t[3] * t[3]); v2u w; w.x = pk2(t[0], t[1]); w.y = pk2(t[2], t[3]); o8[64 * j] = w; }
              s = wave_sum(s);
              if (C.lane < 16) ssp[(size_t)m * 16 + C.lane] = C.lane == 0 ? s : 0.f; } } }
}
__device__ __forceinline__ void moe_weights(const Args& A, const Ctx& C, unsigned gu_mask, unsigned d_mask, int gw, int NGW) {
    LAS float* scr = (LAS float*)(C.lds + C.wid * 16384);
    for (int e = 0; e < 8; ++e) {
        if ((gu_mask >> e) & 1u) {
            { TrJob8 j{A.in[I_MG] + (size_t)e * D * FF, D, FF, FF / 32, A.ws + WS_W_MGU + (size_t)e * 2 * FF * D, 1, A.in[I_ON2G]}; tr_run8(j, scr, gw, NGW, C.lane); }
            { TrJob8 j{A.in[I_MU] + (size_t)e * D * FF, D, FF, FF / 32, A.ws + WS_W_MGU + (size_t)e * 2 * FF * D, 2, A.in[I_ON2G]}; tr_run8(j, scr, gw, NGW, C.lane); } }
        if ((d_mask >> e) & 1u) { TrJob8 j{A.in[I_MD] + (size_t)e * FF * D, FF, D, D / 32, A.ws + WS_W_MDN + (size_t)e * D * FF, 0, nullptr}; tr_run8(j, scr, gw, NGW, C.lane); } }
}

template <int KS, bool SWA = false, bool SWB = false> __device__ __forceinline__ f32x4 mma_rows(const LAS unsigned char* A, int lda, int m0, const LAS unsigned char* Bt, int ldb, int n0, f32x4 acc, int lane) {
    const int r = lane & 15, q = lane >> 4;
    const int sa = SWA ? (((m0 + r) >> 3) & 7) : 0, sb = SWB ? (((n0 + r) >> 3) & 7) : 0;
#pragma unroll
    for (int ks = 0; ks < KS; ++ks) {
        const bf16x8 a = *(const LAS bf16x8*)(A + (m0 + r) * lda + (((ks * 4 + q) ^ sa) * 16));
        const bf16x8 b = *(const LAS bf16x8*)(Bt + (n0 + r) * ldb + (((ks * 4 + q) ^ sb) * 16));
        acc = __builtin_amdgcn_mfma_f32_16x16x32_bf16(a, b, acc, 0, 0, 0);
    }
    return acc;
}
struct MixArgs {
    const bf16* P; int pitch;
    bf16* out;
    const float *convw, *convb, *gateb, *normg;
    const float *gup, *gb;
    float* snap;
    const unsigned* rcs;
};
__device__ __forceinline__ void scatter8x2(LAS unsigned char* base, int ld, int col0, int j0, const v4u a, const v4u b) {
    const unsigned aa[4] = {a.x, a.y, a.z, a.w}, bb[4] = {b.x, b.y, b.z, b.w};
    const int js = j0 ^ (((col0 >> 3) & 7) << 3);
#pragma unroll
    for (int i = 0; i < 8; ++i) { const unsigned lo = (aa[i >> 1] >> (16 * (i & 1))) & 0xffffu, hi = (bb[i >> 1] >> (16 * (i & 1))) & 0xffffu; *(LAS unsigned*)(base + (col0 + i) * ld + 2 * js) = lo | (hi << 16); }
}
template <int KIND>
__device__ __forceinline__ void mixer_unit(const MixArgs& X, const Ctx& C, int b, int h, int seg, int nseg, int pass) {
    constexpr int L = 64, DK = (KIND == 1) ? 64 : 128, DV = 128;
    constexpr int LDK = (DK + 8) * 2, LDL = (L + 8) * 2;
    constexpr int OFF_Q = 0, SZ_Q = L * LDK, OFF_K = OFF_Q + SZ_Q, OFF_KT = OFF_K + SZ_Q, SZ_KT = DK * LDL, OFF_PM = OFF_KT + SZ_KT, SZ_PM = L * LDL, OFF_VT = OFF_PM + SZ_PM, SZ_VT = DV * LDL,
                  OFF_ST = OFF_VT + SZ_VT, SZ_ST = DV * LDK, OFF_SC = OFF_ST + SZ_ST, SCB = (KIND == 1) ? 24576 : 8192, OFF_HS = 0;
    constexpr int HSLD = 132;
    static_assert(OFF_SC + SCB <= RING_BYTES && L * HSLD * 4 <= ((KIND == 1) ? OFF_VT : OFF_KT), "mixer LDS map");
    constexpr int SC_U = 0, SC_MM = 64, SC_RS = 128, SC_EM = 192, SC_CS = 256, SC_DEN = 320, SC_NV = 384, SC_CD = 512, SC_TAB = 576;
    constexpr int SC_LA = 0, LALD = 65, SC_GUP = SC_LA + 64 * LALD, SC_GB = SC_GUP + 1024, SC_GG = SC_GB + 64, SC_GS = SC_GG + 64;
    static_assert((SC_GS + 64) * 4 <= 24576 && (SC_TAB + 1280) * 4 <= 8192, "scalar region");
    LAS unsigned char* lds = C.lds;
    LAS unsigned char* Qs = lds + OFF_Q; LAS unsigned char* Ks = lds + OFF_K; LAS unsigned char* Kt = lds + OFF_KT; LAS unsigned char* Vt = lds + OFF_VT;
    LAS unsigned char* St = lds + OFF_ST; LAS unsigned char* Pm = lds + OFF_PM; LAS float* SC = (LAS float*)(lds + OFF_SC); LAS float* Hs = (LAS float*)(lds + OFF_HS);
    int tid = C.tid; asm volatile("" : "+v"(tid));
    const int lane = tid & 63, wid = C.wid, q4 = lane >> 4, r16 = lane & 15;
    const bf16* P = X.P; const int pitch = X.pitch;
    const float qscale = (KIND == 1) ? 0.125f : 0.08838834764831845f;
    const int c0 = (64 * seg) / nseg, c1 = (64 * (seg + 1)) / nseg;
    const bool full = pass == 1;
    constexpr int SNAP_F = (DK / 16) * 512 * 4 + 256;
    float* snap_base = X.snap + (size_t)((b * 4 + h) * nseg) * SNAP_F;
    LDS_SYNC();
    for (int i = tid; i < SZ_ST / 4; i += NTHR) ((LAS unsigned*)St)[i] = 0u;
    LAS float* NG = (LAS float*)(lds + LDSCTL_OFF + 8192);
    {
        const float ngv = X.normg[h * 128 + (tid & 127)]; float t0 = 0.f, t1 = 0.f, t2 = 0.f;
        if (KIND == 0) { const int k = (tid >> 7) & 3, c = tid & 127, tb = tid & 255; t0 = X.convw[k * 1024 + h * 128 + c]; t1 = X.convw[k * 1024 + 512 + h * 128 + c]; t2 = X.convb[(tb >> 7) * 512 + h * 128 + (tb & 127)]; }
        if (KIND == 1) { t0 = X.gup[(tid >> 6) * 256 + h * 64 + (tid & 63)]; t1 = X.gup[((tid + 512) >> 6) * 256 + h * 64 + (tid & 63)]; t2 = X.gb[h * 64 + (tid & 63)]; }
        if (tid < 128) NG[tid] = ngv;
        if (KIND == 0) { if (tid < 128) SC[SC_NV + tid] = 0.f; SC[SC_TAB + tid] = t0; SC[SC_TAB + 512 + tid] = t1; if (tid < 256) SC[SC_TAB + 1024 + tid] = t2; }
        if (KIND == 1) { SC[SC_GUP + tid] = t0; SC[SC_GUP + 512 + tid] = t1; if (tid < 64) SC[SC_GB + tid] = t2; } }
    float lg2 = 0.f;
    if (KIND == 2) lg2 = log2f(1.0f - exp2f(-5.0f - (float)h));
    float mprev = -1e30f, fsum = 0.f;
    constexpr int NST = DK / 16;
    f32x4 accs[NST];
#pragma unroll
    for (int i = 0; i < NST; ++i) accs[i] = (f32x4){0.f, 0.f, 0.f, 0.f};
    const int s_dkt = (DK == 64) ? (wid >> 1) : wid, s_et0 = (DK == 64) ? 4 * (wid & 1) : 0;
    constexpr int NOT = 4;
    const int o_rt = wid >> 1, o_et0 = 4 * (wid & 1);
    const int cc = tid & 15, r0 = tid >> 4, j0 = 2 * r0;
    const int ei = tid >> 3, esub = tid & 7;
    v4u pq[5], pk[5], pv[2], pe_cur[2];
    v4u pcs[2][2];
    v4u pgl[2]; unsigned pgi = 0u, pgf = 0u;
    float gb_i = 0.f, gb_f = 0.f; if (KIND == 0) { gb_i = X.gateb[h]; gb_f = X.gateb[4 + h]; }
#define MIX_LOAD(c_, full_) do { const int t0_ = (c_) * L; const size_t g0_ = (size_t)b * T + t0_; \
        if (KIND == 0) { \
            if (wid == 0) { pgi = P[(g0_ + lane + lz) * pitch + 2048 + h]; pgf = P[(g0_ + lane + lz) * pitch + 2052 + h]; } } \
        if (KIND == 2) { const int s_ = ccv >> 3, c8_ = ccv & 7; \
            _Pragma("unroll") for (int rr = 0; rr < 2; ++rr) { const int j = j0v + rr; \
                { const bf16* src = P + (g0_ + j) * pitch + s_ * 512 + h * 128 + 8 * c8_; pq[2 * rr] = *(const GAS v4u*)src; pq[2 * rr + 1] = *(const GAS v4u*)(src + 64);   \
                    const GAS v4u* pc_ = (const GAS v4u*)(X.rcs + (size_t)(t0_ + j) * 64 + 8 * c8_); pcs[rr][0] = pc_[0]; pcs[rr][1] = pc_[1]; } \
                pv[rr] = *(const GAS v4u*)(P + (g0_ + j) * pitch + 1024 + h * 128 + 8 * ccv); } } \
        if (KIND == 1) { const int s_ = tid >> 8, jp_ = 2 * ((tid >> 3) & 31) + lz, c8_ = (tid & 7) + lz; \
            { _Pragma("unroll") for (int rr = 0; rr < 2; ++rr) pq[rr] = *(const GAS v4u*)(P + (g0_ + jp_ + rr) * pitch + 2056 + 256 * s_ + h * 64 + 8 * c8_); } \
            _Pragma("unroll") for (int rr = 0; rr < 2; ++rr) pv[rr] = *(const GAS v4u*)(P + (g0_ + j0v + rr) * pitch + 2568 + h * 128 + 8 * ccv); \
            const GAS v4u* gp_ = (const GAS v4u*)(P + (g0_ + lane + lz) * pitch + 3592); pgl[0] = gp_[0]; pgl[1] = gp_[1]; } \
    } while (0)
#define MIX_LOAD_NOW(c_, full_) do { const int t0_ = (c_) * L; \
        if (KIND == 0) { \
            _Pragma("unroll") for (int k = 0; k < 5; ++k) { const int tt = t0_ + j0v - 3 + k; const bool okr = tt >= 0; const size_t ro = ((size_t)b * T + (okr ? tt : 0)) * pitch + h * 128 + 8 * ccv; \
                { pq[k] = *(const GAS v4u*)(P + ro); if (!okr) pq[k] = (v4u){0u, 0u, 0u, 0u}; } \
                pk[k] = *(const GAS v4u*)(P + ro + 512); if (!okr) pk[k] = (v4u){0u, 0u, 0u, 0u}; } \
            _Pragma("unroll") for (int rr = 0; rr < 2; ++rr) pv[rr] = *(const GAS v4u*)(P + ((size_t)b * T + t0_ + j0v + rr) * pitch + 1024 + h * 128 + 8 * ccv); } \
    } while (0)
#define MIX_LOAD_E(c_) do { const size_t g0_ = (size_t)b * T + (c_) * L; const int eo_ = (KIND == 1) ? 3080 : 1536; const GAS v4u* ep_ = (const GAS v4u*)(P + (g0_ + eiv) * pitch + eo_ + h * 128 + 16 * esubv); pe_cur[0] = ep_[0]; pe_cur[1] = ep_[1]; } while (0)
    { int lz = 0; asm volatile("" : "+v"(lz)); const int j0v = j0 + lz, ccv = cc + lz; MIX_LOAD(c0, full); }
    if (KIND == 1) { for (int i = tid; i < 64; i += NTHR) SC[SC_GS + i] = 0.f; }
    if (pass == 1) {
        f32x4 nsv[NST], nax = {0.f, 0.f, 0.f, 0.f}; float nm = 0.f, nF = 0.f, nnv = 0.f;
#define MIX_FOLD_LOAD(j_) do { const float* sp_ = snap_base + (size_t)(j_) * SNAP_F; const float* aux_ = sp_ + NST * 2048; \
            _Pragma("unroll") for (int x = 0; x < NST; ++x) nsv[x] = *(const GAS f32x4*)(sp_ + (x * 512 + tid) * 4); \
            if (KIND == 0) { nm = aux_[128]; nF = aux_[129]; nnv = aux_[tid & 127]; } \
            if (KIND == 1) nax = *(const GAS f32x4*)(aux_ + 16 * s_dkt + 4 * q4); } while (0)
        if (seg > 0) MIX_FOLD_LOAD(0);
        for (int j = 0; j < seg; ++j) {
            f32x4 csv[NST]; const f32x4 cax = nax; const float cm = nm, cF = nF, cnv = nnv;
#pragma unroll
            for (int x = 0; x < NST; ++x) csv[x] = nsv[x];
            { const int jn_ = (j + 1 < seg) ? j + 1 : j; MIX_FOLD_LOAD(jn_); }
            float fa = 1.f, fb = 1.f;
            if (KIND == 0) { const float mn = fmaxf(mprev + cF, cm); fa = fexp(mprev + cF - mn); fb = fexp(cm - mn); mprev = mn; }
            if (KIND == 2) fa = __builtin_amdgcn_exp2f(lg2 * (float)(64 * ((64 * (j + 1)) / nseg - (64 * j) / nseg)));
#pragma unroll
            for (int x = 0; x < NST; ++x) { f32x4 a = accs[x];
                if (KIND == 1) {
#pragma unroll
                    for (int r = 0; r < 4; ++r) a[r] *= fexp(cax[r]);
                } else a = a * fa;
                accs[x] = a + csv[x] * fb; }
            if (KIND == 0 && tid < 128) SC[SC_NV + tid] = fa * SC[SC_NV + tid] + fb * cnv; }
#undef MIX_FOLD_LOAD
#pragma unroll
        for (int x = 0; x < NST; ++x) { const int e = 16 * (s_et0 + x) + r16; v2u w; w.x = pk2(accs[x][0], accs[x][1]); w.y = pk2(accs[x][2], accs[x][3]);
            *(LAS v2u*)(St + e * LDK + 2 * (16 * s_dkt + 4 * q4)) = w; }
    }
    LDS_SYNC();

    for (int c = c0; c < c1; ++c) {
        const int t0 = c * L; const size_t grow0 = (size_t)b * T + t0;
        int lz = 0; asm volatile("" : "+v"(lz));
        const int j0v = j0 + lz, ccv = cc + lz, eiv = ei + lz, esubv = esub + lz, lv = lane + lz, q4v = lv >> 4, r16v = lv & 15;
        MIX_LOAD_NOW(c, full);
        MIX_LOAD_E(c);
        if (KIND == 0) {
            if (wid == 0) {
                const float ip = bf2f((bf16)pgi) + gb_i, fp = bf2f((bf16)pgf) + gb_f;
                const float bs = wave_scan_add(log_sigmoid(fp));
                const float u = ip - bs, am = wave_scan_max(u);
                const float Mi = fmaxf(mprev, am), g = lane63(bs), Ml = lane63(Mi);
                SC[SC_U + lane] = u; SC[SC_MM + lane] = Mi; SC[SC_RS + lane] = fexp(mprev - Mi); SC[SC_EM + lane] = fexp(-(bs + Mi)); SC[SC_CS + lane] = fexp(u - Ml);
                if (lane == 0) SC[SC_CD] = fexp(mprev - Ml);
                mprev = g + Ml; fsum += g; }
            LDS_SYNC();
        }
        if (KIND == 1) {
            float gl[16]; { float t8[8]; unpack8(pgl[0], t8);
#pragma unroll
                for (int i = 0; i < 8; ++i) gl[i] = t8[i]; unpack8(pgl[1], t8);
#pragma unroll
                for (int i = 0; i < 8; ++i) gl[8 + i] = t8[i]; }
#pragma unroll
            for (int k = 0; k < 8; ++k) { const int d = lz + wid * 8 + k; float z = SC[SC_GB + d];
#pragma unroll
                for (int r = 0; r < 16; ++r) z += gl[r] * SC[SC_GUP + r * 64 + d];
                const float v = wave_scan_add(log_sigmoid(z) * (1.0f / 16.0f));
                SC[SC_LA + lane * LALD + d] = v; if (lane == 63) { SC[SC_GG + d] = v; SC[SC_GS + d] += v; } }
            LDS_SYNC();
        }
        {
        if (KIND == 0) {
            v4u kt2[2];
#pragma unroll
            for (int rr = 0; rr < 2; ++rr) { const int j = j0 + rr;
#pragma unroll
                for (int s = 0; s < 2; ++s) {
                    if (s == 0 && !full) continue;
                    float acc[8];
#pragma unroll
                    for (int i = 0; i < 8; ++i) acc[i] = SC[lz + SC_TAB + 1024 + s * 128 + 8 * cc + i];
#pragma unroll
                    for (int k = 0; k < 4; ++k) { float xv[8]; unpack8(s == 0 ? pq[rr + k] : pk[rr + k], xv);
#pragma unroll
                        for (int i = 0; i < 8; ++i) acc[i] += xv[i] * SC[lz + SC_TAB + (s * 4 + k) * 128 + 8 * cc + i]; }
#pragma unroll
                    for (int i = 0; i < 8; ++i) acc[i] = acc[i] * fsig(acc[i]);
                    if (s == 0) {
#pragma unroll
                        for (int i = 0; i < 8; ++i) acc[i] *= qscale;
                        *(LAS v4u*)(Qs + j * LDK + 16 * cc) = pack8(acc);
                    } else {
                        *(LAS v4u*)(Ks + j * LDK + 16 * cc) = pack8(acc);
                        const float cs = SC[SC_CS + j];
#pragma unroll
                        for (int i = 0; i < 8; ++i) acc[i] *= cs;
                        kt2[rr] = pack8(acc);
                    }
                    __builtin_amdgcn_sched_barrier(0);
                } }
            scatter8x2(Kt, LDL, 8 * cc, j0, kt2[0], kt2[1]); scatter8x2(Vt, LDL, 8 * cc, j0, pv[0], pv[1]);
        }
        if (KIND == 2) {
            const int s = cc >> 3, c8 = cc & 7; v4u kt1[2], kt2[2];
#pragma unroll
            for (int rr = 0; rr < 2; ++rr) { const int j = j0 + rr;
                if (full || s == 1) {
                    float x1[8], x2[8]; unpack8(pq[2 * rr], x1); unpack8(pq[2 * rr + 1], x2);
                    const unsigned csw[8] = {pcs[rr][0].x, pcs[rr][0].y, pcs[rr][0].z, pcs[rr][0].w, pcs[rr][1].x, pcs[rr][1].y, pcs[rr][1].z, pcs[rr][1].w};
                    float o1[8], o2[8];
#pragma unroll
                    for (int i = 0; i < 8; ++i) { const float cv = bflo(csw[i]), sv = bfhi(csw[i]); o1[i] = x1[i] * cv - x2[i] * sv; o2[i] = x1[i] * sv + x2[i] * cv; }
                    if (s == 0) {
#pragma unroll
                        for (int i = 0; i < 8; ++i) { o1[i] *= qscale; o2[i] *= qscale; }
                        *(LAS v4u*)(Qs + j * LDK + 16 * c8) = pack8(o1); *(LAS v4u*)(Qs + j * LDK + 128 + 16 * c8) = pack8(o2);
                    } else {
                        *(LAS v4u*)(Ks + j * LDK + 16 * c8) = pack8(o1); *(LAS v4u*)(Ks + j * LDK + 128 + 16 * c8) = pack8(o2);
                        const float cs = __builtin_amdgcn_exp2f(lg2 * (float)(L - 1 - j));
#pragma unroll
                        for (int i = 0; i < 8; ++i) { o1[i] *= cs; o2[i] *= cs; }
                        kt1[rr] = pack8(o1); kt2[rr] = pack8(o2);
                    } }
                __builtin_amdgcn_sched_barrier(0); }
            if (s == 1) { scatter8x2(Kt, LDL, 8 * c8, j0, kt1[0], kt1[1]); scatter8x2(Kt, LDL, 64 + 8 * c8, j0, kt2[0], kt2[1]); }
            scatter8x2(Vt, LDL, 8 * cc, j0, pv[0], pv[1]);
        }
        if (KIND == 1) {
            { const int sk = tid >> 8, jp = 2 * ((tid >> 3) & 31), c8 = tid & 7; v4u kw[2];
              if (full || sk == 1) {
#pragma unroll
                  for (int rr = 0; rr < 2; ++rr) { const int j = jp + rr; float xv[8]; unpack8(pq[rr], xv);
#pragma unroll
                      for (int i = 0; i < 8; ++i) { const float bvv = SC[SC_LA + j * LALD + 8 * c8 + i]; xv[i] *= (sk == 0) ? qscale * fexp(bvv) : fexp(-bvv); }
                      kw[rr] = pack8(xv);
                      *(LAS v4u*)((sk == 0 ? Qs : Ks) + j * LDK + 16 * c8) = kw[rr]; }
                  if (sk == 1) scatter8x2(Kt, LDL, 8 * c8, jp, kw[0], kw[1]); } }
            scatter8x2(Vt, LDL, 8 * cc, j0, pv[0], pv[1]);
        }
        }
        { const int cn_ = (c + 1 < c1) ? c + 1 : c; MIX_LOAD(cn_, full); }
        LDS_SYNC();
        f32x4 acco[NOT];
        if (full) {
            const int jt = wid >> 1;
#pragma unroll
            for (int x = 0; x < 2; ++x) { const int it = 2 * (wid & 1) + x;
                f32x4 s = (f32x4){0.f, 0.f, 0.f, 0.f};
                if (jt <= it) s = mma_rows<DK / 32>(Ks, LDK, 16 * jt, Qs, LDK, 16 * it, s, lv);
                const int i = 16 * it + r16v, j0 = 16 * jt + 4 * q4v; float p[4];
#pragma unroll
                for (int r = 0; r < 4; ++r) { const int j = j0 + r; float dcy;
                    if (KIND == 0) dcy = fexp(SC[SC_U + j] - SC[SC_MM + i]); else if (KIND == 2) dcy = __builtin_amdgcn_exp2f(lg2 * (float)(i - j)); else dcy = 1.f;
                    p[r] = (j <= i) ? s[r] * dcy : 0.f; }
                v2u w; w.x = pk2(p[0], p[1]); w.y = pk2(p[2], p[3]); *(LAS v2u*)(Pm + i * LDL + 2 * j0) = w; }
#pragma unroll
            for (int x = 0; x < NOT; ++x) { acco[x] = mma_rows<DK / 32>(Qs, LDK, 16 * o_rt, St, LDK, 16 * (o_et0 + x), (f32x4){0.f, 0.f, 0.f, 0.f}, lv);
                if (KIND != 1) {
#pragma unroll
                    for (int r = 0; r < 4; ++r) { const int i = 16 * o_rt + 4 * q4v + r; const float rs = (KIND == 0) ? SC[SC_RS + i] : __builtin_amdgcn_exp2f(lg2 * (float)(i + 1)); acco[x][r] *= rs; } }
                if (x & 1) asm volatile("" ::: "memory"); }
        }
        LDS_SYNC();
        if (full) {
#pragma unroll
            for (int x = 0; x < NOT; ++x) { acco[x] = mma_rows<L / 32, false, true>(Pm, LDL, 16 * o_rt, Vt, LDL, 16 * (o_et0 + x), acco[x], lv); if (x & 1) asm volatile("" ::: "memory"); }
            if (KIND == 0) { const int i = tid >> 3, sub = tid & 7; float pvv[8]; unpack8(*(const LAS v4u*)(Pm + i * LDL + 16 * sub), pvv);
                float ps = ((pvv[0] + pvv[1]) + (pvv[2] + pvv[3])) + ((pvv[4] + pvv[5]) + (pvv[6] + pvv[7])); float qn = 0.f;
#pragma unroll
                for (int hh = 0; hh < 2; ++hh) { float qv[8]; unpack8(*(const LAS v4u*)(Qs + i * LDK + 32 * sub + 16 * hh), qv);
#pragma unroll
                    for (int e = 0; e < 8; ++e) qn += qv[e] * SC[SC_NV + 16 * sub + 8 * hh + e]; }
                float v = ps + SC[SC_RS + i] * qn; v += __shfl_xor(v, 1); v += __shfl_xor(v, 2); v += __shfl_xor(v, 4);
                if (sub == 0) SC[SC_DEN + i] = v; }
        }
        { float pre = 1.f; if (KIND == 0) pre = SC[SC_CD]; if (KIND == 2) pre = __builtin_amdgcn_exp2f(lg2 * (float)L);
#pragma unroll
          for (int x = 0; x < NST; ++x) { f32x4 a = accs[x] * pre; a = mma_rows<L / 32, true, true>(Kt, LDL, 16 * s_dkt, Vt, LDL, 16 * (s_et0 + x), a, lv);
              if (KIND == 1) {
#pragma unroll
                  for (int r = 0; r < 4; ++r) a[r] *= fexp(SC[SC_GG + 16 * s_dkt + 4 * q4v + r]); }
              accs[x] = a; if (x & 1) asm volatile("" ::: "memory"); } }
        LDS_SYNC();
        if (full) {
#pragma unroll
            for (int x = 0; x < NOT; ++x)
#pragma unroll
                for (int r = 0; r < 4; ++r) { const int i = 16 * o_rt + 4 * q4v + r, e = 16 * (o_et0 + x) + r16v; float v = acco[x][r];
                    if (KIND == 0) v = v * __builtin_amdgcn_rcpf(fmaxf(fabsf(SC[SC_DEN + i]), SC[SC_EM + i]));
                    Hs[i * HSLD + e] = v; }
        }
        if (KIND == 0 && tid < 128) { float s = 0.f;
#pragma unroll
            for (int k = 0; k < 8; ++k) { float kv[8]; unpack8(*(const LAS v4u*)(Kt + tid * LDL + 16 * k), kv); s += ((kv[0] + kv[1]) + (kv[2] + kv[3])) + ((kv[4] + kv[5]) + (kv[6] + kv[7])); }
            SC[SC_NV + tid] = SC[SC_CD] * SC[SC_NV + tid] + s; }
#pragma unroll
        for (int x = 0; x < NST; ++x) { const int e = 16 * (s_et0 + x) + r16v; v2u w; w.x = pk2(accs[x][0], accs[x][1]); w.y = pk2(accs[x][2], accs[x][3]);
            *(LAS v2u*)(St + e * LDK + 2 * (16 * s_dkt + 4 * q4v)) = w; }
        LDS_SYNC();
        if (full) {
            const size_t row = grow0 + ei; float o[16];
#pragma unroll
            for (int k = 0; k < 4; ++k) { const f32x4 a = *(const LAS f32x4*)(Hs + ei * HSLD + 16 * esub + 4 * k); o[4 * k] = a[0]; o[4 * k + 1] = a[1]; o[4 * k + 2] = a[2]; o[4 * k + 3] = a[3]; }
            float gt[16]; { float t8[8]; unpack8(pe_cur[0], t8);
#pragma unroll
                for (int e = 0; e < 8; ++e) gt[e] = t8[e]; unpack8(pe_cur[1], t8);
#pragma unroll
                for (int e = 0; e < 8; ++e) gt[8 + e] = t8[e]; }
            if (KIND == 0) {
#pragma unroll
                for (int e = 0; e < 16; ++e) o[e] *= fsig(gt[e]); }
            float sm = 0.f;
            if (KIND != 1) {
#pragma unroll
                for (int e = 0; e < 16; ++e) sm += o[e];
                sm += __shfl_xor(sm, 1); sm += __shfl_xor(sm, 2); sm += __shfl_xor(sm, 4); }
            const float mean = sm * (1.0f / 128.0f); float vs = 0.f;
#pragma unroll
            for (int e = 0; e < 16; ++e) { o[e] -= mean; vs += o[e] * o[e]; }
            vs += __shfl_xor(vs, 1); vs += __shfl_xor(vs, 2); vs += __shfl_xor(vs, 4);
            const float rinv = __builtin_amdgcn_rsqf(vs * (1.0f / 128.0f) + 1e-6f);
            const int ocol = ((KIND == 1) ? 512 : 0) + h * 128 + 16 * esub;
#pragma unroll
            for (int e = 0; e < 16; ++e) { float v = o[e] * rinv * NG[lz + 16 * esub + e]; if (KIND != 0) v *= gt[e] * fsig(gt[e]); o[e] = v; }
            float lo8[8], hi8[8];
#pragma unroll
            for (int e = 0; e < 8; ++e) { lo8[e] = o[e]; hi8[e] = o[8 + e]; }
            GAS v4u* dst = (GAS v4u*)(X.out + row * 1024 + ocol); dst[0] = pack8(lo8); dst[1] = pack8(hi8);
            LDS_SYNC();
        }
    }
    if (pass == 0) {
        float* sp = snap_base + (size_t)seg * SNAP_F; float* aux = sp + NST * 2048;
#pragma unroll
        for (int x = 0; x < NST; ++x) *(GAS f32x4*)(sp + (x * 512 + tid) * 4) = accs[x];
        if (KIND == 0) { if (tid < 128) aux[tid] = SC[SC_NV + tid]; if (tid == 0) { aux[128] = mprev; aux[129] = fsum; } }
        if (KIND == 1) { if (tid < 64) aux[tid] = SC[SC_GS + tid]; }
    }
#undef MIX_LOAD
#undef MIX_LOAD_NOW
#undef MIX_LOAD_E
}

typedef short s16x4 __attribute__((ext_vector_type(4)));
#define DPP_ADD(v, ctrl) ((v) + __builtin_bit_cast(float, __builtin_amdgcn_update_dpp(0, __builtin_bit_cast(int, (v)), (ctrl), 0xf, 0xf, true)))
__device__ __forceinline__ float row16_sum(float v) { v = DPP_ADD(v, 0xB1); v = DPP_ADD(v, 0x4E); v = DPP_ADD(v, 0x141); v = DPP_ADD(v, 0x140); return v; }
__device__ __forceinline__ float row16_scan(float v) { v = DPP_ADD(v, 0x111); v = DPP_ADD(v, 0x112); v = DPP_ADD(v, 0x114); v = DPP_ADD(v, 0x118); return v; }
__device__ __forceinline__ f32x4 mfma32(bf16x8 a, bf16x8 b, f32x4 c) { return __builtin_amdgcn_mfma_f32_16x16x32_bf16(a, b, c, 0, 0, 0); }
__device__ __forceinline__ f32x4 mfma16(s16x4 a, s16x4 b, f32x4 c) { bf16x8 a8, b8; a8[0] = a[0]; a8[1] = a[1]; a8[2] = a[2]; a8[3] = a[3]; a8[4] = 0; a8[5] = 0; a8[6] = 0; a8[7] = 0;
    b8[0] = b[0]; b8[1] = b[1]; b8[2] = b[2]; b8[3] = b[3]; b8[4] = 0; b8[5] = 0; b8[6] = 0; b8[7] = 0; return mfma32(a8, b8, c); }
__device__ __forceinline__ s16x4 pk4(float a, float b, float c, float d) { v2u w; w.x = pk2(a, b); w.y = pk2(c, d); return __builtin_bit_cast(s16x4, w); }
__device__ __forceinline__ s16x4 pk4v(f32x4 v) { return pk4(v[0], v[1], v[2], v[3]); }
__device__ __forceinline__ bf16x8 cat8(s16x4 lo, s16x4 hi) { bf16x8 r; r[0] = lo[0]; r[1] = lo[1]; r[2] = lo[2]; r[3] = lo[3]; r[4] = hi[0]; r[5] = hi[1]; r[6] = hi[2]; r[7] = hi[3]; return r; }
constexpr int RW_REC = 11520;
constexpr int RWO_FU = 0, RWO_FS = 2048, RWO_FY = 6144, RWO_W2 = 8192, RWO_W4 = 8704, RWO_VC = 9216, RWO_G = 11264;
constexpr size_t WS_CHD_A = WS_RP, WS_CHD_B = WS_RX, WS_RWG2 = WS_RX + 68 * MiB, WS_RWBON = WS_RX + 100 * MiB;
static_assert(5 * 2048 * (size_t)RW_REC <= 128 * MiB && 3 * 2048 * (size_t)RW_REC <= 68 * MiB && WS_RWBON + MiB <= WS_END, "rwkv map");
__device__ __forceinline__ unsigned char* rw_record(unsigned char* ws, int b, int h, int c) {
    return b < 5 ? ws + WS_CHD_A + (size_t)((b * 8 + h) * 256 + c) * RW_REC : ws + WS_CHD_B + (size_t)(((b - 5) * 8 + h) * 256 + c) * RW_REC;
}
struct RwArgs {
    const bf16* PRW;
    const float *mu, *w0, *a0, *kk_w, *ka_w, *rk_w, *lng, *lnb;
    const bf16 *WupT, *AupT, *GupT;
    bf16* G; float* bonus;
    unsigned char* ws;
    float* yraw;
    bf16* out;
};
__device__ __forceinline__ void shift4(const bf16* PRW, const float* mu, size_t row, int t, int c, float (&o)[4]) {
    const v2u cur = *(const GAS v2u*)(PRW + row * 1792 + c); v2u prv; prv.x = 0u; prv.y = 0u;
    if (t > 0) prv = *(const GAS v2u*)(PRW + (row - 1) * 1792 + c);
    const f32x4 m = *(const GAS f32x4*)(mu + c);
    const float cu[4] = {bflo(cur.x), bfhi(cur.x), bflo(cur.y), bfhi(cur.y)}, pr[4] = {bflo(prv.x), bfhi(prv.x), bflo(prv.y), bfhi(prv.y)};
#pragma unroll
    for (int i = 0; i < 4; ++i) o[i] = cu[i] + (pr[i] - cu[i]) * m[i];
}
constexpr int RW_RAWLD = 3072 + 16;
__device__ __forceinline__ void shift4_lds(const LAS unsigned char* RAW, const LAS float* PAR, int tok16, int t, int arr, int c, float (&o)[4]) {
    const LAS unsigned char* rp = RAW + (tok16 + 1) * RW_RAWLD + arr * 1024 + c * 2;
    const v2u cur = *(const LAS v2u*)rp; v2u prv = *(const LAS v2u*)(rp - RW_RAWLD); if (t == 0) { prv.x = 0u; prv.y = 0u; }
    const f32x4 m = *(const LAS f32x4*)(PAR + arr * 512 + c);
    const float cu[4] = {bflo(cur.x), bfhi(cur.x), bflo(cur.y), bfhi(cur.y)}, pr[4] = {bflo(prv.x), bfhi(prv.x), bflo(prv.y), bfhi(prv.y)};
#pragma unroll
    for (int i = 0; i < 4; ++i) o[i] = cu[i] + (pr[i] - cu[i]) * m[i];
}
__device__ __forceinline__ void rwkv_prep_unit(const RwArgs& X, const Ctx& C, int unit, bool fill_par) {
    constexpr int LD64 = (64 + 8) * 2, LD128 = (128 + 8) * 2;
    LAS unsigned char* TD = C.lds; LAS unsigned char* XA = TD + 64 * LD64; LAS unsigned char* SG = XA + 64 * LD64;
    LAS float* PAR = (LAS float*)(C.lds + 36864);
    LAS unsigned char* RAW = C.lds + 36864 + 16384;
    int tid = C.tid; asm volatile("" : "+v"(tid));
    const int lane = tid & 63, wid = C.wid, q4_ = lane >> 4, r16_ = lane & 15;
    const size_t row0 = (size_t)unit * 64; const int tb = (unit * 64) & (T - 1), bat = unit >> 6;
    WG_SYNC();
    if (fill_par) { float pv[8]; pv[0] = X.mu[tid]; pv[1] = X.mu[512 + tid]; pv[2] = X.mu[1024 + tid]; pv[3] = X.w0[tid]; pv[4] = X.a0[tid]; pv[5] = X.kk_w[tid]; pv[6] = X.ka_w[tid]; pv[7] = X.rk_w[tid];
#pragma unroll
        for (int k = 0; k < 8; ++k) PAR[512 * k + tid] = pv[k]; }
    v4u cuw[4], prw[4];
#pragma unroll
    for (int k = 0; k < 4; ++k) { const int task = tid + NTHR * k, tok = task >> 5, ch = task & 31; const int c = 1536 + 8 * ch; const size_t row = row0 + tok; const int t = tb + tok;
        cuw[k] = *(const GAS v4u*)(X.PRW + row * 1792 + c); prw[k] = *(const GAS v4u*)(X.PRW + (t > 0 ? row - 1 : row) * 1792 + c); }
#pragma unroll
    for (int k = 0; k < 4; ++k) { const int task = tid + NTHR * k, tok = task >> 5, ch = task & 31;
        const int c = 1536 + 8 * ch; const int t = tb + tok;
        float cu[8], pr[8]; unpack8(cuw[k], cu); unpack8(prw[k], pr);
        if (!(t > 0)) {
#pragma unroll
            for (int i = 0; i < 8; ++i) pr[i] = 0.f; }
        float o[8]; const f32x4 mu0 = *(const GAS f32x4*)(X.mu + c), mu1 = *(const GAS f32x4*)(X.mu + c + 4);
#pragma unroll
        for (int i = 0; i < 8; ++i) { const float xs = cu[i] + (pr[i] - cu[i]) * (i < 4 ? mu0[i & 3] : mu1[i & 3]);
            const float r = __builtin_amdgcn_rcpf(1.0f + __builtin_amdgcn_exp2f((ch < 8 ? 2.885390081777927f : -1.4426950408889634f) * xs));
            o[i] = ch < 8 ? 1.0f - 2.0f * r : (ch < 16 ? xs : r); }
        const v4u w = pack8(o);
        if (ch < 8) *(LAS v4u*)(TD + tok * LD64 + 16 * ch) = w; else if (ch < 16) *(LAS v4u*)(XA + tok * LD64 + 16 * (ch - 8)) = w; else *(LAS v4u*)(SG + tok * LD128 + 16 * (ch - 16)) = w; }
    WG_SYNC();
    const s16x4 Ic = pk4(4 * q4_ + 0 == r16_ ? 1.f : 0.f, 4 * q4_ + 1 == r16_ ? 1.f : 0.f, 4 * q4_ + 2 == r16_ ? 1.f : 0.f, 4 * q4_ + 3 == r16_ ? 1.f : 0.f);
    const f32x4 Z4 = (f32x4){0.f, 0.f, 0.f, 0.f};
    bf16x8 fw[2], fa[2], fg[4];
#define RW_LDF(ct_) do { const size_t rb_ = (size_t)(64 * wid + 16 * (ct_) + r16); \
        _Pragma("unroll") for (int ks = 0; ks < 2; ++ks) { fw[ks] = *(const GAS bf16x8*)(X.WupT + rb_ * 64 + ks * 32 + 8 * q4); fa[ks] = *(const GAS bf16x8*)(X.AupT + rb_ * 64 + ks * 32 + 8 * q4); } \
        _Pragma("unroll") for (int ks = 0; ks < 4; ++ks) fg[ks] = *(const GAS bf16x8*)(X.GupT + rb_ * 128 + ks * 32 + 8 * q4); } while (0)
    { const int r16 = r16_, q4 = q4_; RW_LDF(0); }
#pragma unroll 1
    for (int tt = 0; tt < 4; ++tt) {
        int r16 = r16_, q4 = q4_; asm volatile("" : "+v"(r16), "+v"(q4));
        const int tok = 16 * tt + r16; const size_t row = row0 + tok; const int t = tb + tok;
        unsigned char* rec = rw_record(X.ws, bat, wid, (tb >> 4) + tt);
        LDS_SYNC();
        for (int pc = wid; pc < 51; pc += NWAVES) { const int rr_ = pc / 3, pp_ = pc - 3 * rr_;
            __builtin_amdgcn_global_load_lds((const unsigned*)((const unsigned char*)X.PRW + ((long)row0 + 16 * tt - 1 + rr_) * 3584 + pp_ * 1024 + lane * 16), (LAS unsigned*)(RAW + rr_ * RW_RAWLD + pp_ * 1024), 16, 0, 0); }
        asm volatile("s_waitcnt vmcnt(0)" ::: "memory");
        LDS_SYNC();
        float ss = 0.f;
#pragma unroll
        for (int ct = 0; ct < 4; ++ct) { const int c0 = 64 * wid + 16 * ct + 4 * q4; float xk[4]; shift4_lds(RAW, PAR, r16, t, 1, c0, xk);
            const f32x4 kw = *(const LAS f32x4*)(PAR + 5 * 512 + c0);
#pragma unroll
            for (int i = 0; i < 4; ++i) { const float v = xk[i] * kw[i]; ss += v * v; } }
        ss += __shfl_xor(ss, 16); ss += __shfl_xor(ss, 32);
        const float invn = 1.0f / fmaxf(sqrtf(ss), 1e-12f);
        float bon = 0.f;
        s16x4 fA[4], fBi[4], fKi[4], fR[4];
        bf16x8 tbd[2], tba[2], tbg[4];
#pragma unroll
        for (int ks = 0; ks < 2; ++ks) { tbd[ks] = *(const LAS bf16x8*)(TD + tok * LD64 + (ks * 32 + 8 * q4) * 2); tba[ks] = *(const LAS bf16x8*)(XA + tok * LD64 + (ks * 32 + 8 * q4) * 2); }
#pragma unroll
        for (int ks = 0; ks < 4; ++ks) tbg[ks] = *(const LAS bf16x8*)(SG + tok * LD128 + (ks * 32 + 8 * q4) * 2);
#pragma unroll
        for (int ct = 0; ct < 4; ++ct) {
            const int cb = 64 * wid + 16 * ct, c0 = cb + 4 * q4;
            f32x4 cw = Z4, ca = Z4, cg = Z4;
#pragma unroll
            for (int ks = 0; ks < 2; ++ks) { cw = mfma32(fw[ks], tbd[ks], cw); ca = mfma32(fa[ks], tba[ks], ca); }
#pragma unroll
            for (int ks = 0; ks < 4; ++ks) cg = mfma32(fg[ks], tbg[ks], cg);
            asm volatile("" : "+v"(cw), "+v"(ca), "+v"(cg));
            RW_LDF((ct + 1) & 3);
            const f32x4 w0v = *(const LAS f32x4*)(PAR + 3 * 512 + c0), a0v = *(const LAS f32x4*)(PAR + 4 * 512 + c0), kaw = *(const LAS f32x4*)(PAR + 6 * 512 + c0), rkw = *(const LAS f32x4*)(PAR + 7 * 512 + c0), kw = *(const LAS f32x4*)(PAR + 5 * 512 + c0);
            float xr[4], xk[4], xv[4]; shift4_lds(RAW, PAR, r16, t, 0, c0, xr); shift4_lds(RAW, PAR, r16, t, 1, c0, xk); shift4_lds(RAW, PAR, r16, t, 2, c0, xv);
            { v2u w; w.x = pk2(cg[0], cg[1]); w.y = pk2(cg[2], cg[3]); *(GAS v2u*)(X.G + row * 512 + c0) = w; }
            { const f32x4 vc = mfma16(pk4(xv[0], xv[1], xv[2], xv[3]), Ic, Z4); *(GAS s16x4*)(rec + RWO_VC + 512 * ct + lane * 8) = pk4v(vc); }
            float pa[4], pbi[4], pki[4], pr[4], pbh[4], pkh[4]; f32x4 g15;
#pragma unroll
            for (int i = 0; i < 4; ++i) { const float z = w0v[i] + cw[i];
                const float e = 0.6065306597126334f * fsig(z);
                const float a = fsig(a0v[i] + ca[i]);
                const float kkv = xk[i] * kw[i] * invn, khv = xk[i] * (1.0f + (a - 1.0f) * kaw[i]), bbv = kkv * a;
                bon += xr[i] * khv * rkw[i];
                const float cs = row16_scan(e);
                const float gi = fexp(cs), gt = __builtin_amdgcn_rcpf(gi);
                const float gsh = __builtin_bit_cast(float, __builtin_amdgcn_update_dpp(0, __builtin_bit_cast(int, gt), 0x111, 0xf, 0xf, true));
                const float gp = r16 == 0 ? 1.0f : gsh;
                const float gl15 = __builtin_bit_cast(float, __builtin_amdgcn_update_dpp(0, __builtin_bit_cast(int, gt), 0x15F, 0xf, 0xf, true));
                const float gl = gi * gl15;
                pa[i] = -kkv * gp; pbi[i] = bbv * gi; pki[i] = khv * gi; pr[i] = xr[i] * gt; pbh[i] = bbv * gl; pkh[i] = khv * gl; g15[i] = gl15; }
            fA[ct] = pk4(pa[0], pa[1], pa[2], pa[3]); fBi[ct] = pk4(pbi[0], pbi[1], pbi[2], pbi[3]); fKi[ct] = pk4(pki[0], pki[1], pki[2], pki[3]);
            fR[ct] = pk4(pr[0], pr[1], pr[2], pr[3]);
            { const s16x4 bhc = pk4v(mfma16(pk4(pbh[0], pbh[1], pbh[2], pbh[3]), Ic, Z4)), khc = pk4v(mfma16(pk4(pkh[0], pkh[1], pkh[2], pkh[3]), Ic, Z4));
              *(GAS bf16x8*)(rec + RWO_FS + 1024 * ct + lane * 16) = cat8(bhc, khc); }
            if (r16 == 0) *(GAS f32x4*)(rec + RWO_G + (16 * ct + 4 * q4) * 4) = g15;
        }
        bon += __shfl_xor(bon, 16); bon += __shfl_xor(bon, 32);
        if (q4 == 0) X.bonus[row * 8 + wid] = bon;
        f32x4 nA = Z4, nC = Z4, mkaA = Z4, mkaC = Z4, mbrA = Z4, mkrA = Z4;
#pragma unroll
        for (int ks = 0; ks < 2; ++ks) { const bf16x8 a8 = cat8(fA[2 * ks], fA[2 * ks + 1]), bi8 = cat8(fBi[2 * ks], fBi[2 * ks + 1]), ki8 = cat8(fKi[2 * ks], fKi[2 * ks + 1]), r8 = cat8(fR[2 * ks], fR[2 * ks + 1]);
            nA = mfma32(bi8, a8, nA); nC = mfma32(a8, bi8, nC); mkaA = mfma32(ki8, a8, mkaA); mkaC = mfma32(a8, ki8, mkaC); mbrA = mfma32(bi8, r8, mbrA); mkrA = mfma32(ki8, r8, mkrA); }
#pragma unroll
        for (int j = 0; j < 4; ++j) { const int o = 4 * q4 + j;
            if (!(o < r16)) { nA[j] = 0.f; mkaA[j] = 0.f; } if (!(r16 < o)) { nC[j] = 0.f; mkaC[j] = 0.f; } if (!(o <= r16)) { mbrA[j] = 0.f; mkrA[j] = 0.f; } }
        s16x4 Ta;
        { const s16x4 Na = pk4v(nA), Nc = pk4v(nC);
          const f32x4 n2c = mfma16(Na, Nc, Z4), n2a = mfma16(Nc, Na, Z4); const s16x4 N2a = pk4v(n2a), N2c = pk4v(n2c);
          const f32x4 n4c = mfma16(N2a, N2c, Z4), n4a = mfma16(N2c, N2a, Z4); const s16x4 N4a = pk4v(n4a), N4c = pk4v(n4c);
          const f32x4 n8c = mfma16(N4a, N4c, Z4);
          f32x4 f0 = nA, f1 = n2c, f2 = n4c, f3 = n8c;
#pragma unroll
          for (int j = 0; j < 4; ++j) if (4 * q4 + j == r16) { f0[j] += 1.f; f1[j] += 1.f; f2[j] += 1.f; f3[j] += 1.f; }
          const f32x4 p1 = mfma16(pk4v(f1), pk4v(f0), Z4);
          const f32x4 p2 = mfma16(pk4v(f2), pk4v(p1), Z4);
          const f32x4 p3 = mfma16(pk4v(f3), pk4v(p2), Z4);
          Ta = pk4v(p3); }
        const s16x4 MbrA = pk4v(mbrA), MkaC = pk4v(mkaC);
        { const f32x4 w2a = mfma16(MkaC, Ta, Z4), w2c = mfma16(Ta, MkaC, Z4);
          const f32x4 w4a = mfma16(pk4v(w2c), MbrA, mkrA);
          *(GAS s16x4*)(rec + RWO_W2 + lane * 8) = pk4v(w2a); *(GAS s16x4*)(rec + RWO_W4 + lane * 8) = pk4v(w4a); }
        s16x4 w1a[4], w3a[4];
#pragma unroll
        for (int ct = 0; ct < 4; ++ct) { const s16x4 Ac = pk4v(mfma16(fA[ct], Ic, Z4));
            const f32x4 x1a = mfma16(Ac, Ta, Z4), x1c = mfma16(Ta, Ac, Z4);
            f32x4 r0; { const v2u w = __builtin_bit_cast(v2u, fR[ct]); r0[0] = bflo(w.x); r0[1] = bfhi(w.x); r0[2] = bflo(w.y); r0[3] = bfhi(w.y); }
            const f32x4 x3a = mfma16(pk4v(x1c), MbrA, r0);
            w1a[ct] = pk4v(x1a); w3a[ct] = pk4v(x3a); }
#pragma unroll
        for (int ks = 0; ks < 2; ++ks) { *(GAS bf16x8*)(rec + RWO_FU + 1024 * ks + lane * 16) = cat8(w1a[2 * ks], w1a[2 * ks + 1]); *(GAS bf16x8*)(rec + RWO_FY + 1024 * ks + lane * 16) = cat8(w3a[2 * ks], w3a[2 * ks + 1]); }
    }
#undef RW_LDF
}
__device__ __forceinline__ void rwkv_scan(const RwArgs& X, const Ctx& C) {
    constexpr int SLOT = 12288, RING = 8, AHEAD = 6;
    const int lane = C.lane, q4 = lane >> 4, r16 = lane & 15, wid = C.wid;
    for (int v = C.vb; v < 256; v += C.G) { if ((v & 31) >= 8) continue; const int b = v >> 5, h = v & 31;
        const unsigned char* rec0 = rw_record(X.ws, b, h, 0);
        __syncthreads();
        if (wid >= 4) {
            const int lw = wid - 4;
#define RW_DMA(c_) do { const unsigned char* r_ = rec0 + (size_t)(c_) * RW_REC; LAS unsigned char* s_ = C.lds + ((c_) & (RING - 1)) * SLOT; \
                _Pragma("unroll") for (int p_ = 0; p_ < 3; ++p_) __builtin_amdgcn_global_load_lds((const unsigned*)(r_ + (lw + 4 * p_) * 1024 + lane * 16), (LAS unsigned*)(s_ + (lw + 4 * p_) * 1024), 16, 0, 0); } while (0)
            for (int c = 0; c < AHEAD; ++c) RW_DMA(c);
            for (int c = 0; c < 256; ++c) {
                if (c + AHEAD < 256) { RW_DMA(c + AHEAD); asm volatile("s_waitcnt vmcnt(18)" ::: "memory"); }
                else asm volatile("s_waitcnt vmcnt(0)" ::: "memory");
                __builtin_amdgcn_s_barrier();
            }
#undef RW_DMA
        } else {
            const int rg = wid;
            f32x4 S[4];
#pragma unroll
            for (int i = 0; i < 4; ++i) S[i] = (f32x4){0.f, 0.f, 0.f, 0.f};
            for (int c = 0; c < 256; ++c) {
                asm volatile("s_waitcnt lgkmcnt(0)" ::: "memory");
                __builtin_amdgcn_s_barrier();
                asm volatile("" ::: "memory");
                const LAS unsigned char* r = C.lds + (c & (RING - 1)) * SLOT;
                const bf16x8 fu0 = *(const LAS bf16x8*)(r + RWO_FU + lane * 16), fu1 = *(const LAS bf16x8*)(r + RWO_FU + 1024 + lane * 16);
                const bf16x8 fy0 = *(const LAS bf16x8*)(r + RWO_FY + lane * 16), fy1 = *(const LAS bf16x8*)(r + RWO_FY + 1024 + lane * 16);
                const bf16x8 fs0 = *(const LAS bf16x8*)(r + RWO_FS + lane * 16), fs1 = *(const LAS bf16x8*)(r + RWO_FS + 1024 + lane * 16), fs2 = *(const LAS bf16x8*)(r + RWO_FS + 2048 + lane * 16), fs3 = *(const LAS bf16x8*)(r + RWO_FS + 3072 + lane * 16);
                const s16x4 w2 = *(const LAS s16x4*)(r + RWO_W2 + lane * 8), w4 = *(const LAS s16x4*)(r + RWO_W4 + lane * 8), vc = *(const LAS s16x4*)(r + RWO_VC + 512 * rg + lane * 8);
                const f32x4 g0 = *(const LAS f32x4*)(r + RWO_G + (4 * q4) * 4), g1 = *(const LAS f32x4*)(r + RWO_G + (16 + 4 * q4) * 4), g2 = *(const LAS f32x4*)(r + RWO_G + (32 + 4 * q4) * 4), g3 = *(const LAS f32x4*)(r + RWO_G + (48 + 4 * q4) * 4);
                const bf16x8 s0 = cat8(pk4v(S[0]), pk4v(S[1])), s1 = cat8(pk4v(S[2]), pk4v(S[3]));
                f32x4 U = mfma16(w2, vc, (f32x4){0.f, 0.f, 0.f, 0.f}); U = mfma32(fu0, s0, U); U = mfma32(fu1, s1, U);
                f32x4 Y = mfma16(w4, vc, (f32x4){0.f, 0.f, 0.f, 0.f}); Y = mfma32(fy0, s0, Y); Y = mfma32(fy1, s1, Y);
                const bf16x8 uv = cat8(pk4v(U), vc);
                S[0] = mfma32(fs0, uv, S[0] * g0); S[1] = mfma32(fs1, uv, S[1] * g1); S[2] = mfma32(fs2, uv, S[2] * g2); S[3] = mfma32(fs3, uv, S[3] * g3);
                float* yp = X.yraw + ((size_t)b * T + (size_t)c * 16 + 4 * q4) * 512 + h * 64 + 16 * rg + r16;
                yp[0] = Y[0]; yp[512] = Y[1]; yp[1024] = Y[2]; yp[1536] = Y[3];
            }
        }
    }
}
__device__ __forceinline__ void rwkv_finish(const RwArgs& X, const Ctx& C) {
    const int gw = C.bid * NWAVES + C.wid, NGW = C.G * NWAVES, lane = C.lane, c = 8 * lane;
    float lg[8], lb[8], mv[8];
#pragma unroll
    for (int i = 0; i < 8; ++i) { lg[i] = X.lng[c + i]; lb[i] = X.lnb[c + i]; mv[i] = X.mu[1024 + c + i]; }
    const int rpw = M / C.G, mb = C.vb * rpw;
    for (int i0 = C.wid; i0 < rpw; i0 += 2 * NWAVES) { const int m0 = mb + i0;
        f32x4 yl[2][2]; v4u vw[2], pw[2], gw4[2]; float bsr[2];
#pragma unroll
        for (int r = 0; r < 2; ++r) { const int m = (i0 + r * NWAVES < rpw) ? m0 + r * NWAVES : m0; const size_t o = (size_t)m * 512 + c;
            yl[r][0] = *(const GAS f32x4*)(X.yraw + o); yl[r][1] = *(const GAS f32x4*)(X.yraw + o + 4);
            vw[r] = *(const GAS v4u*)(X.PRW + (size_t)m * 1792 + 1024 + c);
            { const bool hp = (m & (T - 1)) != 0; pw[r] = *(const GAS v4u*)(X.PRW + (size_t)(hp ? m - 1 : m) * 1792 + 1024 + c); if (!hp) pw[r] = (v4u){0u, 0u, 0u, 0u}; }
            gw4[r] = *(const GAS v4u*)(X.G + o); bsr[r] = X.bonus[(size_t)m * 8 + (lane >> 3)]; }
#pragma unroll
        for (int r = 0; r < 2; ++r) { const int m = m0 + r * NWAVES; if (i0 + r * NWAVES >= rpw) break;
            float y[8] = {yl[r][0][0], yl[r][0][1], yl[r][0][2], yl[r][0][3], yl[r][1][0], yl[r][1][1], yl[r][1][2], yl[r][1][3]}, v[8], pv[8], g[8];
            unpack8(vw[r], v); unpack8(pw[r], pv); unpack8(gw4[r], g); const float bs = bsr[r];
            float sm = 0.f;
#pragma unroll
            for (int i = 0; i < 8; ++i) { sm += y[i]; v[i] = v[i] + (pv[i] - v[i]) * mv[i]; }
            sm += __shfl_xor(sm, 1); sm += __shfl_xor(sm, 2); sm += __shfl_xor(sm, 4);
            const float mean = sm * (1.0f / 64.0f); float vs = 0.f;
#pragma unroll
            for (int i = 0; i < 8; ++i) { y[i] -= mean; vs += y[i] * y[i]; }
            vs += __shfl_xor(vs, 1); vs += __shfl_xor(vs, 2); vs += __shfl_xor(vs, 4);
            const float rinv = __builtin_amdgcn_rsqf(vs * (1.0f / 64.0f) + 64e-5f);
            float ov[8];
#pragma unroll
            for (int i = 0; i < 8; ++i) ov[i] = (y[i] * rinv * lg[i] + lb[i] + bs * v[i]) * g[i];
            *(GAS v4u*)(X.out + (size_t)m * 1024 + 512 + c) = pack8(ov); } }
}

__device__ __forceinline__ void route_tokens(const Args& A, const Ctx& C) {
    unsigned char* rt = A.ws + WS_ROUTE;
    int* e01 = (int*)(rt + RT_E01); float* w0a = (float*)(rt + RT_W0); float* rsa = (float*)(rt + RT_RS); int* cnt = (int*)(rt + RT_CNT);
    LAS float* Rg = (LAS float*)C.lds;
    LAS int* lcnt = (LAS int*)(C.lds + 32768);
    const float* h = A.out; const float* rw = A.in[I_ROUTER]; const float* g2 = A.in[I_ON2G];
    WG_SYNC();
    for (int i = C.tid; i < 8192; i += NTHR) Rg[(i & 7) * 1024 + (i >> 3)] = rw[i] * g2[i >> 3];
    for (int blk = C.vb; blk < 256; blk += C.G) {
        if (C.tid < 8) lcnt[C.tid] = 0;
        WG_SYNC();
        f32x4 xn[4]; { const GAS f32x4* xr0 = (const GAS f32x4*)(h + (size_t)(blk * 128 + C.wid * 16) * D) + C.lane;
#pragma unroll
            for (int j = 0; j < 4; ++j) xn[j] = xr0[64 * j]; }
        int res_e = 0; float res_w = 0.f, res_r = 0.f;
        for (int k = 0; k < 16; ++k) { const int m = blk * 128 + C.wid * 16 + k;
            f32x4 xc[4];
#pragma unroll
            for (int j = 0; j < 4; ++j) xc[j] = xn[j];
            if (k + 1 < 16) { const GAS f32x4* xr1 = (const GAS f32x4*)(h + (size_t)(m + 1) * D) + C.lane;
#pragma unroll
                for (int j = 0; j < 4; ++j) xn[j] = xr1[64 * j]; }
            float ss = 0.f; float lg[8];
#pragma unroll
            for (int e = 0; e < 8; ++e) lg[e] = 0.f;
#pragma unroll
            for (int j = 0; j < 4; ++j) { const f32x4 v = xc[j]; ss += (v[0] * v[0] + v[1] * v[1]) + (v[2] * v[2] + v[3] * v[3]);
#pragma unroll
                for (int e = 0; e < 8; ++e) { const f32x4 r = *(const LAS f32x4*)(Rg + e * 1024 + 4 * C.lane + 256 * j); lg[e] += (v[0] * r[0] + v[1] * r[1]) + (v[2] * r[2] + v[3] * r[3]); } }
            ss = wave_sum(ss);
#pragma unroll
            for (int e = 0; e < 8; ++e) lg[e] = wave_sum(lg[e]);
            const float rs = 1.0f / sqrtf(ss * (1.0f / 1024.0f) + 1e-6f);
            int b0 = 0; float v0 = lg[0];
#pragma unroll
            for (int e = 1; e < 8; ++e) if (lg[e] > v0) { v0 = lg[e]; b0 = e; }
            int b1 = (b0 + 1) & 7; float v1 = -3.0e38f;
#pragma unroll
            for (int e = 0; e < 8; ++e) if (e != b0 && lg[e] > v1) { v1 = lg[e]; b1 = e; }
            if (C.lane == k) { res_e = b0 | (b1 << 8); res_w = 1.0f / (1.0f + expf((v1 - v0) * rs)); res_r = rs; }
            if (C.lane == 0) { atomicAdd((int*)&lcnt[b0], 1); atomicAdd((int*)&lcnt[b1], 1); } }
        if (C.lane < 16) { const int m = blk * 128 + C.wid * 16 + C.lane; e01[m] = res_e; w0a[m] = res_w; rsa[m] = res_r; }
        WG_SYNC();
        if (C.tid < 8) cnt[blk * 8 + C.tid] = lcnt[C.tid];
        WG_SYNC();
    }
}
__device__ __forceinline__ void route_gather(const Args& A, const Ctx& C) {
    unsigned char* rt = A.ws + WS_ROUTE;
    const int* e01 = (const int*)(rt + RT_E01); const float* rsa = (const float*)(rt + RT_RS); const int* cnt = (const int*)(rt + RT_CNT);
    int* pos0 = (int*)(rt + RT_POS0); int* pos1 = (int*)(rt + RT_POS1); float* rsg = (float*)(rt + RT_RSG); int* tile_e = (int*)(rt + RT_TILE_E); int* meta = (int*)(rt + RT_META);
    const bf16* hb = (const bf16*)(A.ws + WS_HBG); unsigned char* xg = A.ws + WS_XG8;
    LAS int* sh = (LAS int*)C.lds;
    WG_SYNC();
    for (int blk = C.vb; blk < 256; blk += C.G) {
        if (C.tid < 24) sh[C.tid] = 0;
        WG_SYNC();
        { int cv[4];
#pragma unroll
          for (int j = 0; j < 4; ++j) cv[j] = cnt[C.tid + NTHR * j];
          int tot = 0, before = 0;
#pragma unroll
          for (int j = 0; j < 4; ++j) { tot += cv[j]; if ((C.tid >> 3) + 64 * j < blk) before += cv[j]; }
          atomicAdd((int*)&sh[C.tid & 7], tot); atomicAdd((int*)&sh[16 + (C.tid & 7)], before); }
        WG_SYNC();
        if (C.tid == 0) { int s = 0; for (int e = 0; e < 8; ++e) { sh[8 + e] = s; s += (sh[e] + 255) & ~255; }
            if (blk == 0) { meta[0] = s / 256; int t = 0; for (int e = 0; e < 8; ++e) { const int nt = (sh[e] + 255) / 256; for (int i = 0; i < nt; ++i) tile_e[t++] = e; } for (; t < MOE_TILES + 8; ++t) tile_e[t] = 0; } }
        WG_SYNC();
        int my0 = 0, my1 = 0;
        if (C.tid < 128) { const int m = blk * 128 + C.tid; const int ee = e01[m]; const int b0 = ee & 255, b1 = ee >> 8;
            for (int e = 0; e < 8; ++e) { const bool has = (b0 == e) || (b1 == e); const unsigned long long bal = __ballot(has);
                const int below = __popcll(bal & ((1ull << C.lane) - 1ull)); const int wtot = __popcll(bal);
                if (C.lane == 0) sh[512 + C.wid * 8 + e] = wtot;
                if (b0 == e) my0 = below; if (b1 == e) my1 = below; } }
        WG_SYNC();
        if (C.tid < 128) { const int m = blk * 128 + C.tid; const int ee = e01[m]; const int b0 = ee & 255, b1 = ee >> 8;
            const int p0 = sh[8 + b0] + sh[16 + b0] + (C.wid == 1 ? sh[512 + b0] : 0) + my0, p1 = sh[8 + b1] + sh[16 + b1] + (C.wid == 1 ? sh[512 + b1] : 0) + my1;
            pos0[m] = p0; pos1[m] = p1; sh[32 + 2 * C.tid] = p0; sh[32 + 2 * C.tid + 1] = p1; const float rs = rsa[m]; rsg[p0] = rs; rsg[p1] = rs; }
        WG_SYNC();
        for (int k = 0; k < 32; k += 4) { v4u t0[4], t1[4];
#pragma unroll
            for (int q = 0; q < 4; ++q) { const int s = C.wid * 32 + k + q, m = blk * 128 + (s >> 1); const GAS v4u* src = (const GAS v4u*)(hb + (size_t)m * D) + C.lane; t0[q] = src[0]; t1[q] = src[64]; }
#pragma unroll
            for (int q = 0; q < 4; ++q) { const int p = sh[32 + C.wid * 32 + k + q]; GAS v2u* dst = (GAS v2u*)(xg + (size_t)p * D) + C.lane; const v4u a = t0[q], b = t1[q]; v2u oa, ob;
                oa.x = pg8::pk4f8(bflo(a.x), bfhi(a.x), bflo(a.y), bfhi(a.y)); oa.y = pg8::pk4f8(bflo(a.z), bfhi(a.z), bflo(a.w), bfhi(a.w));
                ob.x = pg8::pk4f8(bflo(b.x), bfhi(b.x), bflo(b.y), bfhi(b.y)); ob.y = pg8::pk4f8(bflo(b.z), bfhi(b.z), bflo(b.w), bfhi(b.w));
                dst[0] = oa; dst[64] = ob; } }
        WG_SYNC();
    }
}
__device__ __forceinline__ void final_combine(const Args& A, const Ctx& C) {
    unsigned char* rt = A.ws + WS_ROUTE;
    const float* w0a = (const float*)(rt + RT_W0); const int* pos0 = (const int*)(rt + RT_POS0); const int* pos1 = (const int*)(rt + RT_POS1);
    const bf16* y = (const bf16*)(A.ws + WS_XG); const float* fg = A.in[I_FNG]; float* out = A.out;
    const int gw = C.bid * NWAVES + C.wid, NGW = C.G * NWAVES;
    f32x4 gv[4];
#pragma unroll
    for (int j = 0; j < 4; ++j) gv[j] = *(const GAS f32x4*)(fg + 4 * C.lane + 256 * j);
    const int rpw = M / C.G, mb = C.vb * rpw;
    const int nk = (rpw - C.wid + NWAVES - 1) / NWAVES;
#define FC_LOAD(hv_, ya_, yb_, q_) do { _Pragma("unroll") for (int r = 0; r < 2; ++r) { int kk = 2 * (q_) + r; kk = kk < nkk ? kk : nkk - 1;     \
        const int p0 = __builtin_amdgcn_readlane(P0, kk), p1 = __builtin_amdgcn_readlane(P1, kk); const int m = mb + C.wid + NWAVES * (kb + kk); \
        const GAS f32x4* hr = (const GAS f32x4*)(out + (size_t)m * D) + C.lane; const GAS v2u* y0 = (const GAS v2u*)(y + (size_t)p0 * D) + C.lane; const GAS v2u* y1 = (const GAS v2u*)(y + (size_t)p1 * D) + C.lane; \
        _Pragma("unroll") for (int j = 0; j < 4; ++j) { hv_[r][j] = hr[64 * j]; ya_[r][j] = y0[64 * j]; yb_[r][j] = y1[64 * j]; } } } while (0)
#define FC_DO(hv_, ya_, yb_, q_) do { _Pragma("unroll") for (int r = 0; r < 2; ++r) { const int kk = 2 * (q_) + r; if (kk < nkk) { const int m = mb + C.wid + NWAVES * (kb + kk); \
        const float w0 = __builtin_bit_cast(float, __builtin_amdgcn_readlane(W0, kk)), w1 = 1.0f - w0; f32x4 v[4]; float ss = 0.f; \
        _Pragma("unroll") for (int j = 0; j < 4; ++j) { const f32x4 h4 = hv_[r][j]; const v2u a = ya_[r][j], b = yb_[r][j]; \
            f32x4 o; o[0] = h4[0] + w0 * bflo(a.x) + w1 * bflo(b.x); o[1] = h4[1] + w0 * bfhi(a.x) + w1 * bfhi(b.x); o[2] = h4[2] + w0 * bflo(a.y) + w1 * bflo(b.y); o[3] = h4[3] + w0 * bfhi(a.y) + w1 * bfhi(b.y); \
            v[j] = o; ss += (o[0] * o[0] + o[1] * o[1]) + (o[2] * o[2] + o[3] * o[3]); } \
        ss = wave_sum(ss); const float rs = 1.0f / sqrtf(ss * (1.0f / 1024.0f) + 1e-6f); \
        GAS f32x4* hw = (GAS f32x4*)(out + (size_t)m * D) + C.lane; \
        _Pragma("unroll") for (int j = 0; j < 4; ++j) hw[64 * j] = v[j] * rs * gv[j]; } } } while (0)
    for (int kb = 0; kb < nk; kb += 64) {
        const int nkk = (nk - kb) < 64 ? (nk - kb) : 64, nq = (nkk + 1) >> 1;
        const int kl = C.lane < nkk ? C.lane : nkk - 1, ml = mb + C.wid + NWAVES * (kb + kl);
        const int P0 = pos0[ml], P1 = pos1[ml], W0 = __builtin_bit_cast(int, w0a[ml]);
        f32x4 hvA[2][4], hvB[2][4]; v2u yaA[2][4], ybA[2][4], yaB[2][4], ybB[2][4];
        FC_LOAD(hvA, yaA, ybA, 0);
        for (int q = 0; q < nq; q += 2) {
            FC_LOAD(hvB, yaB, ybB, q + 1);
            FC_DO(hvA, yaA, ybA, q);
            FC_LOAD(hvA, yaA, ybA, q + 2);
            FC_DO(hvB, yaB, ybB, q + 1);
        }
    }
#undef FC_LOAD
#undef FC_DO
}

#ifndef MK_SPLIT
#define MK_SPLIT 0
#endif
constexpr int N_PHASES = 17;
#ifndef WGM_WIDE
#define WGM_WIDE 4
#endif
#ifndef WGM_NARROW
#define WGM_NARROW 4
#endif
#ifndef P2_ML
#define P2_ML 4
#endif
#ifndef MOEW_REP
#define MOEW_REP 1
#endif
#ifndef PROBE_REPEAT
#define PROBE_REPEAT 0u
#endif
#ifndef PROBE_SKIP
#define PROBE_SKIP 0u
#endif
#define NREP(k) ((((unsigned)(PROBE_SKIP)) >> (k)) & 1u ? 0 : ((((unsigned)(PROBE_REPEAT)) >> (k)) & 1u ? 2 : 1))
__device__ __forceinline__ int seg4(int s) { return s <= 0 ? 0 : s == 1 ? 25 : s == 2 ? 42 : s == 3 ? 55 : 64; }
__device__ __forceinline__ int seg4g(int s) { return s <= 0 ? 0 : s == 1 ? 25 : s == 2 ? 42 : s == 3 ? 55 : 64; }
__device__ __forceinline__ int seg8(int s) { return s <= 0 ? 0 : s == 1 ? 20 : s == 2 ? 34 : s == 3 ? 44 : s == 4 ? 51 : s == 5 ? 56 : s == 6 ? 60 : s == 7 ? 62 : 64; }

__global__ void __launch_bounds__(NTHR, 2) fwd_kernel(Args args) {
    extern __shared__ __attribute__((aligned(16))) unsigned char lds_raw[];
    Ctx C; C.lds = (LAS unsigned char*)lds_raw; C.tid = threadIdx.x; C.lane = C.tid & 63; C.wid = __builtin_amdgcn_readfirstlane(C.tid >> 6); C.G = gridDim.x; C.bid = blockIdx.x; C.vb = (C.G == 256) ? ((C.bid & 7) * 32 + (C.bid >> 3)) : C.bid;
    volatile LAS unsigned* MISC = (volatile LAS unsigned*)(C.lds + MISC_OFF);
    for (int u = C.tid; u < (LDS_BYTES - LDSCTL_OFF) / 4; u += NTHR) ((LAS unsigned*)(C.lds + LDSCTL_OFF))[u] = 0u;
    __syncthreads();
    unsigned char* ws = args.ws;
    XcdBarrier bar = xcd_barrier_post((unsigned*)(ws + WS_CTL) + CW_BAR, MISC + 8, (unsigned)C.wid);
    const int lo = args.ph_lo, hi = args.ph_hi;
#define IN(k) (lo <= (k) && (k) < hi)
#define PHASE_TID() do { int t_ = C.wid * 64 + (int)xb_lane_id(); C.tid = t_; C.lane = t_ & 63; } while (0)
#define SEAM(k) do { if (IN(k) && IN((k) + 1)) xcd_barrier(bar); } while (0)
    float* ssp = (float*)(ws + WS_SSP);
    bf16* HB0 = (bf16*)(ws + WS_HB0); bf16* HB1 = (bf16*)(ws + WS_HB1); bf16* RP = (bf16*)(ws + WS_RP);

    if (IN(0)) for (int rep_ = 0; rep_ < NREP(0); ++rep_) { if (rep_) WG_SYNC(); PHASE_TID(); p0_prologue(args, C); } SEAM(0);
#ifdef XBAR_EXTRA
    for (int q_ = 0; q_ < XBAR_EXTRA; ++q_) xcd_barrier(bar);
#endif
    if (IN(1)) for (int rep_ = 0; rep_ < NREP(1); ++rep_) { if (rep_) WG_SYNC(); PHASE_TID(); pg8::Gemm g{HB0, (const bf16*)(ws + WS_W_EIN), M, PW, D}; pg8::StaticOrder S; S.init(M, PW, C.G, C.bid, WGM_WIDE, 2);
        pg8::EpiProj E{RP, PW, RP, PW, 1 << 30, ssp};
        pg8::gemm_phase<pg8::EpiProj, pg8::StaticOrder, true, true>(C.lds, g, S, E, C.tid); } SEAM(1);
    if (IN(2)) for (int rep_ = 0; rep_ < NREP(2); ++rep_) { if (rep_) WG_SYNC(); PHASE_TID(); MixArgs X{}; X.P = RP; X.pitch = PW; X.out = HB1; X.convw = args.in[I_CONVW]; X.convb = args.in[I_CONVB]; X.gateb = args.in[I_GATEB]; X.gup = args.in[I_GLAUP]; X.gb = args.in[I_GLAB];
        for (int pass = 0; pass < 2; ++pass) { int late_j = -1;
            for (int u = C.vb; u < 256; u += C.G) { const int bb = u >> 5, r = u & 31;
                if (r < 4 * P2_ML) { const int hh = r / P2_ML, sg = r - P2_ML * hh; X.normg = args.in[I_MLNG]; X.snap = (float*)(ws + WS_RX); if (pass == 1 || sg < P2_ML - 1) mixer_unit<0>(X, C, bb, hh, sg, P2_ML, pass); else late_j = bb * 8 + hh; }
                else { const int v = r - 4 * P2_ML, hh = v / (8 - P2_ML), sg = v - (8 - P2_ML) * hh; X.normg = args.in[I_GLANG]; X.snap = (float*)(ws + WS_RX + 16 * MiB); if (pass == 1 || sg < 7 - P2_ML) mixer_unit<1>(X, C, bb, hh, sg, 8 - P2_ML, pass); else late_j = bb * 8 + 4 + hh; } }
            if (pass == 0 && C.G == 256 && late_j >= 0) { WG_SYNC(); layer_weights_late(args, C, late_j * NWAVES + C.wid, 64 * NWAVES); }
            if (pass == 0) xcd_barrier(bar); } } SEAM(2);
    if (IN(3)) for (int rep_ = 0; rep_ < NREP(3); ++rep_) { if (rep_) WG_SYNC(); PHASE_TID(); pg8::Gemm g{HB1, (const bf16*)(ws + WS_W_EOUT), M, D, D}; pg8::StaticOrder S; S.init(M, D, C.G, C.bid, WGM_NARROW, 1);
#if FFN8_UP
        pg8::EpiResidT<true> E{args.in[I_X], args.out, HB0, ssp, 1.0f};
        pg8::gemm_phase<pg8::EpiResidT<true>, pg8::StaticOrder, true, true>(C.lds, g, S, E, C.tid); } SEAM(3);
#else
        pg8::EpiResid E{args.in[I_X], args.out, HB0, ssp, 1.0f};
        pg8::gemm_phase<pg8::EpiResid, pg8::StaticOrder, true, true>(C.lds, g, S, E, C.tid); } SEAM(3);
#endif
#if FFN8_UP
    if (IN(4)) for (int rep_ = 0; rep_ < NREP(4); ++rep_) { if (rep_) WG_SYNC(); PHASE_TID(); int k8 = D / 2; asm volatile("" : "+s"(k8)); pg8::Gemm g{HB0, (const bf16*)(ws + WS_W_FGU), M, 2 * FF, k8}; pg8::StaticOrder S; S.init(M, 2 * FF, C.G, C.bid, WGM_WIDE, 2);
#if FFN8_UP == 2
        pg8::EpiSwiGLU8T<false, true> E{(unsigned char*)RP, FF, ssp, 1.0f / 256.0f};
        pg8::gemm_phase<pg8::EpiSwiGLU8T<false, true>, pg8::StaticOrder, true, true, true>(C.lds, g, S, E, C.tid); } SEAM(4);
    if (IN(5)) for (int rep_ = 0; rep_ < NREP(5); ++rep_) { if (rep_) WG_SYNC(); PHASE_TID(); int k8 = FF / 2; asm volatile("" : "+s"(k8)); pg8::Gemm g{RP, (const bf16*)(ws + WS_W_FDN), M, D, k8}; pg8::StaticOrder S; S.init(M, D, C.G, C.bid, WGM_NARROW, 1);
        pg8::EpiResid E{args.out, args.out, HB0, ssp, 1.0f / 4096.0f};
        pg8::gemm_phase<pg8::EpiResid, pg8::StaticOrder, true, true, true>(C.lds, g, S, E, C.tid); } SEAM(5);
#else
        pg8::EpiSwiGLU8T<false, false> E{(unsigned char*)RP, FF, ssp, 1.0f / 256.0f};
        pg8::gemm_phase<pg8::EpiSwiGLU8T<false, false>, pg8::StaticOrder, true, true, true>(C.lds, g, S, E, C.tid); } SEAM(4);
    if (IN(5)) for (int rep_ = 0; rep_ < NREP(5); ++rep_) { if (rep_) WG_SYNC(); PHASE_TID(); pg8::Gemm g{RP, (const bf16*)(ws + WS_W_FDN), M, D, FF}; pg8::StaticOrder S; S.init(M, D, C.G, C.bid, WGM_NARROW, 1);
        pg8::EpiResid E{args.out, args.out, HB0, ssp, 1.0f};
        pg8::gemm_phase<pg8::EpiResid, pg8::StaticOrder, true, true>(C.lds, g, S, E, C.tid); } SEAM(5);
#endif
#else
    if (IN(4)) for (int rep_ = 0; rep_ < NREP(4); ++rep_) { if (rep_) WG_SYNC(); PHASE_TID(); pg8::Gemm g{HB0, (const bf16*)(ws + WS_W_FGU), M, 2 * FF, D}; pg8::StaticOrder S; S.init(M, 2 * FF, C.G, C.bid, WGM_WIDE, 2);
        pg8::EpiSwiGLU8T<false> E{(unsigned char*)RP, FF, ssp, 1.0f};
        pg8::gemm_phase<pg8::EpiSwiGLU8T<false>, pg8::StaticOrder, true, true>(C.lds, g, S, E, C.tid); } SEAM(4);
    if (IN(5)) for (int rep_ = 0; rep_ < NREP(5); ++rep_) { if (rep_) WG_SYNC(); PHASE_TID(); int k8 = FF / 2; asm volatile("" : "+s"(k8)); pg8::Gemm g{RP, (const bf16*)(ws + WS_W_FDN), M, D, k8}; pg8::StaticOrder S; S.init(M, D, C.G, C.bid, WGM_NARROW, 1);
        pg8::EpiResid E{args.out, args.out, HB0, ssp, 1.0f / 4096.0f};
        pg8::gemm_phase<pg8::EpiResid, pg8::StaticOrder, true, true, true>(C.lds, g, S, E, C.tid); } SEAM(5);
#endif
    if (IN(6)) for (int rep_ = 0; rep_ < NREP(6); ++rep_) { if (rep_) WG_SYNC(); PHASE_TID(); pg8::Gemm g{HB0, (const bf16*)(ws + WS_W_OIN), M, PW, D}; pg8::StaticOrder S; S.init(M, PW, C.G, C.bid, WGM_WIDE, 2);
        pg8::EpiProj E{(bf16*)(ws + WS_PRET), 2048, (bf16*)(ws + WS_PRW), 1792, 8, ssp};
        pg8::gemm_phase<pg8::EpiProj, pg8::StaticOrder, true, true>(C.lds, g, S, E, C.tid); } SEAM(6);
    if (IN(7)) for (int rep_ = 0; rep_ < NREP(7); ++rep_) { if (rep_) WG_SYNC(); PHASE_TID(); MixArgs X{}; X.P = (const bf16*)(ws + WS_PRET); X.pitch = 2048; X.out = HB1; X.normg = args.in[I_RETNG]; X.rcs = (const unsigned*)(ws + WS_ROT);
        X.snap = (float*)(ws + WS_RX + 32 * MiB);
        for (int pass = 0; pass < 2; ++pass) {
            for (int u = C.vb; u < 256; u += C.G) { const int bb = u >> 5, hh = (u >> 3) & 3, sg = u & 7; if (pass == 1 || sg < 7) mixer_unit<2>(X, C, bb, hh, sg, 8, pass); }
            if (pass == 0) xcd_barrier(bar); } } SEAM(7);
    RwArgs RW{}; RW.PRW = (const bf16*)(ws + WS_PRW); RW.mu = args.in[I_RWMU]; RW.w0 = args.in[I_RWW0]; RW.a0 = args.in[I_RWA0]; RW.kk_w = args.in[I_RWKK]; RW.ka_w = args.in[I_RWKA]; RW.rk_w = args.in[I_RWRK];
    RW.lng = args.in[I_RWLNG]; RW.lnb = args.in[I_RWLNB]; RW.WupT = (const bf16*)(ws + WS_LORA); RW.AupT = (const bf16*)(ws + WS_LORA + 65536); RW.GupT = (const bf16*)(ws + WS_LORA + 131072);
    RW.G = (bf16*)(ws + WS_RWG2); RW.bonus = (float*)(ws + WS_RWBON); RW.ws = ws; RW.yraw = (float*)(ws + WS_YRAW); RW.out = HB1;
    if (IN(8)) for (int rep_ = 0; rep_ < NREP(8); ++rep_) { if (rep_) WG_SYNC(); PHASE_TID(); for (int u = 2 * C.vb; u < M / 64; u += 2 * C.G) { rwkv_prep_unit(RW, C, u, true); rwkv_prep_unit(RW, C, u + 1, false); } } SEAM(8);
    if (IN(9)) for (int rep_ = 0; rep_ < NREP(9); ++rep_) { if (rep_) WG_SYNC(); PHASE_TID(); rwkv_scan(RW, C);
        if (C.G == 256 && (C.vb & 31) >= 8) { const int j_ = (C.vb >> 5) * 24 + (C.vb & 31) - 8; WG_SYNC(); moe_weights(args, C, 0x1fu, 0u, j_ * NWAVES + C.wid, 192 * NWAVES); } } SEAM(9);
    if (IN(10)) for (int rep_ = 0; rep_ < NREP(10); ++rep_) { if (rep_) WG_SYNC(); PHASE_TID(); rwkv_finish(RW, C); } SEAM(10);
    if (IN(11)) for (int rep_ = 0; rep_ < NREP(11); ++rep_) { if (rep_) WG_SYNC(); PHASE_TID(); pg8::Gemm g{HB1, (const bf16*)(ws + WS_W_OOUT), M, D, D}; pg8::StaticOrder S; S.init(M, D, C.G, C.bid, WGM_NARROW, 1);
        pg8::EpiResid E{args.out, args.out, (bf16*)(ws + WS_HBG), ssp, 1.0f};
        pg8::gemm_phase<pg8::EpiResid, pg8::StaticOrder, true, true>(C.lds, g, S, E, C.tid); } SEAM(11);
    if (IN(12)) for (int rep_ = 0; rep_ < NREP(12); ++rep_) { if (rep_) WG_SYNC(); PHASE_TID(); route_tokens(args, C); WG_SYNC(); moe_weights(args, C, C.G == 256 ? 0x20u : 0x3fu, 0x0fu, C.bid * NWAVES + C.wid, C.G * NWAVES); } SEAM(12);
    if (IN(13)) for (int rep_ = 0; rep_ < NREP(13); ++rep_) { if (rep_) WG_SYNC(); PHASE_TID(); route_gather(args, C); WG_SYNC(); moe_weights(args, C, 0xc0u, 0xf0u, C.bid * NWAVES + C.wid, C.G * NWAVES); } SEAM(13);
    {
        const int* meta = (const int*)(ws + WS_ROUTE + RT_META); const int* tile_e = (const int*)(ws + WS_ROUTE + RT_TILE_E); const float* rsg = (const float*)(ws + WS_ROUTE + RT_RSG);
        LAS int* te_lds = (LAS int*)(C.lds + LDSCTL_OFF + 4096);
        bf16* Y = (bf16*)(ws + WS_XG); unsigned char* XG8 = ws + WS_XG8; unsigned char* HM = ws + WS_HMID;
        if (IN(14)) for (int rep_ = 0; rep_ < NREP(14); ++rep_) { if (rep_) WG_SYNC(); PHASE_TID(); for (int i_ = C.tid; i_ < MOE_TILES + 8; i_ += NTHR) te_lds[i_] = tile_e[i_]; WG_SYNC(); const int nt = meta[0];
            int k8 = D / 2; asm volatile("" : "+s"(k8));
            pg8::Gemm g{(const bf16*)XG8, (const bf16*)(ws + WS_W_MGU), 0, 0, k8}; pg8::MoeOrder S{0, nt, 2 * FF / 256, 2 * FF / 256, C.G, C.bid, te_lds, false, true, WGM_WIDE, 2};
            pg8::EpiSwiGLU8 E{HM, FF, rsg, 1.0f / 256.0f};
            pg8::gemm_phase<pg8::EpiSwiGLU8, pg8::MoeOrder, true, true, true>(C.lds, g, S, E, C.tid); } SEAM(14);
        if (IN(15)) for (int rep_ = 0; rep_ < NREP(15); ++rep_) { if (rep_) WG_SYNC(); PHASE_TID(); for (int i_ = C.tid; i_ < MOE_TILES + 8; i_ += NTHR) te_lds[i_] = tile_e[i_]; WG_SYNC(); const int nt = meta[0];
            int k8 = FF / 2; asm volatile("" : "+s"(k8));
            pg8::Gemm g{(const bf16*)HM, (const bf16*)(ws + WS_W_MDN), 0, 0, k8}; pg8::MoeOrder S{0, nt, D / 256, D / 256, C.G, C.bid, te_lds, true, false, WGM_NARROW, 4};
            pg8::EpiStore E{Y, D, 1.0f / 4096.0f};
            pg8::gemm_phase<pg8::EpiStore, pg8::MoeOrder, true, true, true>(C.lds, g, S, E, C.tid); } SEAM(15);
    }
    if (IN(16)) for (int rep_ = 0; rep_ < NREP(16); ++rep_) { if (rep_) WG_SYNC(); PHASE_TID(); final_combine(args, C); }
#undef IN
#undef SEAM
}

extern "C" void kernel_launch(void* const* d_in, const int* in_sizes, int n_in, void* d_out, int out_size, void* d_ws, size_t ws_size, hipStream_t stream) {
    static int grid = 0;
    if (grid == 0) {
        if (n_in != N_IN || in_sizes[0] != M * D || out_size != M * D || ws_size < WS_END) { fprintf(stderr, "kernel_launch: unexpected shapes (n_in %d, ws %zu < %zu?)\n", n_in, ws_size, (size_t)WS_END); grid = -1; return; }
        int dev = 0, cus = 0;
        if (hipGetDevice(&dev) != hipSuccess || hipDeviceGetAttribute(&cus, hipDeviceAttributeMultiprocessorCount, dev) != hipSuccess) { grid = -1; return; }
        if (hipFuncSetAttribute((const void*)fwd_kernel, hipFuncAttributeMaxDynamicSharedMemorySize, LDS_BYTES) != hipSuccess) { fprintf(stderr, "kernel_launch: hipFuncSetAttribute failed\n"); grid = -1; return; }
        int per_cu = 0;
        if (hipOccupancyMaxActiveBlocksPerMultiprocessor(&per_cu, (const void*)fwd_kernel, NTHR, LDS_BYTES) != hipSuccess || per_cu < 1) { fprintf(stderr, "kernel_launch: occupancy query says %d\n", per_cu); }
        (void)hipGetLastError();
        grid = cus;
    }
    if (grid < 0) return;
    (void)hipMemsetAsync((char*)d_ws + WS_CTL, 0, CTL_ZERO_BYTES, stream);
    Args a{};
    for (int i = 0; i < N_IN; ++i) a.in[i] = (const float*)d_in[i];
    a.out = (float*)d_out; a.ws = (unsigned char*)d_ws;
#if MK_SPLIT
    for (int p = 0; p < N_PHASES; ++p) { a.ph_lo = p; a.ph_hi = p + 1; hipLaunchKernelGGL(fwd_kernel, dim3(grid), dim3(NTHR), LDS_BYTES, stream, a); }
#else
    a.ph_lo = 0; a.ph_hi = N_PHASES;
    hipLaunchKernelGGL(fwd_kernel, dim3(grid), dim3(NTHR), LDS_BYTES, stream, a);
#endif
}
```

```cpp
#include <hip/hip_runtime.h>
#include <cstdio>
#include <cstdint>
namespace pg8 {
#define PG8_LAS __attribute__((address_space(3)))
typedef unsigned short bf16_t;
typedef short bf16x8 __attribute__((ext_vector_type(8)));
typedef float f32x4 __attribute__((ext_vector_type(4)));
typedef unsigned u32x4 __attribute__((ext_vector_type(4)));
constexpr int BM = 256, BK = 64, HALF = 128, HTB = HALF * BK * 2  , STAGE_BYTES = 8 * HTB, NXCD = 8;

__host__ __device__ __forceinline__ int lds_byte(int r, int c) { const int st = (r >> 4) * 2 + (c >> 5), rr = r & 15, cc = c & 31, ob = rr * 64 + cc * 2; return st * 1024 + (ob ^ (((ob >> 9) & 1) << 5)); }
__host__ __device__ __forceinline__ void stage_rc(int b, int& R, int& C) { const int st = b / 1024, sb = b % 1024, swz = sb ^ (((sb >> 9) & 1) << 5); R = (st >> 1) * 16 + swz / 64; C = (st & 1) * 32 + (swz % 64) / 2; }
__host__ __device__ __forceinline__ int perm32(int rho) { const int n = rho >> 4, i = rho & 15; return 8 * (i >> 2) + 4 * n + (i & 3); }

struct Unit { int pm, pn, bn, po, hm, hn; };
__host__ __device__ __forceinline__ bool tail_split(int i, int G, int c, int nwg, int smax, int& L, int& hm, int& hn) {
    const int F = nwg / G, R = nwg - F * G; hm = 0; hn = 0;
    if (i < F) { L = i * G + c; return true; }
    if (i > F || R == 0) return false;
    const int sh = (smax >= 4 && 4 * R <= G) ? 2 : ((smax >= 2 && 2 * R <= G) ? 1 : 0);
    if (c >= (R << sh)) return false;
    const int pc = c & ((1 << sh) - 1); L = F * G + (c >> sh);
    if (sh >= 1) hm = 1 + (pc & 1); if (sh == 2) hn = 1 + (pc >> 1);
    return true;
}
struct Gemm { const bf16_t* A; const bf16_t* Bt; int M, N, K; };

struct StaticOrder {
    int nM, nN, nwg, G, c, WGM, smax;
    __host__ __device__ void init(int M, int N, int G_, int c_, int wgm, int smax_) { nM = M / BM; nN = N / BM; nwg = nM * nN; G = G_; c = c_; WGM = wgm; smax = smax_; }
    __host__ __device__ bool next(int i, Unit& u) const {
        int L; if (!tail_split(i, G, c, nwg, smax, L, u.hm, u.hn)) return false;
        int wgid = L; { const int q = nwg / NXCD, r = nwg % NXCD, xcd = wgid % NXCD, off = wgid / NXCD; wgid = (xcd < r ? xcd * (q + 1) : r * (q + 1) + (xcd - r) * q) + off; }
        const int nig = WGM * nN, gid = wgid / nig, fm = gid * WGM, gsz = (nM - fm) < WGM ? (nM - fm) : WGM;
        u.pm = fm + ((wgid % nig) % gsz); u.pn = (wgid % nig) / gsz; u.bn = u.pn; u.po = u.pm; return true;
    }
    __device__ __forceinline__ void a_ready(const Unit&) const {}
    __device__ __forceinline__ void done(const Unit&) const {}
};

__device__ __forceinline__ unsigned cvt_pk_bf16(float lo, float hi) { unsigned r; asm volatile("v_cvt_pk_bf16_f32 %0, %1, %2" : "=v"(r) : "v"(lo), "v"(hi)); return r; }
typedef float f32x2 __attribute__((ext_vector_type(2)));
typedef int i32x4 __attribute__((ext_vector_type(4)));
typedef int i32x8 __attribute__((ext_vector_type(8)));
__device__ __forceinline__ unsigned pk4f8(float a, float b, float c, float d) {
    a = __builtin_amdgcn_fmed3f(a, -448.f, 448.f); b = __builtin_amdgcn_fmed3f(b, -448.f, 448.f); c = __builtin_amdgcn_fmed3f(c, -448.f, 448.f); d = __builtin_amdgcn_fmed3f(d, -448.f, 448.f);
    int w = __builtin_amdgcn_cvt_pk_fp8_f32(a, b, 0, false); w = __builtin_amdgcn_cvt_pk_fp8_f32(c, d, w, true); return (unsigned)w; }
__device__ __forceinline__ i32x8 cat8(bf16x8 a, bf16x8 b) { const i32x4 x = __builtin_bit_cast(i32x4, a), y = __builtin_bit_cast(i32x4, b); return __builtin_shufflevector(x, y, 0, 1, 2, 3, 4, 5, 6, 7); }
constexpr float RMS_EPS = 1e-6f;
__device__ __forceinline__ float rs_from_ssp(const float* ssp, int row) {
    const f32x4* p = (const f32x4*)(ssp + (size_t)row * 16);
    const f32x4 a = p[0], b = p[1], c = p[2], d = p[3];
    const float s = ((a[0] + a[1]) + (a[2] + a[3])) + ((b[0] + b[1]) + (b[2] + b[3])) + ((c[0] + c[1]) + (c[2] + c[3])) + ((d[0] + d[1]) + (d[2] + d[3]));
    return __builtin_amdgcn_rsqf(s * (1.0f / 1024.0f) + RMS_EPS);
}
__device__ __forceinline__ void rs8_from_ssp(const float* ssp, int row0, int fq, float (&rs)[8]) {
    f32x4 p[8];
#pragma unroll
    for (int i = 0; i < 8; ++i) p[i] = *(const f32x4*)(ssp + (size_t)(row0 + (i >> 2) * HALF + (i & 3) * 16) * 16 + 4 * fq);
#pragma unroll
    for (int i = 0; i < 8; ++i) { float t = (p[i][0] + p[i][1]) + (p[i][2] + p[i][3]); t += __shfl_xor(t, 16); t += __shfl_xor(t, 32); rs[i] = __builtin_amdgcn_rsqf(t * (1.0f / 1024.0f) + RMS_EPS); }
}
struct RsAhead { f32x4 a, b; float s; };
template <bool DIRECT> __device__ __forceinline__ void rs_issue(const float* src, int rowbase, int tid, RsAhead& r) {
    if constexpr (DIRECT) { const float* p = src + rowbase + (tid & 255); asm volatile("global_load_dword %0, %1, off" : "=v"(r.s) : "v"(p) : "memory"); }
    else { const float* p = src + (size_t)(rowbase + (tid >> 1)) * 16 + 8 * (tid & 1);
        asm volatile("global_load_dwordx4 %0, %2, off\n\tglobal_load_dwordx4 %1, %2, off offset:16" : "=&v"(r.a), "=&v"(r.b) : "v"(p) : "memory"); }
}
template <bool DIRECT, int NST> __device__ __forceinline__ void rs_commit(PG8_LAS float* dst, int tid, RsAhead& r) {
    if constexpr (DIRECT) { asm volatile("s_waitcnt vmcnt(%1)" : "+v"(r.s) : "n"(NST) : "memory"); dst[tid & 255] = r.s; }
    else { asm volatile("s_waitcnt vmcnt(%2)" : "+v"(r.a), "+v"(r.b) : "n"(NST) : "memory");
        float t = ((r.a[0] + r.a[1]) + (r.a[2] + r.a[3])) + ((r.b[0] + r.b[1]) + (r.b[2] + r.b[3])); t += __shfl_xor(t, 1);
        dst[tid >> 1] = __builtin_amdgcn_rsqf(t * (1.0f / 1024.0f) + RMS_EPS); }
}
__device__ __forceinline__ float fast_sigmoid(float x) { return __builtin_amdgcn_rcpf(1.0f + __builtin_amdgcn_exp2f(-1.4426950408889634f * x)); }
__device__ __forceinline__ float fast_silu(float x) { return x * fast_sigmoid(x); }

__device__ __forceinline__ f32x2 swiglu2(f32x2 G, f32x2 U, float c1, float ik2) {
    f32x2 e = G * c1; e[0] = __builtin_amdgcn_exp2f(e[0]); e[1] = __builtin_amdgcn_exp2f(e[1]);
    f32x2 d = e * ik2 + ik2; d[0] = __builtin_amdgcn_rcpf(d[0]); d[1] = __builtin_amdgcn_rcpf(d[1]);
    return (G * U) * d;
}
struct EpiProj {
    static constexpr bool PERM = true, AFTER_DRAIN = false, RSLDS = true; static constexpr int NSTORES = 16;
    bf16_t* O0; int ld0; bf16_t* O1; int ld1; int split; const float* ssp;
    __device__ __forceinline__ void rs_first(const Unit& u, PG8_LAS float* dst, int tid) const { RsAhead r; rs_issue<false>(ssp, u.po * BM, tid, r); rs_commit<false, 0>(dst, tid, r); }
    __device__ __forceinline__ void operator()(const f32x4 (&acc)[2][2][4][2], const Unit& u, int wr, int wc, int fr, int fq, const PG8_LAS float* rs_cur, PG8_LAS float* rs_nxt, const Unit& nxt, bool has_next, int tid) const {
        int frl = fr, fql = fq, tidl = tid; asm volatile("" : "+v"(frl), "+v"(fql), "+v"(tidl));
        RsAhead rn; rs_issue<false>(ssp, (has_next ? nxt.po : u.po) * BM, tidl, rn);
        const int row0 = u.po * BM + (u.hm == 2 ? HALF : 0) + wr * 64 + frl;
        bf16_t* base; int ld, ct;
        if (u.pn < split) { base = O0; ld = ld0; ct = u.pn; } else { base = O1; ld = ld1; ct = u.pn - split; }
        const int col0 = ct * BM + (u.hn == 2 ? HALF : 0) + wc * 32 + 8 * fql;
        float rsv[8];
#pragma unroll
        for (int i = 0; i < 8; ++i) rsv[i] = rs_cur[(u.hm == 2 ? HALF : 0) + wr * 64 + frl + (i >> 2) * HALF + (i & 3) * 16 - ((u.hm == 2 && i >= 4) ? HALF : 0)];
#pragma unroll
        for (int ai = 0; ai < 2; ++ai)
#pragma unroll
            for (int m = 0; m < 4; ++m) { if (ai && u.hm) continue; const int row = row0 + ai * HALF + m * 16; const float rs = rsv[ai * 4 + m]; bf16_t* rowp = base + (size_t)row * ld + col0;
#pragma unroll
                for (int bj = 0; bj < 2; ++bj) { if (bj && u.hn) continue; const f32x4 v0 = acc[ai][bj][m][0] * rs, v1 = acc[ai][bj][m][1] * rs;
                    u32x4 w; w.x = cvt_pk_bf16(v0[0], v0[1]); w.y = cvt_pk_bf16(v0[2], v0[3]); w.z = cvt_pk_bf16(v1[0], v1[1]); w.w = cvt_pk_bf16(v1[2], v1[3]);
                    *(u32x4*)(rowp + bj * HALF) = w; } }
        rs_commit<false, NSTORES>(rs_nxt, tidl, rn);
    }
};
template <bool HB8> struct EpiResidT {
    static constexpr bool PERM = false, AFTER_DRAIN = false, RSLDS = false; static constexpr int NSTORES = -1;
    const float* res; float* Hout; bf16_t* hb; float* ssp; float sc;
    __device__ __forceinline__ void operator()(const f32x4 (&acc)[2][2][4][2], const Unit& u, int wr, int wc, int fr, int fq) const {
        typedef unsigned u32x2v __attribute__((ext_vector_type(2)));
        const int row0 = u.po * BM + wr * 64 + fr, col0 = u.pn * BM + wc * 32 + 4 * fq;
        f32x4 h[2][4][2][2];
#pragma unroll
        for (int q = 0; q < 4; ++q) { const int ai = q >> 1; f32x4 r[2][2][2];
#pragma unroll
            for (int mm = 0; mm < 2; ++mm)
#pragma unroll
                for (int bj = 0; bj < 2; ++bj)
#pragma unroll
                    for (int n = 0; n < 2; ++n) r[mm][bj][n] = *(const f32x4*)(res + (size_t)(row0 + ai * HALF + ((q & 1) * 2 + mm) * 16) * 1024 + col0 + bj * HALF + n * 16);
#pragma unroll
            for (int mm = 0; mm < 2; ++mm)
#pragma unroll
                for (int bj = 0; bj < 2; ++bj)
#pragma unroll
                    for (int n = 0; n < 2; ++n) { f32x4 t = r[mm][bj][n] + acc[ai][bj][(q & 1) * 2 + mm][n] * sc; asm volatile("" : "+v"(t)); h[ai][(q & 1) * 2 + mm][bj][n] = t; }
            __builtin_amdgcn_sched_barrier(0); }
#pragma unroll
        for (int ai = 0; ai < 2; ++ai)
#pragma unroll
            for (int m = 0; m < 4; ++m) { const int row = row0 + ai * HALF + m * 16; const size_t off = (size_t)row * 1024 + col0; float ss = 0.f;
#pragma unroll
                for (int bj = 0; bj < 2; ++bj)
#pragma unroll
                    for (int n = 0; n < 2; ++n) { const size_t o = off + bj * HALF + n * 16; const f32x4 hv = h[ai][m][bj][n];
                        *(f32x4*)(Hout + o) = hv;
                        if constexpr (HB8) *(unsigned*)((unsigned char*)hb + o) = pk4f8(hv[0], hv[1], hv[2], hv[3]);
                        else { u32x2v w; w.x = cvt_pk_bf16(hv[0], hv[1]); w.y = cvt_pk_bf16(hv[2], hv[3]); *(u32x2v*)(hb + o) = w; }
                        ss += (hv[0] * hv[0] + hv[1] * hv[1]) + (hv[2] * hv[2] + hv[3] * hv[3]); }
                ss += __shfl_xor(ss, 16); ss += __shfl_xor(ss, 32);
                if (fq == 0) ssp[(size_t)row * 16 + u.pn * 4 + wc] = ss; }
    }
};
typedef EpiResidT<false> EpiResid;
template <bool MOE> struct EpiSwiGLU {
    static constexpr bool PERM = true, AFTER_DRAIN = false, RSLDS = false; static constexpr int NSTORES = 8;
    bf16_t* O; int ld; const float* rsrc;
    __device__ __forceinline__ void operator()(const f32x4 (&acc)[2][2][4][2], const Unit& u, int wr, int wc, int fr, int fq) const {
        int frl = fr, fql = fq; asm volatile("" : "+v"(frl), "+v"(fql));
        const int rloc = wr * 64 + frl, col0 = u.pn * HALF + wc * 32 + 8 * fql;
        float rsv[8];
        if constexpr (MOE) {
#pragma unroll
            for (int i = 0; i < 8; ++i) rsv[i] = rsrc[u.pm * BM + rloc + (i >> 2) * HALF + (i & 3) * 16]; }
        else rs8_from_ssp(rsrc, u.pm * BM + rloc, fql, rsv);
#pragma unroll
        for (int ai = 0; ai < 2; ++ai)
#pragma unroll
            for (int m = 0; m < 4; ++m) { const int r = rloc + ai * HALF + m * 16;
                const float rs = rsv[ai * 4 + m], c1 = -1.4426950408889634f * rs, ik2 = __builtin_amdgcn_rcpf(rs * rs);
                f32x2 o[4];
#pragma unroll
                for (int n = 0; n < 2; ++n)
#pragma unroll
                    for (int hh = 0; hh < 2; ++hh) { const f32x4 g4 = acc[ai][0][m][n], u4 = acc[ai][1][m][n]; const f32x2 G = {g4[2 * hh], g4[2 * hh + 1]}, U = {u4[2 * hh], u4[2 * hh + 1]}; o[n * 2 + hh] = swiglu2(G, U, c1, ik2); }
                u32x4 w; w.x = cvt_pk_bf16(o[0][0], o[0][1]); w.y = cvt_pk_bf16(o[1][0], o[1][1]); w.z = cvt_pk_bf16(o[2][0], o[2][1]); w.w = cvt_pk_bf16(o[3][0], o[3][1]);
                *(u32x4*)(O + (size_t)(u.po * BM + r) * ld + col0) = w; }
    }
};
template <bool MOE, bool OUT8 = true> struct EpiSwiGLU8T {
    static constexpr bool PERM = true, AFTER_DRAIN = false, RSLDS = true; static constexpr int NSTORES = 8;
    unsigned char* O; int ld; const float* rsrc; float wsc;
    __device__ __forceinline__ void rs_first(const Unit& u, PG8_LAS float* dst, int tid) const { RsAhead r; rs_issue<MOE>(rsrc, u.pm * BM, tid, r); rs_commit<MOE, 0>(dst, tid, r); }
    __device__ __forceinline__ void operator()(const f32x4 (&acc)[2][2][4][2], const Unit& u, int wr, int wc, int fr, int fq, const PG8_LAS float* rs_cur, PG8_LAS float* rs_nxt, const Unit& nxt, bool has_next, int tid) const {
        typedef unsigned u32x2v __attribute__((ext_vector_type(2)));
        int tidl = tid; asm volatile("" : "+v"(tidl));
        RsAhead rn; rs_issue<MOE>(rsrc, (has_next ? nxt.pm : u.pm) * BM, tidl, rn);
        int frl = fr, fql = fq; asm volatile("" : "+v"(frl), "+v"(fql));
        const int rloc = (u.hm == 2 ? HALF : 0) + wr * 64 + frl, col0 = u.pn * HALF + wc * 32 + 8 * fql;
        float rsv[8];
#pragma unroll
        for (int i = 0; i < 8; ++i) rsv[i] = rs_cur[rloc + (i & 3) * 16 + ((i >= 4 && !u.hm) ? HALF : 0)];
#pragma unroll
        for (int ai = 0; ai < 2; ++ai)
#pragma unroll
            for (int m = 0; m < 4; ++m) { if (ai && u.hm) continue; const int r = rloc + ai * HALF + m * 16;
                const float rs = rsv[ai * 4 + m] * wsc, c1 = -1.4426950408889634f * rs, ik2 = __builtin_amdgcn_rcpf(rs * rs * (OUT8 ? 16.0f : 1.0f));
                f32x2 o[4];
#pragma unroll
                for (int n = 0; n < 2; ++n)
#pragma unroll
                    for (int hh = 0; hh < 2; ++hh) { const f32x4 g4 = acc[ai][0][m][n], u4 = acc[ai][1][m][n]; const f32x2 G = {g4[2 * hh], g4[2 * hh + 1]}, U = {u4[2 * hh], u4[2 * hh + 1]}; o[n * 2 + hh] = swiglu2(G, U, c1, ik2); }
                if constexpr (OUT8) { u32x2v w; w.x = pk4f8(o[0][0], o[0][1], o[1][0], o[1][1]); w.y = pk4f8(o[2][0], o[2][1], o[3][0], o[3][1]);
                    *(u32x2v*)(O + (size_t)(u.po * BM + r) * ld + col0) = w; }
                else { u32x4 w; w.x = cvt_pk_bf16(o[0][0], o[0][1]); w.y = cvt_pk_bf16(o[1][0], o[1][1]); w.z = cvt_pk_bf16(o[2][0], o[2][1]); w.w = cvt_pk_bf16(o[3][0], o[3][1]);
                    *(u32x4*)((bf16_t*)O + (size_t)(u.po * BM + r) * ld + col0) = w; } }
        rs_commit<MOE, NSTORES>(rs_nxt, tidl, rn);
    }
};
typedef EpiSwiGLU8T<true> EpiSwiGLU8;
struct EpiStore {
    static constexpr bool PERM = true, AFTER_DRAIN = false, RSLDS = false; static constexpr int NSTORES = 16;
    bf16_t* O; int ld; float sc;
    __device__ __forceinline__ void operator()(const f32x4 (&acc)[2][2][4][2], const Unit& u, int wr, int wc, int fr, int fq) const {
        int frl = fr, fql = fq; asm volatile("" : "+v"(frl), "+v"(fql));
        const int row0 = u.po * BM + (u.hm == 2 ? HALF : 0) + wr * 64 + frl, col0 = u.pn * BM + (u.hn == 2 ? HALF : 0) + wc * 32 + 8 * fql;
#pragma unroll
        for (int ai = 0; ai < 2; ++ai)
#pragma unroll
            for (int m = 0; m < 4; ++m) { if (ai && u.hm) continue; bf16_t* rowp = O + (size_t)(row0 + ai * HALF + m * 16) * ld + col0;
#pragma unroll
                for (int bj = 0; bj < 2; ++bj) { if (bj && u.hn) continue; const f32x4 v0 = acc[ai][bj][m][0] * sc, v1 = acc[ai][bj][m][1] * sc;
                    u32x4 w; w.x = cvt_pk_bf16(v0[0], v0[1]); w.y = cvt_pk_bf16(v0[2], v0[3]); w.z = cvt_pk_bf16(v1[0], v1[1]); w.w = cvt_pk_bf16(v1[2], v1[3]);
                    *(u32x4*)(rowp + bj * HALF) = w; } }
    }
};
struct MoeOrder {
    int t_lo, nT, nN, nBper, G, c; const PG8_LAS int* tile_expert; bool a_local, o_local; int WGM, smax;
    __device__ bool next(int i, Unit& u) const {
        const int nwg = nT * nN; int L; if (!tail_split(i, G, c, nwg, smax, L, u.hm, u.hn)) return false;
        { const int q = nwg / NXCD, r = nwg % NXCD, xcd = L % NXCD, off = L / NXCD; L = (xcd < r ? xcd * (q + 1) : r * (q + 1) + (xcd - r) * q) + off; }
        const int nig = WGM * nN, gid = L / nig, fm = gid * WGM, gsz = (nT - fm) < WGM ? (nT - fm) : WGM, rem = L % nig;
        const int pmi = fm + rem % gsz, pn = rem / gsz, t = t_lo + pmi, e = tile_expert[t];
        u.pn = pn; u.bn = e * nBper + pn; u.pm = a_local ? pmi : t; u.po = o_local ? pmi : t; return true;
    }
    __device__ __forceinline__ void a_ready(const Unit&) const {}
    __device__ __forceinline__ void done(const Unit&) const {}
};
template <class Epi, class Sched, bool ALIGN_EPI = false, bool SP2 = false, bool FP8 = false>
__device__ __forceinline__ void gemm_phase(PG8_LAS unsigned char* lds, const Gemm g, const Sched& S, const Epi& E, const int tid  ) {
    const int wid = __builtin_amdgcn_readfirstlane(tid >> 6), lane = tid & 63, wr = wid >> 2, wc = wid & 3, fr = lane & 15, fq = lane >> 4;
    const int K = g.K, nt = K / BK;
    unsigned voffA[2], voffB[2];
#pragma unroll
    for (int i = 0; i < 2; ++i) { int R, C; stage_rc(tid * 16 + i * 8192, R, C); const int Rb = Epi::PERM ? ((R & ~31) + perm32(R & 31)) : R;
        voffA[i] = (unsigned)(R * K + C) * 2u; voffB[i] = (unsigned)(Rb * K + C) * 2u; }
    const size_t kstep = (size_t)(BK * 2);
    const size_t hstep = (size_t)HALF * K * 2;
    const size_t tstep = 2 * hstep;
    const unsigned ldsw = (unsigned)wid * 1024u;
    const int aoff = lds_byte(wr * 64 + fr, fq * 8), boff = lds_byte(wc * 32 + fr, fq * 8);
#define PG8_SA(b, h) (((b) * 2 + (h)) * HTB)
#define PG8_SB(b, h) ((4 + (b) * 2 + (h)) * HTB)
#define PG8_STAGE(bufoff, gbase, voff) do { const char* gb_ = (const char*)(gbase); asm volatile("" : "+s"(gb_));   \
        _Pragma("unroll") for (int _i = 0; _i < 2; ++_i) { unsigned vo_ = (voff)[_i]; asm volatile("" : "+v"(vo_)); \
        __builtin_amdgcn_global_load_lds((const unsigned*)(gb_ + vo_), (PG8_LAS unsigned*)(lds + (bufoff) + ldsw + _i * 8192), 16, 0, 0); } } while (0)
#define PG8_LDA(dst, b, h) do { _Pragma("unroll") for (int m = 0; m < 4; ++m) _Pragma("unroll") for (int k = 0; k < 2; ++k) dst[m][k] = *(const PG8_LAS bf16x8*)(lds + PG8_SA(b, h) + aoff + m * 2048 + k * 1024); } while (0)
#define PG8_LDB(dst, b, h) do { _Pragma("unroll") for (int n = 0; n < 2; ++n) _Pragma("unroll") for (int k = 0; k < 2; ++k) dst[n][k] = *(const PG8_LAS bf16x8*)(lds + PG8_SB(b, h) + boff + n * 2048 + k * 1024); } while (0)
#define PG8_MMA(ai, bj, At, Bt) do { __builtin_amdgcn_s_setprio(1); _Pragma("unroll") for (int m = 0; m < 4; ++m) _Pragma("unroll") for (int n = 0; n < 2; ++n) { \
        if constexpr (FP8) acc[ai][bj][m][n] = __builtin_amdgcn_mfma_scale_f32_16x16x128_f8f6f4(cat8(Bt[n][0], Bt[n][1]), cat8(At[m][0], At[m][1]), acc[ai][bj][m][n], 0, 0, 0, 0, 0, 0); \
        else { _Pragma("unroll") for (int k = 0; k < 2; ++k) acc[ai][bj][m][n] = __builtin_amdgcn_mfma_f32_16x16x32_bf16(Bt[n][k], At[m][k], acc[ai][bj][m][n], 0, 0, 0); } } __builtin_amdgcn_s_setprio(0); } while (0)
#define PG8_WAIT_V(n) asm volatile("s_waitcnt vmcnt(" #n ")" ::: "memory")
#define PG8_WAIT_L(n) asm volatile("s_waitcnt lgkmcnt(" #n ")" ::: "memory")
#define PG8_WAIT_VP() do { if (peel) asm volatile("s_waitcnt vmcnt(%0)" :: "n"(8 + (Epi::NSTORES > 0 ? Epi::NSTORES : 0)) : "memory"); else PG8_WAIT_V(8); } while (0)
#define PG8_BAR __builtin_amdgcn_s_barrier()
#define PG8_SCHED __builtin_amdgcn_sched_barrier(0)
    constexpr bool PRE = SP2 && Epi::NSTORES > 0 && Epi::NSTORES <= 55;
    bool pre = false;
    Unit cur, nxt; int ui = 0;
    if (!S.next(0, cur)) return;
    PG8_LAS float* rsb = (PG8_LAS float*)(lds + STAGE_BYTES + 12288);
    if constexpr (Epi::RSLDS) E.rs_first(cur, rsb, tid);
    f32x4 acc[2][2][4][2];
#pragma unroll
    for (int a = 0; a < 2; ++a)
#pragma unroll
        for (int b = 0; b < 2; ++b)
#pragma unroll
            for (int m = 0; m < 4; ++m)
#pragma unroll
                for (int n = 0; n < 2; ++n) acc[a][b][m][n] = (f32x4){0.f, 0.f, 0.f, 0.f};
    bf16x8 At[4][2], B0[2][2], B1[2][2];
    const char* cA = (const char*)g.A + (size_t)cur.pm * tstep + (cur.hm == 2 ? hstep : 0); const char* cB = (const char*)g.Bt + (size_t)cur.bn * tstep + (cur.hn == 2 ? hstep : 0);
    S.a_ready(cur);
    if constexpr (SP2) {
        PG8_STAGE(PG8_SB(0, 0), cB, voffB); PG8_STAGE(PG8_SB(0, 1), cB + hstep, voffB); PG8_STAGE(PG8_SA(0, 0), cA, voffA); PG8_STAGE(PG8_SA(0, 1), cA + hstep, voffA);
        if (wr == 1) PG8_BAR;
        PG8_WAIT_V(2); PG8_BAR;
        PG8_STAGE(PG8_SB(1, 0), cB + kstep, voffB); PG8_STAGE(PG8_SA(1, 0), cA + kstep, voffA); PG8_STAGE(PG8_SB(1, 1), cB + hstep + kstep, voffB);
        PG8_WAIT_V(6); PG8_BAR;
    } else {
        PG8_STAGE(PG8_SB(0, 0), cB, voffB); PG8_STAGE(PG8_SA(0, 0), cA, voffA); PG8_STAGE(PG8_SB(0, 1), cB + hstep, voffB); PG8_STAGE(PG8_SA(0, 1), cA + hstep, voffA);
        if (wr == 1) PG8_BAR;
        PG8_WAIT_V(4); PG8_BAR;
        PG8_STAGE(PG8_SB(1, 0), cB + kstep, voffB); PG8_STAGE(PG8_SA(1, 0), cA + kstep, voffA); PG8_STAGE(PG8_SB(1, 1), cB + hstep + kstep, voffB);
        PG8_WAIT_V(6); PG8_BAR;
    }
    for (;;) {
        const bool has_next = S.next(ui + 1, nxt);
        const char* nA = has_next ? (const char*)g.A + (size_t)nxt.pm * tstep + (nxt.hm == 2 ? hstep : 0) : cA; const char* nB = has_next ? (const char*)g.Bt + (size_t)nxt.bn * tstep + (nxt.hn == 2 ? hstep : 0) : cB;
        for (int t = 0; t < nt; t += 2) {
            const bool last = (t == nt - 2);
            const char* a1 = cA + (size_t)(t + 1) * kstep;
            const char* a2 = last ? nA : cA + (size_t)(t + 2) * kstep; const char* b2 = last ? nB : cB + (size_t)(t + 2) * kstep;
            const char* a3 = a2 + kstep; const char* b3 = b2 + kstep;
            if (last && has_next) S.a_ready(nxt);
            if constexpr (SP2) {
            const bool peel = PRE && pre && t == 0;
            PG8_LDB(B0, 0, 0); PG8_LDB(B1, 0, 1); PG8_SCHED; PG8_LDA(At, 0, 0); if (!peel) PG8_STAGE(PG8_SA(1, 1), a1 + hstep, voffA);
            PG8_WAIT_VP(); PG8_WAIT_L(0); PG8_BAR; PG8_MMA(0, 0, At, B0); if (!cur.hn) PG8_MMA(0, 1, At, B1); PG8_BAR; PG8_SCHED;
            PG8_LDA(At, 0, 1); PG8_STAGE(PG8_SB(0, 0), b2, voffB); PG8_STAGE(PG8_SB(0, 1), b2 + hstep, voffB); PG8_STAGE(PG8_SA(0, 0), a2, voffA);
            PG8_WAIT_VP(); PG8_WAIT_L(0); PG8_BAR; if (!cur.hm) { PG8_MMA(1, 0, At, B0); if (!cur.hn) PG8_MMA(1, 1, At, B1); } PG8_BAR; PG8_SCHED;
            PG8_LDB(B0, 1, 0); PG8_LDB(B1, 1, 1); PG8_SCHED; PG8_LDA(At, 1, 0); PG8_STAGE(PG8_SA(0, 1), a2 + hstep, voffA);
            PG8_WAIT_VP(); PG8_WAIT_L(0); PG8_BAR; PG8_MMA(0, 0, At, B0); if (!cur.hn) PG8_MMA(0, 1, At, B1); PG8_BAR; PG8_SCHED;
            PG8_LDA(At, 1, 1); PG8_STAGE(PG8_SB(1, 0), b3, voffB); PG8_STAGE(PG8_SB(1, 1), b3 + hstep, voffB); PG8_STAGE(PG8_SA(1, 0), a3, voffA);
            PG8_WAIT_V(8); PG8_WAIT_L(0); PG8_BAR; if (!cur.hm) { PG8_MMA(1, 0, At, B0); if (!cur.hn) PG8_MMA(1, 1, At, B1); } PG8_BAR; PG8_SCHED;
            } else {
            PG8_LDB(B0, 0, 0); PG8_SCHED; PG8_LDA(At, 0, 0); PG8_STAGE(PG8_SA(1, 1), a1 + hstep, voffA);
            PG8_WAIT_L(8); PG8_BAR; PG8_WAIT_L(0); PG8_MMA(0, 0, At, B0); PG8_BAR; PG8_SCHED;
            PG8_LDB(B1, 0, 1); PG8_STAGE(PG8_SB(0, 0), b2, voffB);
            PG8_BAR; PG8_WAIT_L(0); PG8_MMA(0, 1, At, B1); PG8_BAR;
            PG8_LDA(At, 0, 1); PG8_STAGE(PG8_SA(0, 0), a2, voffA);
            PG8_BAR; PG8_WAIT_L(0); PG8_MMA(1, 0, At, B0); PG8_BAR; PG8_SCHED;
            PG8_STAGE(PG8_SB(0, 1), b2 + hstep, voffB);
            PG8_WAIT_V(6); PG8_BAR; PG8_MMA(1, 1, At, B1); PG8_BAR;
            PG8_LDB(B0, 1, 0); PG8_SCHED; PG8_LDA(At, 1, 0); PG8_STAGE(PG8_SA(0, 1), a2 + hstep, voffA);
            PG8_WAIT_L(8); PG8_BAR; PG8_WAIT_L(0); PG8_MMA(0, 0, At, B0); PG8_BAR; PG8_SCHED;
            PG8_LDB(B1, 1, 1); PG8_STAGE(PG8_SB(1, 0), b3, voffB);
            PG8_BAR; PG8_WAIT_L(0); PG8_MMA(0, 1, At, B1); PG8_BAR;
            PG8_LDA(At, 1, 1); PG8_STAGE(PG8_SA(1, 0), a3, voffA);
            PG8_BAR; PG8_WAIT_L(0); PG8_MMA(1, 0, At, B0); PG8_BAR; PG8_SCHED;
            PG8_STAGE(PG8_SB(1, 1), b3 + hstep, voffB);
            PG8_WAIT_V(6); PG8_BAR; PG8_MMA(1, 1, At, B1); PG8_BAR;
            }
        }
        if constexpr (PRE) { if (has_next) PG8_STAGE(PG8_SA(1, 1), nA + kstep + hstep, voffA); pre = has_next; }
        if constexpr (ALIGN_EPI) { if (wr == 0) PG8_BAR; }
        if constexpr (!Epi::AFTER_DRAIN) {
            if constexpr (Epi::RSLDS) E(acc, cur, wr, wc, fr, fq, rsb + (ui & 1) * 256, rsb + ((ui & 1) ^ 1) * 256, nxt, has_next, tid); else E(acc, cur, wr, wc, fr, fq);
            S.done(cur); }
        if (!has_next) break;
#pragma unroll
        for (int a = 0; a < 2; ++a)
#pragma unroll
            for (int b = 0; b < 2; ++b)
#pragma unroll
                for (int m = 0; m < 4; ++m)
#pragma unroll
                    for (int n = 0; n < 2; ++n) acc[a][b][m][n] = (f32x4){0.f, 0.f, 0.f, 0.f};
        cur = nxt; cA = nA; cB = nB; ++ui;
        if constexpr (ALIGN_EPI) { if (wr == 1) PG8_BAR; }
    }
    PG8_WAIT_V(0);
    if constexpr (!ALIGN_EPI) { if (wr == 0) PG8_BAR; }
    PG8_BAR;
    if constexpr (Epi::AFTER_DRAIN) { E.fused(acc, cur, wr, wc, fr, fq, lds, wid, lane); S.done(cur); }
#undef PG8_SA
#undef PG8_SB
#undef PG8_STAGE
#undef PG8_LDA
#undef PG8_LDB
#undef PG8_MMA
#undef PG8_WAIT_V
#undef PG8_WAIT_L
#undef PG8_WAIT_VP
#undef PG8_BAR
#undef PG8_SCHED
}
}

constexpr int NWAVES = 8, NTHR = 512;
#ifndef FFN8_UP
#define FFN8_UP 2
#endif
constexpr int M = 32768, D = 1024, T = 4096, NBATCH = 8, PW = 3840, FF = 3584;
constexpr size_t MiB = 1u << 20;
constexpr size_t WS_CTL = 0, CTL_ZERO_BYTES = 1 * MiB;
constexpr size_t WS_SSP = 1 * MiB;
constexpr size_t WS_ROUTE = 3 * MiB;
constexpr size_t WS_LORA = 4 * MiB;
constexpr size_t WS_ROT = 5 * MiB;
constexpr size_t WS_W_EIN = 8 * MiB, WS_W_EOUT = WS_W_EIN + (size_t)PW * D * 2, WS_W_FGU = WS_W_EOUT + 2 * MiB, WS_W_FDN = WS_W_FGU + 14 * MiB,
                 WS_W_OIN = WS_W_FDN + 7 * MiB, WS_W_OOUT = WS_W_OIN + (size_t)PW * D * 2;
static_assert(WS_W_OOUT + 2 * MiB == 48 * MiB, "weight map");
constexpr size_t WS_HB0 = 48 * MiB, WS_HB1 = 112 * MiB, WS_RP = 176 * MiB, WS_RX = 416 * MiB;
constexpr size_t WS_PRET = WS_RP, WS_PRW = WS_RP + 128 * MiB;
constexpr size_t WS_YRAW = WS_HB0;
constexpr size_t WS_W_MGU = 8 * MiB, WS_W_MDN = 64 * MiB;
constexpr int MOE_ROWS = 67584, MOE_TILES = 264;
constexpr size_t WS_HMID = 176 * MiB, WS_XG = 407 * MiB, WS_END = 539 * MiB;
constexpr size_t WS_XG8 = 100 * MiB;
constexpr size_t WS_HBG = WS_HMID;
static_assert(WS_W_MGU + (size_t)5 * 2 * FF * D <= WS_W_OOUT, "experts 0..4 are converted while W_out of layer 1 is still live");
static_assert(WS_W_MGU + (size_t)8 * 2 * FF * D <= WS_W_MDN && WS_W_MDN + (size_t)8 * FF * D <= WS_XG8 && WS_XG8 + (size_t)MOE_ROWS * D <= WS_HMID, "moe fp8 map");
static_assert(WS_HMID + (size_t)MOE_TILES * 256 * FF <= WS_XG && WS_XG + (size_t)MOE_ROWS * D * 2 <= WS_END, "moe map");
constexpr size_t RT_E01 = 0, RT_W0 = 128 * 1024, RT_RS = 256 * 1024, RT_POS0 = 384 * 1024, RT_POS1 = 512 * 1024, RT_RSG = 640 * 1024, RT_CNT = 920 * 1024, RT_TILE_E = 936 * 1024, RT_META = 944 * 1024;
constexpr int CW_BAR = 4096;
constexpr int RING_BYTES = 131072, LDSCTL_OFF = RING_BYTES, MISC_OFF = LDSCTL_OFF + 320, LDS_BYTES = 147456;

#define GAS __attribute__((address_space(1)))
#define LAS __attribute__((address_space(3)))
typedef unsigned short bf16;
typedef unsigned v4u __attribute__((ext_vector_type(4)));
typedef unsigned v2u __attribute__((ext_vector_type(2)));
typedef float f32x4 __attribute__((ext_vector_type(4)));
typedef short bf16x8 __attribute__((ext_vector_type(8)));
typedef GAS unsigned gu32;
#define LDS_WAIT() asm volatile("s_waitcnt lgkmcnt(0)" ::: "memory")
#define VM_WAIT() asm volatile("s_waitcnt vmcnt(0)" ::: "memory")
#define WG_SYNC() __syncthreads()
#define LDS_SYNC() do { asm volatile("s_waitcnt lgkmcnt(0)" ::: "memory"); __builtin_amdgcn_s_barrier(); asm volatile("" ::: "memory"); } while (0)
__device__ __forceinline__ float bflo(unsigned u) { return __uint_as_float(u << 16); }
__device__ __forceinline__ float bfhi(unsigned u) { return __uint_as_float(u & 0xffff0000u); }
__device__ __forceinline__ float bf2f(bf16 u) { return __uint_as_float((unsigned)u << 16); }
typedef float f32x2n __attribute__((ext_vector_type(2)));
typedef __bf16 bfx2n __attribute__((ext_vector_type(2)));
__device__ __forceinline__ unsigned pk2(float lo, float hi) { const f32x2n v = {lo, hi}; return __builtin_bit_cast(unsigned, __builtin_convertvector(v, bfx2n)); }
__device__ __forceinline__ void unpack8(const v4u w, float (&f)[8]) { f[0] = bflo(w.x); f[1] = bfhi(w.x); f[2] = bflo(w.y); f[3] = bfhi(w.y); f[4] = bflo(w.z); f[5] = bfhi(w.z); f[6] = bflo(w.w); f[7] = bfhi(w.w); }
__device__ __forceinline__ v4u pack8(const float (&f)[8]) { v4u w; w.x = pk2(f[0], f[1]); w.y = pk2(f[2], f[3]); w.z = pk2(f[4], f[5]); w.w = pk2(f[6], f[7]); return w; }
__device__ __forceinline__ float fsig(float x) { return __builtin_amdgcn_rcpf(1.0f + __builtin_amdgcn_exp2f(-1.4426950408889634f * x)); }
__device__ __forceinline__ float fexp(float x) { return __builtin_amdgcn_exp2f(1.4426950408889634f * x); }
__device__ __forceinline__ float log_sigmoid(float x) { return fminf(x, 0.f) - 0.6931471805599453f * __builtin_amdgcn_logf(1.0f + __builtin_amdgcn_exp2f(-1.4426950408889634f * fabsf(x))); }
#define DPPF(old, v, ctrl, rmask, bc) __builtin_bit_cast(float, __builtin_amdgcn_update_dpp(__builtin_bit_cast(int, (float)(old)), __builtin_bit_cast(int, (float)(v)), (ctrl), (rmask), 0xf, (bc)))
__device__ __forceinline__ float wave_scan_add(float v) {
    v += DPPF(0.f, v, 0x111, 0xf, true); v += DPPF(0.f, v, 0x112, 0xf, true); v += DPPF(0.f, v, 0x114, 0xf, true); v += DPPF(0.f, v, 0x118, 0xf, true);
    v += DPPF(0.f, v, 0x142, 0xa, false); v += DPPF(0.f, v, 0x143, 0xc, false); return v;
}
__device__ __forceinline__ float wave_scan_max(float v) {
    const float NI = -__builtin_inff();
    v = fmaxf(v, DPPF(NI, v, 0x111, 0xf, false)); v = fmaxf(v, DPPF(NI, v, 0x112, 0xf, false)); v = fmaxf(v, DPPF(NI, v, 0x114, 0xf, false)); v = fmaxf(v, DPPF(NI, v, 0x118, 0xf, false));
    v = fmaxf(v, DPPF(NI, v, 0x142, 0xa, false)); v = fmaxf(v, DPPF(NI, v, 0x143, 0xc, false)); return v;
}
__device__ __forceinline__ float lane63(float v) { return __builtin_bit_cast(float, __builtin_amdgcn_readlane(__builtin_bit_cast(int, v), 63)); }
__device__ __forceinline__ float wave_sum(float v) { return lane63(wave_scan_add(v)); }
#define XB_TMO      128
#define XB_XCNT(j)  (256  + 64 * (j))
#define XB_XSUB(j)  (1280 + 64 * (j))
#define XB_XGEN(j)  (2304 + 64 * (j))
#define XB_TOP      3328
#define XB_TOPGEN   3392
#define XCD_BAR_WORDS 3456
#define XB_SPIN_CAP (1u << 18)

__device__ __forceinline__ unsigned xb_ld(unsigned* p)              { return __hip_atomic_load(p, __ATOMIC_RELAXED, __HIP_MEMORY_SCOPE_AGENT); }
__device__ __forceinline__ unsigned xb_add(unsigned* p, unsigned v) { return __hip_atomic_fetch_add(p, v, __ATOMIC_RELAXED, __HIP_MEMORY_SCOPE_AGENT); }
__device__ __forceinline__ unsigned xb_xcc_id() { return (unsigned)__builtin_amdgcn_s_getreg((3 << 11) | 20) & 0xFu; }
#define XB_SPIN(cond, bar) do { unsigned _sp = 0; while (cond) { __builtin_amdgcn_s_sleep(1); \
    if ((++_sp & 255u) == 0u) { if (xb_ld(&(bar)[XB_TMO])) break; if (_sp > XB_SPIN_CAP) { atomicAdd(&(bar)[XB_TMO], 1u); break; } } } } while (0)

struct XcdBarrier {
    unsigned* bar; unsigned x, wid;
    volatile LAS unsigned* st;
};

__device__ __forceinline__ unsigned xb_lane_id() { unsigned l; asm volatile("v_mbcnt_lo_u32_b32 %0, -1, 0\n\tv_mbcnt_hi_u32_b32 %0, -1, %0" : "=v"(l)); return l; }
__device__ __forceinline__ bool xb_lane0() { return xb_lane_id() == 0u; }
__device__ __forceinline__ XcdBarrier xcd_barrier_post(unsigned* bar, volatile LAS unsigned* st, unsigned wid) {
    XcdBarrier b; b.bar = bar; b.x = xb_xcc_id(); b.st = st; b.wid = wid;
    if (wid == 0u && xb_lane0()) (void)xb_add(&bar[XB_XCNT(b.x)], 1u);
    return b;
}
__device__ __forceinline__ void xcd_barrier_complete(unsigned* bar, unsigned x, unsigned& nloc, unsigned& nx) {
    const unsigned G = gridDim.x * gridDim.y * gridDim.z;
    unsigned sum, cnt, mine, sp = 0u;
    for (;;) {
        sum = 0u; cnt = 0u; mine = 0u;
#pragma unroll
        for (unsigned j = 0; j < 16; ++j) { const unsigned c = xb_ld(&bar[XB_XCNT(j)]); sum += c; cnt += (c > 0u) ? 1u : 0u; mine = (j == x) ? c : mine; }
        if (sum == G) break;
        __builtin_amdgcn_s_sleep(1);
        if ((++sp & 255u) == 0u) { if (xb_ld(&bar[XB_TMO])) break; if (sp > XB_SPIN_CAP) { atomicAdd(&bar[XB_TMO], 1u); break; } }
    }
    nloc = mine > 0u ? mine : 1u; nx = cnt > 0u ? cnt : 1u;
}

__device__ __forceinline__ void xcd_barrier(const XcdBarrier& b) {
    asm volatile("s_waitcnt vmcnt(0)" ::: "memory");
    __syncthreads();
    if (b.wid == 0u && xb_lane0()) {
        unsigned* bar = b.bar;
        __builtin_amdgcn_s_waitcnt(0);
        unsigned nloc = b.st[0], nx = b.st[1];
        if (nloc == 0u) { xcd_barrier_complete(bar, b.x, nloc, nx); b.st[0] = nloc; b.st[1] = nx; }
        const unsigned old = xb_add(&bar[XB_XSUB(b.x)], 1u);
        const unsigned gen = old / nloc;
        if (old + 1u == (gen + 1u) * nloc) {
            __builtin_amdgcn_fence(__ATOMIC_RELEASE, "agent");
            asm volatile("s_waitcnt vmcnt(0)" ::: "memory");
            const unsigned og = xb_add(&bar[XB_TOP], 1u);
            const unsigned tg = og / nx;
            if (og + 1u == (tg + 1u) * nx) xb_add(&bar[XB_TOPGEN], 1u);
            else XB_SPIN(xb_ld(&bar[XB_TOPGEN]) == tg, bar);
            __builtin_amdgcn_fence(__ATOMIC_ACQUIRE, "agent");
            xb_add(&bar[XB_XGEN(b.x)], 1u);
            asm volatile("s_waitcnt vmcnt(0)" ::: "memory");
        } else {
            XB_SPIN(xb_ld(&bar[XB_XGEN(b.x)]) == gen, bar);
            __builtin_amdgcn_fence(__ATOMIC_ACQUIRE, "agent");
            asm volatile("s_waitcnt vmcnt(0)" ::: "memory");
        }
    }
    __syncthreads();
}

enum { I_X = 0, I_EN1G, I_EWIN, I_CONVW, I_CONVB, I_GATEB, I_MLNG, I_GLAUP, I_GLAB, I_GLANG, I_EWOUT, I_EN2G, I_FFG, I_FFU, I_FFD,
       I_ON1G, I_OWIN, I_RETNG, I_RWMU, I_RWWUP, I_RWW0, I_RWAUP, I_RWA0, I_RWGUP, I_RWKK, I_RWKA, I_RWRK, I_RWLNG, I_RWLNB, I_OWOUT, I_ON2G, I_ROUTER, I_MG, I_MU, I_MD, I_FNG, N_IN };
struct Args { const float* in[N_IN]; float* out; unsigned char* ws; int ph_lo, ph_hi; };
struct Ctx { int tid, lane, wid, G, bid, vb; LAS unsigned char* lds; };

__device__ __forceinline__ void tr_item(const float* W, int K, int N, int nblk, bf16* WT, int mode, const float* gain, LAS float* scr, int item, int lane) {
    const int kb = item / nblk, nb = item % nblk, k0 = 64 * kb, n0 = 32 * nb;
    const int nn = n0 + (lane & 31); const bool ok = nn < N;
    const int c = lane & 7;
    f32x4 ga = {1.f, 1.f, 1.f, 1.f}, gb = ga; if (gain) { ga = *(const GAS f32x4*)(gain + k0 + 8 * c); gb = *(const GAS f32x4*)(gain + k0 + 8 * c + 4); }
    float wv[32];
#pragma unroll
    for (int i = 0; i < 32; ++i) { const int kk = 2 * i + (lane >> 5); wv[i] = ok ? W[(size_t)(k0 + kk) * N + nn] : 0.f; }
#pragma unroll
    for (int i = 0; i < 32; ++i) { const int kk = 2 * i + (lane >> 5); scr[kk * 33 + (lane & 31)] = wv[i]; }
    LDS_WAIT(); asm volatile("" ::: "memory");
#pragma unroll
    for (int j = 0; j < 4; ++j) { const int n = (lane >> 3) + 8 * j; const LAS float* s = scr + (8 * c) * 33 + n;
        v4u o; o.x = pk2(s[0 * 33] * ga[0], s[1 * 33] * ga[1]); o.y = pk2(s[2 * 33] * ga[2], s[3 * 33] * ga[3]); o.z = pk2(s[4 * 33] * gb[0], s[5 * 33] * gb[1]); o.w = pk2(s[6 * 33] * gb[2], s[7 * 33] * gb[3]);
        const int ncol = n0 + n; const int drow = mode == 0 ? ncol : ((ncol >> 7) * 256 + (mode == 2 ? 128 : 0) + (ncol & 127));
        *(GAS v4u*)(WT + (size_t)drow * K + k0 + 8 * c) = o; }
    LDS_WAIT(); asm volatile("" ::: "memory");
}
__device__ __forceinline__ void tr_item8(const float* W, int K, int N, int nblk, unsigned char* WT, int mode, const float* gain, LAS float* scr, int item, int lane) {
    const int kb = item / nblk, nb = item % nblk, k0 = 64 * kb, n0 = 32 * nb;
    const int nn = n0 + (lane & 31); const bool ok = nn < N;
    const int c = lane & 3;
    f32x4 g4[4];
#pragma unroll
    for (int q = 0; q < 4; ++q) { g4[q] = (f32x4){256.f, 256.f, 256.f, 256.f}; if (gain) g4[q] = *(const GAS f32x4*)(gain + k0 + 16 * c + 4 * q) * 256.0f; }
    float wv[32];
#pragma unroll
    for (int i = 0; i < 32; ++i) { const int kk = 2 * i + (lane >> 5); wv[i] = ok ? W[(size_t)(k0 + kk) * N + nn] : 0.f; }
#pragma unroll
    for (int i = 0; i < 32; ++i) { const int kk = 2 * i + (lane >> 5); scr[kk * 33 + (lane & 31)] = wv[i]; }
    LDS_WAIT(); asm volatile("" ::: "memory");
#pragma unroll
    for (int j = 0; j < 2; ++j) { const int n = (lane >> 2) + 16 * j; const LAS float* s = scr + (16 * c) * 33 + n;
        v4u o; o.x = pg8::pk4f8(s[0 * 33] * g4[0][0], s[1 * 33] * g4[0][1], s[2 * 33] * g4[0][2], s[3 * 33] * g4[0][3]); o.y = pg8::pk4f8(s[4 * 33] * g4[1][0], s[5 * 33] * g4[1][1], s[6 * 33] * g4[1][2], s[7 * 33] * g4[1][3]);
        o.z = pg8::pk4f8(s[8 * 33] * g4[2][0], s[9 * 33] * g4[2][1], s[10 * 33] * g4[2][2], s[11 * 33] * g4[2][3]); o.w = pg8::pk4f8(s[12 * 33] * g4[3][0], s[13 * 33] * g4[3][1], s[14 * 33] * g4[3][2], s[15 * 33] * g4[3][3]);
        const int ncol = n0 + n; const int drow = mode == 0 ? ncol : ((ncol >> 7) * 256 + (mode == 2 ? 128 : 0) + (ncol & 127));
        *(GAS v4u*)(WT + (size_t)drow * K + k0 + 16 * c) = o; }
    LDS_WAIT(); asm volatile("" ::: "memory");
}
struct TrJob { const float* W; int K, N, nblk; bf16* WT; int mode; const float* gain; };
__device__ __forceinline__ void tr_run(const TrJob& j, LAS float* scr, int gw, int NGW, int lane) {
    const int nitems = (j.K / 64) * j.nblk;
    for (int it = gw; it < nitems; it += NGW) tr_item(j.W, j.K, j.N, j.nblk, j.WT, j.mode, j.gain, scr, it, lane);
}
struct TrJob8 { const float* W; int K, N, nblk; unsigned char* WT; int mode; const float* gain; };
__device__ __forceinline__ void tr_run8(const TrJob8& j, LAS float* scr, int gw, int NGW, int lane) {
    const int nitems = (j.K / 64) * j.nblk;
    for (int it = gw; it < nitems; it += NGW) tr_item8(j.W, j.K, j.N, j.nblk, j.WT, j.mode, j.gain, scr, it, lane);
}
__device__ __forceinline__ void layer_weights_late(const Args& A, const Ctx& C, int gw, int NGW) {
    LAS float* scr = (LAS float*)(C.lds + C.wid * 16384); unsigned char* ws = A.ws;
    { TrJob j{A.in[I_EWOUT], D, D, D / 32, (bf16*)(ws + WS_W_EOUT), 0, nullptr}; tr_run(j, scr, gw, NGW, C.lane); }
#if FFN8_UP
    { TrJob8 j{A.in[I_FFG], D, FF, FF / 32, ws + WS_W_FGU, 1, A.in[I_EN2G]}; tr_run8(j, scr, gw, NGW, C.lane); }
    { TrJob8 j{A.in[I_FFU], D, FF, FF / 32, ws + WS_W_FGU, 2, A.in[I_EN2G]}; tr_run8(j, scr, gw, NGW, C.lane); }
#if FFN8_UP == 2
    { TrJob8 j{A.in[I_FFD], FF, D, D / 32, ws + WS_W_FDN, 0, nullptr}; tr_run8(j, scr, gw, NGW, C.lane); }
#else
    { TrJob j{A.in[I_FFD], FF, D, D / 32, (bf16*)(ws + WS_W_FDN), 0, nullptr}; tr_run(j, scr, gw, NGW, C.lane); }
#endif
#else
    { TrJob j{A.in[I_FFG], D, FF, FF / 32, (bf16*)(ws + WS_W_FGU), 1, A.in[I_EN2G]}; tr_run(j, scr, gw, NGW, C.lane); }
    { TrJob j{A.in[I_FFU], D, FF, FF / 32, (bf16*)(ws + WS_W_FGU), 2, A.in[I_EN2G]}; tr_run(j, scr, gw, NGW, C.lane); }
    { TrJob8 j{A.in[I_FFD], FF, D, D / 32, ws + WS_W_FDN, 0, nullptr}; tr_run8(j, scr, gw, NGW, C.lane); }
#endif
    { TrJob j{A.in[I_OWIN], D, PW, PW / 32, (bf16*)(ws + WS_W_OIN), 0, A.in[I_ON1G]}; tr_run(j, scr, gw, NGW, C.lane); }
    { TrJob j{A.in[I_OWOUT], D, D, D / 32, (bf16*)(ws + WS_W_OOUT), 0, nullptr}; tr_run(j, scr, gw, NGW, C.lane); }
}
__device__ __forceinline__ void p0_prologue(const Args& A, const Ctx& C) {
    LAS float* scr = (LAS float*)(C.lds + C.wid * 16384);
    const int gw = C.bid * NWAVES + C.wid, NGW = C.G * NWAVES;
    unsigned char* ws = A.ws;
    { TrJob j{A.in[I_EWIN], D, 3608, PW / 32, (bf16*)(ws + WS_W_EIN), 0, A.in[I_EN1G]}; tr_run(j, scr, gw, NGW, C.lane); }
    if (C.G != 256) layer_weights_late(A, C, gw, NGW);
    { TrJob j{A.in[I_RWWUP], 64, 512, 16, (bf16*)(ws + WS_LORA), 0, nullptr}; tr_run(j, scr, gw, NGW, C.lane); }
    { TrJob j{A.in[I_RWAUP], 64, 512, 16, (bf16*)(ws + WS_LORA + 65536), 0, nullptr}; tr_run(j, scr, gw, NGW, C.lane); }
    { TrJob j{A.in[I_RWGUP], 128, 512, 16, (bf16*)(ws + WS_LORA + 131072), 0, nullptr}; tr_run(j, scr, gw, NGW, C.lane); }
    { unsigned* tcs = (unsigned*)(ws + WS_ROT);
      for (int e = C.bid * NTHR + C.tid; e < T * 64; e += C.G * NTHR) { const int t = e >> 6, i = e & 63;
          const float inv = exp2f(-(float)(2 * i) * (1.0f / 128.0f) * 13.287712379549449f);
          double rev = (double)((float)t * inv) * 0.15915494309189535; rev -= __builtin_rint(rev); const float fr = (float)rev;
          tcs[e] = pk2(__builtin_amdgcn_cosf(fr), __builtin_amdgcn_sinf(fr)); } }
    { const float* x = A.in[I_X]; bf16* xb = (bf16*)(ws + WS_HB0); float* ssp = (float*)(ws + WS_SSP);
      const int rpw = M / C.G, mb = C.vb * rpw;
      for (int i0 = C.wid; i0 < rpw; i0 += 2 * NWAVES) { const int m0 = mb + i0; f32x4 v[2][4];
#pragma unroll
          for (int r = 0; r < 2; ++r) { const int mr = (i0 + r * NWAVES < rpw) ? m0 + r * NWAVES : m0; const GAS f32x4* xr = (const GAS f32x4*)(x + (size_t)mr * D) + C.lane;
#pragma unroll
              for (int j = 0; j < 4; ++j) v[r][j] = xr[64 * j]; }
#pragma unroll
          for (int r = 0; r < 2; ++r) { const int m = m0 + r * NWAVES; if (i0 + r * NWAVES >= rpw) break; GAS v2u* o8 = (GAS v2u*)(xb + (size_t)m * D) + C.lane; float s = 0.f;
#pragma unroll
              for (int j = 0; j < 4; ++j) { const f32x4 t = v[r][j]; s += (t[0] * t[0] + t[1] * t[1]) + (t[2] * t[2] + t[3] * t[3]); v2u w; w.x = pk2(t[0], t[1]); w.y = pk2(t[2], t[3]); o8[64 * j] = w; }
              s = wave_sum(s);
              if (C.lane < 16) ssp[(size_t)m * 16 + C.lane] = C.lane == 0 ? s : 0.f; } } }
}
__device__ __forceinline__ void moe_weights(const Args& A, const Ctx& C, unsigned gu_mask, unsigned d_mask, int gw, int NGW) {
    LAS float* scr = (LAS float*)(C.lds + C.wid * 16384);
    for (int e = 0; e < 8; ++e) {
        if ((gu_mask >> e) & 1u) {
            { TrJob8 j{A.in[I_MG] + (size_t)e * D * FF, D, FF, FF / 32, A.ws + WS_W_MGU + (size_t)e * 2 * FF * D, 1, A.in[I_ON2G]}; tr_run8(j, scr, gw, NGW, C.lane); }
            { TrJob8 j{A.in[I_MU] + (size_t)e * D * FF, D, FF, FF / 32, A.ws + WS_W_MGU + (size_t)e * 2 * FF * D, 2, A.in[I_ON2G]}; tr_run8(j, scr, gw, NGW, C.lane); } }
        if ((d_mask >> e) & 1u) { TrJob8 j{A.in[I_MD] + (size_t)e * FF * D, FF, D, D / 32, A.ws + WS_W_MDN + (size_t)e * D * FF, 0, nullptr}; tr_run8(j, scr, gw, NGW, C.lane); } }
}

template <int KS, bool SWA = false, bool SWB = false> __device__ __forceinline__ f32x4 mma_rows(const LAS unsigned char* A, int lda, int m0, const LAS unsigned char* Bt, int ldb, int n0, f32x4 acc, int lane) {
    const int r = lane & 15, q = lane >> 4;
    const int sa = SWA ? (((m0 + r) >> 3) & 7) : 0, sb = SWB ? (((n0 + r) >> 3) & 7) : 0;
#pragma unroll
    for (int ks = 0; ks < KS; ++ks) {
        const bf16x8 a = *(const LAS bf16x8*)(A + (m0 + r) * lda + (((ks * 4 + q) ^ sa) * 16));
        const bf16x8 b = *(const LAS bf16x8*)(Bt + (n0 + r) * ldb + (((ks * 4 + q) ^ sb) * 16));
        acc = __builtin_amdgcn_mfma_f32_16x16x32_bf16(a, b, acc, 0, 0, 0);
    }
    return acc;
}
struct MixArgs {
    const bf16* P; int pitch;
    bf16* out;
    const float *convw, *convb, *gateb, *normg;
    const float *gup, *gb;
    float* snap;
    const unsigned* rcs;
};
__device__ __forceinline__ void scatter8x2(LAS unsigned char* base, int ld, int col0, int j0, const v4u a, const v4u b) {
    const unsigned aa[4] = {a.x, a.y, a.z, a.w}, bb[4] = {b.x, b.y, b.z, b.w};
    const int js = j0 ^ (((col0 >> 3) & 7) << 3);
#pragma unroll
    for (int i = 0; i < 8; ++i) { const unsigned lo = (aa[i >> 1] >> (16 * (i & 1))) & 0xffffu, hi = (bb[i >> 1] >> (16 * (i & 1))) & 0xffffu; *(LAS unsigned*)(base + (col0 + i) * ld + 2 * js) = lo | (hi << 16); }
}
template <int KIND>
__device__ __forceinline__ void mixer_unit(const MixArgs& X, const Ctx& C, int b, int h, int seg, int nseg, int pass) {
    constexpr int L = 64, DK = (KIND == 1) ? 64 : 128, DV = 128;
    constexpr int LDK = (DK + 8) * 2, LDL = (L + 8) * 2;
    constexpr int OFF_Q = 0, SZ_Q = L * LDK, OFF_K = OFF_Q + SZ_Q, OFF_KT = OFF_K + SZ_Q, SZ_KT = DK * LDL, OFF_PM = OFF_KT + SZ_KT, SZ_PM = L * LDL, OFF_VT = OFF_PM + SZ_PM, SZ_VT = DV * LDL,
                  OFF_ST = OFF_VT + SZ_VT, SZ_ST = DV * LDK, OFF_SC = OFF_ST + SZ_ST, SCB = (KIND == 1) ? 24576 : 8192, OFF_HS = 0;
    constexpr int HSLD = 132;
    static_assert(OFF_SC + SCB <= RING_BYTES && L * HSLD * 4 <= ((KIND == 1) ? OFF_VT : OFF_KT), "mixer LDS map");
    constexpr int SC_U = 0, SC_MM = 64, SC_RS = 128, SC_EM = 192, SC_CS = 256, SC_DEN = 320, SC_NV = 384, SC_CD = 512, SC_TAB = 576;
    constexpr int SC_LA = 0, LALD = 65, SC_GUP = SC_LA + 64 * LALD, SC_GB = SC_GUP + 1024, SC_GG = SC_GB + 64, SC_GS = SC_GG + 64;
    static_assert((SC_GS + 64) * 4 <= 24576 && (SC_TAB + 1280) * 4 <= 8192, "scalar region");
    LAS unsigned char* lds = C.lds;
    LAS unsigned char* Qs = lds + OFF_Q; LAS unsigned char* Ks = lds + OFF_K; LAS unsigned char* Kt = lds + OFF_KT; LAS unsigned char* Vt = lds + OFF_VT;
    LAS unsigned char* St = lds + OFF_ST; LAS unsigned char* Pm = lds + OFF_PM; LAS float* SC = (LAS float*)(lds + OFF_SC); LAS float* Hs = (LAS float*)(lds + OFF_HS);
    int tid = C.tid; asm volatile("" : "+v"(tid));
    const int lane = tid & 63, wid = C.wid, q4 = lane >> 4, r16 = lane & 15;
    const bf16* P = X.P; const int pitch = X.pitch;
    const float qscale = (KIND == 1) ? 0.125f : 0.08838834764831845f;
    const int c0 = (64 * seg) / nseg, c1 = (64 * (seg + 1)) / nseg;
    const bool full = pass == 1;
    constexpr int SNAP_F = (DK / 16) * 512 * 4 + 256;
    float* snap_base = X.snap + (size_t)((b * 4 + h) * nseg) * SNAP_F;
    LDS_SYNC();
    for (int i = tid; i < SZ_ST / 4; i += NTHR) ((LAS unsigned*)St)[i] = 0u;
    LAS float* NG = (LAS float*)(lds + LDSCTL_OFF + 8192);
    {
        const float ngv = X.normg[h * 128 + (tid & 127)]; float t0 = 0.f, t1 = 0.f, t2 = 0.f;
        if (KIND == 0) { const int k = (tid >> 7) & 3, c = tid & 127, tb = tid & 255; t0 = X.convw[k * 1024 + h * 128 + c]; t1 = X.convw[k * 1024 + 512 + h * 128 + c]; t2 = X.convb[(tb >> 7) * 512 + h * 128 + (tb & 127)]; }
        if (KIND == 1) { t0 = X.gup[(tid >> 6) * 256 + h * 64 + (tid & 63)]; t1 = X.gup[((tid + 512) >> 6) * 256 + h * 64 + (tid & 63)]; t2 = X.gb[h * 64 + (tid & 63)]; }
        if (tid < 128) NG[tid] = ngv;
        if (KIND == 0) { if (tid < 128) SC[SC_NV + tid] = 0.f; SC[SC_TAB + tid] = t0; SC[SC_TAB + 512 + tid] = t1; if (tid < 256) SC[SC_TAB + 1024 + tid] = t2; }
        if (KIND == 1) { SC[SC_GUP + tid] = t0; SC[SC_GUP + 512 + tid] = t1; if (tid < 64) SC[SC_GB + tid] = t2; } }
    float lg2 = 0.f;
    if (KIND == 2) lg2 = log2f(1.0f - exp2f(-5.0f - (float)h));
    float mprev = -1e30f, fsum = 0.f;
    constexpr int NST = DK / 16;
    f32x4 accs[NST];
#pragma unroll
    for (int i = 0; i < NST; ++i) accs[i] = (f32x4){0.f, 0.f, 0.f, 0.f};
    const int s_dkt = (DK == 64) ? (wid >> 1) : wid, s_et0 = (DK == 64) ? 4 * (wid & 1) : 0;
    constexpr int NOT = 4;
    const int o_rt = wid >> 1, o_et0 = 4 * (wid & 1);
    const int cc = tid & 15, r0 = tid >> 4, j0 = 2 * r0;
    const int ei = tid >> 3, esub = tid & 7;
    v4u pq[5], pk[5], pv[2], pe_cur[2];
    v4u pcs[2][2];
    v4u pgl[2]; unsigned pgi = 0u, pgf = 0u;
    float gb_i = 0.f, gb_f = 0.f; if (KIND == 0) { gb_i = X.gateb[h]; gb_f = X.gateb[4 + h]; }
#define MIX_LOAD(c_, full_) do { const int t0_ = (c_) * L; const size_t g0_ = (size_t)b * T + t0_; \
        if (KIND == 0) { \
            if (wid == 0) { pgi = P[(g0_ + lane + lz) * pitch + 2048 + h]; pgf = P[(g0_ + lane + lz) * pitch + 2052 + h]; } } \
        if (KIND == 2) { const int s_ = ccv >> 3, c8_ = ccv & 7; \
            _Pragma("unroll") for (int rr = 0; rr < 2; ++rr) { const int j = j0v + rr; \
                { const bf16* src = P + (g0_ + j) * pitch + s_ * 512 + h * 128 + 8 * c8_; pq[2 * rr] = *(const GAS v4u*)src; pq[2 * rr + 1] = *(const GAS v4u*)(src + 64);   \
                    const GAS v4u* pc_ = (const GAS v4u*)(X.rcs + (size_t)(t0_ + j) * 64 + 8 * c8_); pcs[rr][0] = pc_[0]; pcs[rr][1] = pc_[1]; } \
                pv[rr] = *(const GAS v4u*)(P + (g0_ + j) * pitch + 1024 + h * 128 + 8 * ccv); } } \
        if (KIND == 1) { const int s_ = tid >> 8, jp_ = 2 * ((tid >> 3) & 31) + lz, c8_ = (tid & 7) + lz; \
            { _Pragma("unroll") for (int rr = 0; rr < 2; ++rr) pq[rr] = *(const GAS v4u*)(P + (g0_ + jp_ + rr) * pitch + 2056 + 256 * s_ + h * 64 + 8 * c8_); } \
            _Pragma("unroll") for (int rr = 0; rr < 2; ++rr) pv[rr] = *(const GAS v4u*)(P + (g0_ + j0v + rr) * pitch + 2568 + h * 128 + 8 * ccv); \
            const GAS v4u* gp_ = (const GAS v4u*)(P + (g0_ + lane + lz) * pitch + 3592); pgl[0] = gp_[0]; pgl[1] = gp_[1]; } \
    } while (0)
#define MIX_LOAD_NOW(c_, full_) do { const int t0_ = (c_) * L; \
        if (KIND == 0) { \
            _Pragma("unroll") for (int k = 0; k < 5; ++k) { const int tt = t0_ + j0v - 3 + k; const bool okr = tt >= 0; const size_t ro = ((size_t)b * T + (okr ? tt : 0)) * pitch + h * 128 + 8 * ccv; \
                { pq[k] = *(const GAS v4u*)(P + ro); if (!okr) pq[k] = (v4u){0u, 0u, 0u, 0u}; } \
                pk[k] = *(const GAS v4u*)(P + ro + 512); if (!okr) pk[k] = (v4u){0u, 0u, 0u, 0u}; } \
            _Pragma("unroll") for (int rr = 0; rr < 2; ++rr) pv[rr] = *(const GAS v4u*)(P + ((size_t)b * T + t0_ + j0v + rr) * pitch + 1024 + h * 128 + 8 * ccv); } \
    } while (0)
#define MIX_LOAD_E(c_) do { const size_t g0_ = (size_t)b * T + (c_) * L; const int eo_ = (KIND == 1) ? 3080 : 1536; const GAS v4u* ep_ = (const GAS v4u*)(P + (g0_ + eiv) * pitch + eo_ + h * 128 + 16 * esubv); pe_cur[0] = ep_[0]; pe_cur[1] = ep_[1]; } while (0)
    { int lz = 0; asm volatile("" : "+v"(lz)); const int j0v = j0 + lz, ccv = cc + lz; MIX_LOAD(c0, full); }
    if (KIND == 1) { for (int i = tid; i < 64; i += NTHR) SC[SC_GS + i] = 0.f; }
    if (pass == 1) {
        f32x4 nsv[NST], nax = {0.f, 0.f, 0.f, 0.f}; float nm = 0.f, nF = 0.f, nnv = 0.f;
#define MIX_FOLD_LOAD(j_) do { const float* sp_ = snap_base + (size_t)(j_) * SNAP_F; const float* aux_ = sp_ + NST * 2048; \
            _Pragma("unroll") for (int x = 0; x < NST; ++x) nsv[x] = *(const GAS f32x4*)(sp_ + (x * 512 + tid) * 4); \
            if (KIND == 0) { nm = aux_[128]; nF = aux_[129]; nnv = aux_[tid & 127]; } \
            if (KIND == 1) nax = *(const GAS f32x4*)(aux_ + 16 * s_dkt + 4 * q4); } while (0)
        if (seg > 0) MIX_FOLD_LOAD(0);
        for (int j = 0; j < seg; ++j) {
            f32x4 csv[NST]; const f32x4 cax = nax; const float cm = nm, cF = nF, cnv = nnv;
#pragma unroll
            for (int x = 0; x < NST; ++x) csv[x] = nsv[x];
            { const int jn_ = (j + 1 < seg) ? j + 1 : j; MIX_FOLD_LOAD(jn_); }
            float fa = 1.f, fb = 1.f;
            if (KIND == 0) { const float mn = fmaxf(mprev + cF, cm); fa = fexp(mprev + cF - mn); fb = fexp(cm - mn); mprev = mn; }
            if (KIND == 2) fa = __builtin_amdgcn_exp2f(lg2 * (float)(64 * ((64 * (j + 1)) / nseg - (64 * j) / nseg)));
#pragma unroll
            for (int x = 0; x < NST; ++x) { f32x4 a = accs[x];
                if (KIND == 1) {
#pragma unroll
                    for (int r = 0; r < 4; ++r) a[r] *= fexp(cax[r]);
                } else a = a * fa;
                accs[x] = a + csv[x] * fb; }
            if (KIND == 0 && tid < 128) SC[SC_NV + tid] = fa * SC[SC_NV + tid] + fb * cnv; }
#undef MIX_FOLD_LOAD
#pragma unroll
        for (int x = 0; x < NST; ++x) { const int e = 16 * (s_et0 + x) + r16; v2u w; w.x = pk2(accs[x][0], accs[x][1]); w.y = pk2(accs[x][2], accs[x][3]);
            *(LAS v2u*)(St + e * LDK + 2 * (16 * s_dkt + 4 * q4)) = w; }
    }
    LDS_SYNC();

    for (int c = c0; c < c1; ++c) {
        const int t0 = c * L; const size_t grow0 = (size_t)b * T + t0;
        int lz = 0; asm volatile("" : "+v"(lz));
        const int j0v = j0 + lz, ccv = cc + lz, eiv = ei + lz, esubv = esub + lz, lv = lane + lz, q4v = lv >> 4, r16v = lv & 15;
        MIX_LOAD_NOW(c, full);
        MIX_LOAD_E(c);
        if (KIND == 0) {
            if (wid == 0) {
                const float ip = bf2f((bf16)pgi) + gb_i, fp = bf2f((bf16)pgf) + gb_f;
                const float bs = wave_scan_add(log_sigmoid(fp));
                const float u = ip - bs, am = wave_scan_max(u);
                const float Mi = fmaxf(mprev, am), g = lane63(bs), Ml = lane63(Mi);
                SC[SC_U + lane] = u; SC[SC_MM + lane] = Mi; SC[SC_RS + lane] = fexp(mprev - Mi); SC[SC_EM + lane] = fexp(-(bs + Mi)); SC[SC_CS + lane] = fexp(u - Ml);
                if (lane == 0) SC[SC_CD] = fexp(mprev - Ml);
                mprev = g + Ml; fsum += g; }
            LDS_SYNC();
        }
        if (KIND == 1) {
            float gl[16]; { float t8[8]; unpack8(pgl[0], t8);
#pragma unroll
                for (int i = 0; i < 8; ++i) gl[i] = t8[i]; unpack8(pgl[1], t8);
#pragma unroll
                for (int i = 0; i < 8; ++i) gl[8 + i] = t8[i]; }
#pragma unroll
            for (int k = 0; k < 8; ++k) { const int d = lz + wid * 8 + k; float z = SC[SC_GB + d];
#pragma unroll
                for (int r = 0; r < 16; ++r) z += gl[r] * SC[SC_GUP + r * 64 + d];
                const float v = wave_scan_add(log_sigmoid(z) * (1.0f / 16.0f));
                SC[SC_LA + lane * LALD + d] = v; if (lane == 63) { SC[SC_GG + d] = v; SC[SC_GS + d] += v; } }
            LDS_SYNC();
        }
        {
        if (KIND == 0) {
            v4u kt2[2];
#pragma unroll
            for (int rr = 0; rr < 2; ++rr) { const int j = j0 + rr;
#pragma unroll
                for (int s = 0; s < 2; ++s) {
                    if (s == 0 && !full) continue;
                    float acc[8];
#pragma unroll
                    for (int i = 0; i < 8; ++i) acc[i] = SC[lz + SC_TAB + 1024 + s * 128 + 8 * cc + i];
#pragma unroll
                    for (int k = 0; k < 4; ++k) { float xv[8]; unpack8(s == 0 ? pq[rr + k] : pk[rr + k], xv);
#pragma unroll
                        for (int i = 0; i < 8; ++i) acc[i] += xv[i] * SC[lz + SC_TAB + (s * 4 + k) * 128 + 8 * cc + i]; }
#pragma unroll
                    for (int i = 0; i < 8; ++i) acc[i] = acc[i] * fsig(acc[i]);
                    if (s == 0) {
#pragma unroll
                        for (int i = 0; i < 8; ++i) acc[i] *= qscale;
                        *(LAS v4u*)(Qs + j * LDK + 16 * cc) = pack8(acc);
                    } else {
                        *(LAS v4u*)(Ks + j * LDK + 16 * cc) = pack8(acc);
                        const float cs = SC[SC_CS + j];
#pragma unroll
                        for (int i = 0; i < 8; ++i) acc[i] *= cs;
                        kt2[rr] = pack8(acc);
                    }
                    __builtin_amdgcn_sched_barrier(0);
                } }
            scatter8x2(Kt, LDL, 8 * cc, j0, kt2[0], kt2[1]); scatter8x2(Vt, LDL, 8 * cc, j0, pv[0], pv[1]);
        }
        if (KIND == 2) {
            const int s = cc >> 3, c8 = cc & 7; v4u kt1[2], kt2[2];
#pragma unroll
            for (int rr = 0; rr < 2; ++rr) { const int j = j0 + rr;
                if (full || s == 1) {
                    float x1[8], x2[8]; unpack8(pq[2 * rr], x1); unpack8(pq[2 * rr + 1], x2);
                    const unsigned csw[8] = {pcs[rr][0].x, pcs[rr][0].y, pcs[rr][0].z, pcs[rr][0].w, pcs[rr][1].x, pcs[rr][1].y, pcs[rr][1].z, pcs[rr][1].w};
                    float o1[8], o2[8];
#pragma unroll
                    for (int i = 0; i < 8; ++i) { const float cv = bflo(csw[i]), sv = bfhi(csw[i]); o1[i] = x1[i] * cv - x2[i] * sv; o2[i] = x1[i] * sv + x2[i] * cv; }
                    if (s == 0) {
#pragma unroll
                        for (int i = 0; i < 8; ++i) { o1[i] *= qscale; o2[i] *= qscale; }
                        *(LAS v4u*)(Qs + j * LDK + 16 * c8) = pack8(o1); *(LAS v4u*)(Qs + j * LDK + 128 + 16 * c8) = pack8(o2);
                    } else {
                        *(LAS v4u*)(Ks + j * LDK + 16 * c8) = pack8(o1); *(LAS v4u*)(Ks + j * LDK + 128 + 16 * c8) = pack8(o2);
                        const float cs = __builtin_amdgcn_exp2f(lg2 * (float)(L - 1 - j));
#pragma unroll
                        for (int i = 0; i < 8; ++i) { o1[i] *= cs; o2[i] *= cs; }
                        kt1[rr] = pack8(o1); kt2[rr] = pack8(o2);
                    } }
                __builtin_amdgcn_sched_barrier(0); }
            if (s == 1) { scatter8x2(Kt, LDL, 8 * c8, j0, kt1[0], kt1[1]); scatter8x2(Kt, LDL, 64 + 8 * c8, j0, kt2[0], kt2[1]); }
            scatter8x2(Vt, LDL, 8 * cc, j0, pv[0], pv[1]);
        }
        if (KIND == 1) {
            { const int sk = tid >> 8, jp = 2 * ((tid >> 3) & 31), c8 = tid & 7; v4u kw[2];
              if (full || sk == 1) {
#pragma unroll
                  for (int rr = 0; rr < 2; ++rr) { const int j = jp + rr; float xv[8]; unpack8(pq[rr], xv);
#pragma unroll
                      for (int i = 0; i < 8; ++i) { const float bvv = SC[SC_LA + j * LALD + 8 * c8 + i]; xv[i] *= (sk == 0) ? qscale * fexp(bvv) : fexp(-bvv); }
                      kw[rr] = pack8(xv);
                      *(LAS v4u*)((sk == 0 ? Qs : Ks) + j * LDK + 16 * c8) = kw[rr]; }
                  if (sk == 1) scatter8x2(Kt, LDL, 8 * c8, jp, kw[0], kw[1]); } }
            scatter8x2(Vt, LDL, 8 * cc, j0, pv[0], pv[1]);
        }
        }
        { const int cn_ = (c + 1 < c1) ? c + 1 : c; MIX_LOAD(cn_, full); }
        LDS_SYNC();
        f32x4 acco[NOT];
        if (full) {
            const int jt = wid >> 1;
#pragma unroll
            for (int x = 0; x < 2; ++x) { const int it = 2 * (wid & 1) + x;
                f32x4 s = (f32x4){0.f, 0.f, 0.f, 0.f};
                if (jt <= it) s = mma_rows<DK / 32>(Ks, LDK, 16 * jt, Qs, LDK, 16 * it, s, lv);
                const int i = 16 * it + r16v, j0 = 16 * jt + 4 * q4v; float p[4];
#pragma unroll
                for (int r = 0; r < 4; ++r) { const int j = j0 + r; float dcy;
                    if (KIND == 0) dcy = fexp(SC[SC_U + j] - SC[SC_MM + i]); else if (KIND == 2) dcy = __builtin_amdgcn_exp2f(lg2 * (float)(i - j)); else dcy = 1.f;
                    p[r] = (j <= i) ? s[r] * dcy : 0.f; }
                v2u w; w.x = pk2(p[0], p[1]); w.y = pk2(p[2], p[3]); *(LAS v2u*)(Pm + i * LDL + 2 * j0) = w; }
#pragma unroll
            for (int x = 0; x < NOT; ++x) { acco[x] = mma_rows<DK / 32>(Qs, LDK, 16 * o_rt, St, LDK, 16 * (o_et0 + x), (f32x4){0.f, 0.f, 0.f, 0.f}, lv);
                if (KIND != 1) {
#pragma unroll
                    for (int r = 0; r < 4; ++r) { const int i = 16 * o_rt + 4 * q4v + r; const float rs = (KIND == 0) ? SC[SC_RS + i] : __builtin_amdgcn_exp2f(lg2 * (float)(i + 1)); acco[x][r] *= rs; } }
                if (x & 1) asm volatile("" ::: "memory"); }
        }
        LDS_SYNC();
        if (full) {
#pragma unroll
            for (int x = 0; x < NOT; ++x) { acco[x] = mma_rows<L / 32, false, true>(Pm, LDL, 16 * o_rt, Vt, LDL, 16 * (o_et0 + x), acco[x], lv); if (x & 1) asm volatile("" ::: "memory"); }
            if (KIND == 0) { const int i = tid >> 3, sub = tid & 7; float pvv[8]; unpack8(*(const LAS v4u*)(Pm + i * LDL + 16 * sub), pvv);
                float ps = ((pvv[0] + pvv[1]) + (pvv[2] + pvv[3])) + ((pvv[4] + pvv[5]) + (pvv[6] + pvv[7])); float qn = 0.f;
#pragma unroll
                for (int hh = 0; hh < 2; ++hh) { float qv[8]; unpack8(*(const LAS v4u*)(Qs + i * LDK + 32 * sub + 16 * hh), qv);
#pragma unroll
                    for (int e = 0; e < 8; ++e) qn += qv[e] * SC[SC_NV + 16 * sub + 8 * hh + e]; }
                float v = ps + SC[SC_RS + i] * qn; v += __shfl_xor(v, 1); v += __shfl_xor(v, 2); v += __shfl_xor(v, 4);
                if (sub == 0) SC[SC_DEN + i] = v; }
        }
        { float pre = 1.f; if (KIND == 0) pre = SC[SC_CD]; if (KIND == 2) pre = __builtin_amdgcn_exp2f(lg2 * (float)L);
#pragma unroll
          for (int x = 0; x < NST; ++x) { f32x4 a = accs[x] * pre; a = mma_rows<L / 32, true, true>(Kt, LDL, 16 * s_dkt, Vt, LDL, 16 * (s_et0 + x), a, lv);
              if (KIND == 1) {
#pragma unroll
                  for (int r = 0; r < 4; ++r) a[r] *= fexp(SC[SC_GG + 16 * s_dkt + 4 * q4v + r]); }
              accs[x] = a; if (x & 1) asm volatile("" ::: "memory"); } }
        LDS_SYNC();
        if (full) {
#pragma unroll
            for (int x = 0; x < NOT; ++x)
#pragma unroll
                for (int r = 0; r < 4; ++r) { const int i = 16 * o_rt + 4 * q4v + r, e = 16 * (o_et0 + x) + r16v; float v = acco[x][r];
                    if (KIND == 0) v = v * __builtin_amdgcn_rcpf(fmaxf(fabsf(SC[SC_DEN + i]), SC[SC_EM + i]));
                    Hs[i * HSLD + e] = v; }
        }
        if (KIND == 0 && tid < 128) { float s = 0.f;
#pragma unroll
            for (int k = 0; k < 8; ++k) { float kv[8]; unpack8(*(const LAS v4u*)(Kt + tid * LDL + 16 * k), kv); s += ((kv[0] + kv[1]) + (kv[2] + kv[3])) + ((kv[4] + kv[5]) + (kv[6] + kv[7])); }
            SC[SC_NV + tid] = SC[SC_CD] * SC[SC_NV + tid] + s; }
#pragma unroll
        for (int x = 0; x < NST; ++x) { const int e = 16 * (s_et0 + x) + r16v; v2u w; w.x = pk2(accs[x][0], accs[x][1]); w.y = pk2(accs[x][2], accs[x][3]);
            *(LAS v2u*)(St + e * LDK + 2 * (16 * s_dkt + 4 * q4v)) = w; }
        LDS_SYNC();
        if (full) {
            const size_t row = grow0 + ei; float o[16];
#pragma unroll
            for (int k = 0; k < 4; ++k) { const f32x4 a = *(const LAS f32x4*)(Hs + ei * HSLD + 16 * esub + 4 * k); o[4 * k] = a[0]; o[4 * k + 1] = a[1]; o[4 * k + 2] = a[2]; o[4 * k + 3] = a[3]; }
            float gt[16]; { float t8[8]; unpack8(pe_cur[0], t8);
#pragma unroll
                for (int e = 0; e < 8; ++e) gt[e] = t8[e]; unpack8(pe_cur[1], t8);
#pragma unroll
                for (int e = 0; e < 8; ++e) gt[8 + e] = t8[e]; }
            if (KIND == 0) {
#pragma unroll
                for (int e = 0; e < 16; ++e) o[e] *= fsig(gt[e]); }
            float sm = 0.f;
            if (KIND != 1) {
#pragma unroll
                for (int e = 0; e < 16; ++e) sm += o[e];
                sm += __shfl_xor(sm, 1); sm += __shfl_xor(sm, 2); sm += __shfl_xor(sm, 4); }
            const float mean = sm * (1.0f / 128.0f); float vs = 0.f;
#pragma unroll
            for (int e = 0; e < 16; ++e) { o[e] -= mean; vs += o[e] * o[e]; }
            vs += __shfl_xor(vs, 1); vs += __shfl_xor(vs, 2); vs += __shfl_xor(vs, 4);
            const float rinv = __builtin_amdgcn_rsqf(vs * (1.0f / 128.0f) + 1e-6f);
            const int ocol = ((KIND == 1) ? 512 : 0) + h * 128 + 16 * esub;
#pragma unroll
            for (int e = 0; e < 16; ++e) { float v = o[e] * rinv * NG[lz + 16 * esub + e]; if (KIND != 0) v *= gt[e] * fsig(gt[e]); o[e] = v; }
            float lo8[8], hi8[8];
#pragma unroll
            for (int e = 0; e < 8; ++e) { lo8[e] = o[e]; hi8[e] = o[8 + e]; }
            GAS v4u* dst = (GAS v4u*)(X.out + row * 1024 + ocol); dst[0] = pack8(lo8); dst[1] = pack8(hi8);
            LDS_SYNC();
        }
    }
    if (pass == 0) {
        float* sp = snap_base + (size_t)seg * SNAP_F; float* aux = sp + NST * 2048;
#pragma unroll
        for (int x = 0; x < NST; ++x) *(GAS f32x4*)(sp + (x * 512 + tid) * 4) = accs[x];
        if (KIND == 0) { if (tid < 128) aux[tid] = SC[SC_NV + tid]; if (tid == 0) { aux[128] = mprev; aux[129] = fsum; } }
        if (KIND == 1) { if (tid < 64) aux[tid] = SC[SC_GS + tid]; }
    }
#undef MIX_LOAD
#undef MIX_LOAD_NOW
#undef MIX_LOAD_E
}

typedef short s16x4 __attribute__((ext_vector_type(4)));
#define DPP_ADD(v, ctrl) ((v) + __builtin_bit_cast(float, __builtin_amdgcn_update_dpp(0, __builtin_bit_cast(int, (v)), (ctrl), 0xf, 0xf, true)))
__device__ __forceinline__ float row16_sum(float v) { v = DPP_ADD(v, 0xB1); v = DPP_ADD(v, 0x4E); v = DPP_ADD(v, 0x141); v = DPP_ADD(v, 0x140); return v; }
__device__ __forceinline__ float row16_scan(float v) { v = DPP_ADD(v, 0x111); v = DPP_ADD(v, 0x112); v = DPP_ADD(v, 0x114); v = DPP_ADD(v, 0x118); return v; }
__device__ __forceinline__ f32x4 mfma32(bf16x8 a, bf16x8 b, f32x4 c) { return __builtin_amdgcn_mfma_f32_16x16x32_bf16(a, b, c, 0, 0, 0); }
__device__ __forceinline__ f32x4 mfma16(s16x4 a, s16x4 b, f32x4 c) { bf16x8 a8, b8; a8[0] = a[0]; a8[1] = a[1]; a8[2] = a[2]; a8[3] = a[3]; a8[4] = 0; a8[5] = 0; a8[6] = 0; a8[7] = 0;
    b8[0] = b[0]; b8[1] = b[1]; b8[2] = b[2]; b8[3] = b[3]; b8[4] = 0; b8[5] = 0; b8[6] = 0; b8[7] = 0; return mfma32(a8, b8, c); }
__device__ __forceinline__ s16x4 pk4(float a, float b, float c, float d) { v2u w; w.x = pk2(a, b); w.y = pk2(c, d); return __builtin_bit_cast(s16x4, w); }
__device__ __forceinline__ s16x4 pk4v(f32x4 v) { return pk4(v[0], v[1], v[2], v[3]); }
__device__ __forceinline__ bf16x8 cat8(s16x4 lo, s16x4 hi) { bf16x8 r; r[0] = lo[0]; r[1] = lo[1]; r[2] = lo[2]; r[3] = lo[3]; r[4] = hi[0]; r[5] = hi[1]; r[6] = hi[2]; r[7] = hi[3]; return r; }
constexpr int RW_REC = 11520;
constexpr int RWO_FU = 0, RWO_FS = 2048, RWO_FY = 6144, RWO_W2 = 8192, RWO_W4 = 8704, RWO_VC = 9216, RWO_G = 11264;
constexpr size_t WS_CHD_A = WS_RP, WS_CHD_B = WS_RX, WS_RWG2 = WS_RX + 68 * MiB, WS_RWBON = WS_RX + 100 * MiB;
static_assert(5 * 2048 * (size_t)RW_REC <= 128 * MiB && 3 * 2048 * (size_t)RW_REC <= 68 * MiB && WS_RWBON + MiB <= WS_END, "rwkv map");
__device__ __forceinline__ unsigned char* rw_record(unsigned char* ws, int b, int h, int c) {
    return b < 5 ? ws + WS_CHD_A + (size_t)((b * 8 + h) * 256 + c) * RW_REC : ws + WS_CHD_B + (size_t)(((b - 5) * 8 + h) * 256 + c) * RW_REC;
}
struct RwArgs {
    const bf16* PRW;
    const float *mu, *w0, *a0, *kk_w, *ka_w, *rk_w, *lng, *lnb;
    const bf16 *WupT, *AupT, *GupT;
    bf16* G; float* bonus;
    unsigned char* ws;
    float* yraw;
    bf16* out;
};
__device__ __forceinline__ void shift4(const bf16* PRW, const float* mu, size_t row, int t, int c, float (&o)[4]) {
    const v2u cur = *(const GAS v2u*)(PRW + row * 1792 + c); v2u prv; prv.x = 0u; prv.y = 0u;
    if (t > 0) prv = *(const GAS v2u*)(PRW + (row - 1) * 1792 + c);
    const f32x4 m = *(const GAS f32x4*)(mu + c);
    const float cu[4] = {bflo(cur.x), bfhi(cur.x), bflo(cur.y), bfhi(cur.y)}, pr[4] = {bflo(prv.x), bfhi(prv.x), bflo(prv.y), bfhi(prv.y)};
#pragma unroll
    for (int i = 0; i < 4; ++i) o[i] = cu[i] + (pr[i] - cu[i]) * m[i];
}
constexpr int RW_RAWLD = 3072 + 16;
__device__ __forceinline__ void shift4_lds(const LAS unsigned char* RAW, const LAS float* PAR, int tok16, int t, int arr, int c, float (&o)[4]) {
    const LAS unsigned char* rp = RAW + (tok16 + 1) * RW_RAWLD + arr * 1024 + c * 2;
    const v2u cur = *(const LAS v2u*)rp; v2u prv = *(const LAS v2u*)(rp - RW_RAWLD); if (t == 0) { prv.x = 0u; prv.y = 0u; }
    const f32x4 m = *(const LAS f32x4*)(PAR + arr * 512 + c);
    const float cu[4] = {bflo(cur.x), bfhi(cur.x), bflo(cur.y), bfhi(cur.y)}, pr[4] = {bflo(prv.x), bfhi(prv.x), bflo(prv.y), bfhi(prv.y)};
#pragma unroll
    for (int i = 0; i < 4; ++i) o[i] = cu[i] + (pr[i] - cu[i]) * m[i];
}
__device__ __forceinline__ void rwkv_prep_unit(const RwArgs& X, const Ctx& C, int unit, bool fill_par) {
    constexpr int LD64 = (64 + 8) * 2, LD128 = (128 + 8) * 2;
    LAS unsigned char* TD = C.lds; LAS unsigned char* XA = TD + 64 * LD64; LAS unsigned char* SG = XA + 64 * LD64;
    LAS float* PAR = (LAS float*)(C.lds + 36864);
    LAS unsigned char* RAW = C.lds + 36864 + 16384;
    int tid = C.tid; asm volatile("" : "+v"(tid));
    const int lane = tid & 63, wid = C.wid, q4_ = lane >> 4, r16_ = lane & 15;
    const size_t row0 = (size_t)unit * 64; const int tb = (unit * 64) & (T - 1), bat = unit >> 6;
    WG_SYNC();
    if (fill_par) { float pv[8]; pv[0] = X.mu[tid]; pv[1] = X.mu[512 + tid]; pv[2] = X.mu[1024 + tid]; pv[3] = X.w0[tid]; pv[4] = X.a0[tid]; pv[5] = X.kk_w[tid]; pv[6] = X.ka_w[tid]; pv[7] = X.rk_w[tid];
#pragma unroll
        for (int k = 0; k < 8; ++k) PAR[512 * k + tid] = pv[k]; }
    v4u cuw[4], prw[4];
#pragma unroll
    for (int k = 0; k < 4; ++k) { const int task = tid + NTHR * k, tok = task >> 5, ch = task & 31; const int c = 1536 + 8 * ch; const size_t row = row0 + tok; const int t = tb + tok;
        cuw[k] = *(const GAS v4u*)(X.PRW + row * 1792 + c); prw[k] = *(const GAS v4u*)(X.PRW + (t > 0 ? row - 1 : row) * 1792 + c); }
#pragma unroll
    for (int k = 0; k < 4; ++k) { const int task = tid + NTHR * k, tok = task >> 5, ch = task & 31;
        const int c = 1536 + 8 * ch; const int t = tb + tok;
        float cu[8], pr[8]; unpack8(cuw[k], cu); unpack8(prw[k], pr);
        if (!(t > 0)) {
#pragma unroll
            for (int i = 0; i < 8; ++i) pr[i] = 0.f; }
        float o[8]; const f32x4 mu0 = *(const GAS f32x4*)(X.mu + c), mu1 = *(const GAS f32x4*)(X.mu + c + 4);
#pragma unroll
        for (int i = 0; i < 8; ++i) { const float xs = cu[i] + (pr[i] - cu[i]) * (i < 4 ? mu0[i & 3] : mu1[i & 3]);
            const float r = __builtin_amdgcn_rcpf(1.0f + __builtin_amdgcn_exp2f((ch < 8 ? 2.885390081777927f : -1.4426950408889634f) * xs));
            o[i] = ch < 8 ? 1.0f - 2.0f * r : (ch < 16 ? xs : r); }
        const v4u w = pack8(o);
        if (ch < 8) *(LAS v4u*)(TD + tok * LD64 + 16 * ch) = w; else if (ch < 16) *(LAS v4u*)(XA + tok * LD64 + 16 * (ch - 8)) = w; else *(LAS v4u*)(SG + tok * LD128 + 16 * (ch - 16)) = w; }
    WG_SYNC();
    const s16x4 Ic = pk4(4 * q4_ + 0 == r16_ ? 1.f : 0.f, 4 * q4_ + 1 == r16_ ? 1.f : 0.f, 4 * q4_ + 2 == r16_ ? 1.f : 0.f, 4 * q4_ + 3 == r16_ ? 1.f : 0.f);
    const f32x4 Z4 = (f32x4){0.f, 0.f, 0.f, 0.f};
    bf16x8 fw[2], fa[2], fg[4];
#define RW_LDF(ct_) do { const size_t rb_ = (size_t)(64 * wid + 16 * (ct_) + r16); \
        _Pragma("unroll") for (int ks = 0; ks < 2; ++ks) { fw[ks] = *(const GAS bf16x8*)(X.WupT + rb_ * 64 + ks * 32 + 8 * q4); fa[ks] = *(const GAS bf16x8*)(X.AupT + rb_ * 64 + ks * 32 + 8 * q4); } \
        _Pragma("unroll") for (int ks = 0; ks < 4; ++ks) fg[ks] = *(const GAS bf16x8*)(X.GupT + rb_ * 128 + ks * 32 + 8 * q4); } while (0)
    { const int r16 = r16_, q4 = q4_; RW_LDF(0); }
#pragma unroll 1
    for (int tt = 0; tt < 4; ++tt) {
        int r16 = r16_, q4 = q4_; asm volatile("" : "+v"(r16), "+v"(q4));
        const int tok = 16 * tt + r16; const size_t row = row0 + tok; const int t = tb + tok;
        unsigned char* rec = rw_record(X.ws, bat, wid, (tb >> 4) + tt);
        LDS_SYNC();
        for (int pc = wid; pc < 51; pc += NWAVES) { const int rr_ = pc / 3, pp_ = pc - 3 * rr_;
            __builtin_amdgcn_global_load_lds((const unsigned*)((const unsigned char*)X.PRW + ((long)row0 + 16 * tt - 1 + rr_) * 3584 + pp_ * 1024 + lane * 16), (LAS unsigned*)(RAW + rr_ * RW_RAWLD + pp_ * 1024), 16, 0, 0); }
        asm volatile("s_waitcnt vmcnt(0)" ::: "memory");
        LDS_SYNC();
        float ss = 0.f;
#pragma unroll
        for (int ct = 0; ct < 4; ++ct) { const int c0 = 64 * wid + 16 * ct + 4 * q4; float xk[4]; shift4_lds(RAW, PAR, r16, t, 1, c0, xk);
            const f32x4 kw = *(const LAS f32x4*)(PAR + 5 * 512 + c0);
#pragma unroll
            for (int i = 0; i < 4; ++i) { const float v = xk[i] * kw[i]; ss += v * v; } }
        ss += __shfl_xor(ss, 16); ss += __shfl_xor(ss, 32);
        const float invn = 1.0f / fmaxf(sqrtf(ss), 1e-12f);
        float bon = 0.f;
        s16x4 fA[4], fBi[4], fKi[4], fR[4];
        bf16x8 tbd[2], tba[2], tbg[4];
#pragma unroll
        for (int ks = 0; ks < 2; ++ks) { tbd[ks] = *(const LAS bf16x8*)(TD + tok * LD64 + (ks * 32 + 8 * q4) * 2); tba[ks] = *(const LAS bf16x8*)(XA + tok * LD64 + (ks * 32 + 8 * q4) * 2); }
#pragma unroll
        for (int ks = 0; ks < 4; ++ks) tbg[ks] = *(const LAS bf16x8*)(SG + tok * LD128 + (ks * 32 + 8 * q4) * 2);
#pragma unroll
        for (int ct = 0; ct < 4; ++ct) {
            const int cb = 64 * wid + 16 * ct, c0 = cb + 4 * q4;
            f32x4 cw = Z4, ca = Z4, cg = Z4;
#pragma unroll
            for (int ks = 0; ks < 2; ++ks) { cw = mfma32(fw[ks], tbd[ks], cw); ca = mfma32(fa[ks], tba[ks], ca); }
#pragma unroll
            for (int ks = 0; ks < 4; ++ks) cg = mfma32(fg[ks], tbg[ks], cg);
            asm volatile("" : "+v"(cw), "+v"(ca), "+v"(cg));
            RW_LDF((ct + 1) & 3);
            const f32x4 w0v = *(const LAS f32x4*)(PAR + 3 * 512 + c0), a0v = *(const LAS f32x4*)(PAR + 4 * 512 + c0), kaw = *(const LAS f32x4*)(PAR + 6 * 512 + c0), rkw = *(const LAS f32x4*)(PAR + 7 * 512 + c0), kw = *(const LAS f32x4*)(PAR + 5 * 512 + c0);
            float xr[4], xk[4], xv[4]; shift4_lds(RAW, PAR, r16, t, 0, c0, xr); shift4_lds(RAW, PAR, r16, t, 1, c0, xk); shift4_lds(RAW, PAR, r16, t, 2, c0, xv);
            { v2u w; w.x = pk2(cg[0], cg[1]); w.y = pk2(cg[2], cg[3]); *(GAS v2u*)(X.G + row * 512 + c0) = w; }
            { const f32x4 vc = mfma16(pk4(xv[0], xv[1], xv[2], xv[3]), Ic, Z4); *(GAS s16x4*)(rec + RWO_VC + 512 * ct + lane * 8) = pk4v(vc); }
            float pa[4], pbi[4], pki[4], pr[4], pbh[4], pkh[4]; f32x4 g15;
#pragma unroll
            for (int i = 0; i < 4; ++i) { const float z = w0v[i] + cw[i];
                const float e = 0.6065306597126334f * fsig(z);
                const float a = fsig(a0v[i] + ca[i]);
                const float kkv = xk[i] * kw[i] * invn, khv = xk[i] * (1.0f + (a - 1.0f) * kaw[i]), bbv = kkv * a;
                bon += xr[i] * khv * rkw[i];
                const float cs = row16_scan(e);
                const float gi = fexp(cs), gt = __builtin_amdgcn_rcpf(gi);
                const float gsh = __builtin_bit_cast(float, __builtin_amdgcn_update_dpp(0, __builtin_bit_cast(int, gt), 0x111, 0xf, 0xf, true));
                const float gp = r16 == 0 ? 1.0f : gsh;
                const float gl15 = __builtin_bit_cast(float, __builtin_amdgcn_update_dpp(0, __builtin_bit_cast(int, gt), 0x15F, 0xf, 0xf, true));
                const float gl = gi * gl15;
                pa[i] = -kkv * gp; pbi[i] = bbv * gi; pki[i] = khv * gi; pr[i] = xr[i] * gt; pbh[i] = bbv * gl; pkh[i] = khv * gl; g15[i] = gl15; }
            fA[ct] = pk4(pa[0], pa[1], pa[2], pa[3]); fBi[ct] = pk4(pbi[0], pbi[1], pbi[2], pbi[3]); fKi[ct] = pk4(pki[0], pki[1], pki[2], pki[3]);
            fR[ct] = pk4(pr[0], pr[1], pr[2], pr[3]);
            { const s16x4 bhc = pk4v(mfma16(pk4(pbh[0], pbh[1], pbh[2], pbh[3]), Ic, Z4)), khc = pk4v(mfma16(pk4(pkh[0], pkh[1], pkh[2], pkh[3]), Ic, Z4));
              *(GAS bf16x8*)(rec + RWO_FS + 1024 * ct + lane * 16) = cat8(bhc, khc); }
            if (r16 == 0) *(GAS f32x4*)(rec + RWO_G + (16 * ct + 4 * q4) * 4) = g15;
        }
        bon += __shfl_xor(bon, 16); bon += __shfl_xor(bon, 32);
        if (q4 == 0) X.bonus[row * 8 + wid] = bon;
        f32x4 nA = Z4, nC = Z4, mkaA = Z4, mkaC = Z4, mbrA = Z4, mkrA = Z4;
#pragma unroll
        for (int ks = 0; ks < 2; ++ks) { const bf16x8 a8 = cat8(fA[2 * ks], fA[2 * ks + 1]), bi8 = cat8(fBi[2 * ks], fBi[2 * ks + 1]), ki8 = cat8(fKi[2 * ks], fKi[2 * ks + 1]), r8 = cat8(fR[2 * ks], fR[2 * ks + 1]);
            nA = mfma32(bi8, a8, nA); nC = mfma32(a8, bi8, nC); mkaA = mfma32(ki8, a8, mkaA); mkaC = mfma32(a8, ki8, mkaC); mbrA = mfma32(bi8, r8, mbrA); mkrA = mfma32(ki8, r8, mkrA); }
#pragma unroll
        for (int j = 0; j < 4; ++j) { const int o = 4 * q4 + j;
            if (!(o < r16)) { nA[j] = 0.f; mkaA[j] = 0.f; } if (!(r16 < o)) { nC[j] = 0.f; mkaC[j] = 0.f; } if (!(o <= r16)) { mbrA[j] = 0.f; mkrA[j] = 0.f; } }
        s16x4 Ta;
        { const s16x4 Na = pk4v(nA), Nc = pk4v(nC);
          const f32x4 n2c = mfma16(Na, Nc, Z4), n2a = mfma16(Nc, Na, Z4); const s16x4 N2a = pk4v(n2a), N2c = pk4v(n2c);
          const f32x4 n4c = mfma16(N2a, N2c, Z4), n4a = mfma16(N2c, N2a, Z4); const s16x4 N4a = pk4v(n4a), N4c = pk4v(n4c);
          const f32x4 n8c = mfma16(N4a, N4c, Z4);
          f32x4 f0 = nA, f1 = n2c, f2 = n4c, f3 = n8c;
#pragma unroll
          for (int j = 0; j < 4; ++j) if (4 * q4 + j == r16) { f0[j] += 1.f; f1[j] += 1.f; f2[j] += 1.f; f3[j] += 1.f; }
          const f32x4 p1 = mfma16(pk4v(f1), pk4v(f0), Z4);
          const f32x4 p2 = mfma16(pk4v(f2), pk4v(p1), Z4);
          const f32x4 p3 = mfma16(pk4v(f3), pk4v(p2), Z4);
          Ta = pk4v(p3); }
        const s16x4 MbrA = pk4v(mbrA), MkaC = pk4v(mkaC);
        { const f32x4 w2a = mfma16(MkaC, Ta, Z4), w2c = mfma16(Ta, MkaC, Z4);
          const f32x4 w4a = mfma16(pk4v(w2c), MbrA, mkrA);
          *(GAS s16x4*)(rec + RWO_W2 + lane * 8) = pk4v(w2a); *(GAS s16x4*)(rec + RWO_W4 + lane * 8) = pk4v(w4a); }
        s16x4 w1a[4], w3a[4];
#pragma unroll
        for (int ct = 0; ct < 4; ++ct) { const s16x4 Ac = pk4v(mfma16(fA[ct], Ic, Z4));
            const f32x4 x1a = mfma16(Ac, Ta, Z4), x1c = mfma16(Ta, Ac, Z4);
            f32x4 r0; { const v2u w = __builtin_bit_cast(v2u, fR[ct]); r0[0] = bflo(w.x); r0[1] = bfhi(w.x); r0[2] = bflo(w.y); r0[3] = bfhi(w.y); }
            const f32x4 x3a = mfma16(pk4v(x1c), MbrA, r0);
            w1a[ct] = pk4v(x1a); w3a[ct] = pk4v(x3a); }
#pragma unroll
        for (int ks = 0; ks < 2; ++ks) { *(GAS bf16x8*)(rec + RWO_FU + 1024 * ks + lane * 16) = cat8(w1a[2 * ks], w1a[2 * ks + 1]); *(GAS bf16x8*)(rec + RWO_FY + 1024 * ks + lane * 16) = cat8(w3a[2 * ks], w3a[2 * ks + 1]); }
    }
#undef RW_LDF
}
__device__ __forceinline__ void rwkv_scan(const RwArgs& X, const Ctx& C) {
    constexpr int SLOT = 12288, RING = 8, AHEAD = 6;
    const int lane = C.lane, q4 = lane >> 4, r16 = lane & 15, wid = C.wid;
    for (int v = C.vb; v < 256; v += C.G) { if ((v & 31) >= 8) continue; const int b = v >> 5, h = v & 31;
        const unsigned char* rec0 = rw_record(X.ws, b, h, 0);
        __syncthreads();
        if (wid >= 4) {
            const int lw = wid - 4;
#define RW_DMA(c_) do { const unsigned char* r_ = rec0 + (size_t)(c_) * RW_REC; LAS unsigned char* s_ = C.lds + ((c_) & (RING - 1)) * SLOT; \
                _Pragma("unroll") for (int p_ = 0; p_ < 3; ++p_) __builtin_amdgcn_global_load_lds((const unsigned*)(r_ + (lw + 4 * p_) * 1024 + lane * 16), (LAS unsigned*)(s_ + (lw + 4 * p_) * 1024), 16, 0, 0); } while (0)
            for (int c = 0; c < AHEAD; ++c) RW_DMA(c);
            for (int c = 0; c < 256; ++c) {
                if (c + AHEAD < 256) { RW_DMA(c + AHEAD); asm volatile("s_waitcnt vmcnt(18)" ::: "memory"); }
                else asm volatile("s_waitcnt vmcnt(0)" ::: "memory");
                __builtin_amdgcn_s_barrier();
            }
#undef RW_DMA
        } else {
            const int rg = wid;
            f32x4 S[4];
#pragma unroll
            for (int i = 0; i < 4; ++i) S[i] = (f32x4){0.f, 0.f, 0.f, 0.f};
            for (int c = 0; c < 256; ++c) {
                asm volatile("s_waitcnt lgkmcnt(0)" ::: "memory");
                __builtin_amdgcn_s_barrier();
                asm volatile("" ::: "memory");
                const LAS unsigned char* r = C.lds + (c & (RING - 1)) * SLOT;
                const bf16x8 fu0 = *(const LAS bf16x8*)(r + RWO_FU + lane * 16), fu1 = *(const LAS bf16x8*)(r + RWO_FU + 1024 + lane * 16);
                const bf16x8 fy0 = *(const LAS bf16x8*)(r + RWO_FY + lane * 16), fy1 = *(const LAS bf16x8*)(r + RWO_FY + 1024 + lane * 16);
                const bf16x8 fs0 = *(const LAS bf16x8*)(r + RWO_FS + lane * 16), fs1 = *(const LAS bf16x8*)(r + RWO_FS + 1024 + lane * 16), fs2 = *(const LAS bf16x8*)(r + RWO_FS + 2048 + lane * 16), fs3 = *(const LAS bf16x8*)(r + RWO_FS + 3072 + lane * 16);
                const s16x4 w2 = *(const LAS s16x4*)(r + RWO_W2 + lane * 8), w4 = *(const LAS s16x4*)(r + RWO_W4 + lane * 8), vc = *(const LAS s16x4*)(r + RWO_VC + 512 * rg + lane * 8);
                const f32x4 g0 = *(const LAS f32x4*)(r + RWO_G + (4 * q4) * 4), g1 = *(const LAS f32x4*)(r + RWO_G + (16 + 4 * q4) * 4), g2 = *(const LAS f32x4*)(r + RWO_G + (32 + 4 * q4) * 4), g3 = *(const LAS f32x4*)(r + RWO_G + (48 + 4 * q4) * 4);
                const bf16x8 s0 = cat8(pk4v(S[0]), pk4v(S[1])), s1 = cat8(pk4v(S[2]), pk4v(S[3]));
                f32x4 U = mfma16(w2, vc, (f32x4){0.f, 0.f, 0.f, 0.f}); U = mfma32(fu0, s0, U); U = mfma32(fu1, s1, U);
                f32x4 Y = mfma16(w4, vc, (f32x4){0.f, 0.f, 0.f, 0.f}); Y = mfma32(fy0, s0, Y); Y = mfma32(fy1, s1, Y);
                const bf16x8 uv = cat8(pk4v(U), vc);
                S[0] = mfma32(fs0, uv, S[0] * g0); S[1] = mfma32(fs1, uv, S[1] * g1); S[2] = mfma32(fs2, uv, S[2] * g2); S[3] = mfma32(fs3, uv, S[3] * g3);
                float* yp = X.yraw + ((size_t)b * T + (size_t)c * 16 + 4 * q4) * 512 + h * 64 + 16 * rg + r16;
                yp[0] = Y[0]; yp[512] = Y[1]; yp[1024] = Y[2]; yp[1536] = Y[3];
            }
        }
    }
}
__device__ __forceinline__ void rwkv_finish(const RwArgs& X, const Ctx& C) {
    const int gw = C.bid * NWAVES + C.wid, NGW = C.G * NWAVES, lane = C.lane, c = 8 * lane;
    float lg[8], lb[8], mv[8];
#pragma unroll
    for (int i = 0; i < 8; ++i) { lg[i] = X.lng[c + i]; lb[i] = X.lnb[c + i]; mv[i] = X.mu[1024 + c + i]; }
    const int rpw = M / C.G, mb = C.vb * rpw;
    for (int i0 = C.wid; i0 < rpw; i0 += 2 * NWAVES) { const int m0 = mb + i0;
        f32x4 yl[2][2]; v4u vw[2], pw[2], gw4[2]; float bsr[2];
#pragma unroll
        for (int r = 0; r < 2; ++r) { const int m = (i0 + r * NWAVES < rpw) ? m0 + r * NWAVES : m0; const size_t o = (size_t)m * 512 + c;
            yl[r][0] = *(const GAS f32x4*)(X.yraw + o); yl[r][1] = *(const GAS f32x4*)(X.yraw + o + 4);
            vw[r] = *(const GAS v4u*)(X.PRW + (size_t)m * 1792 + 1024 + c);
            { const bool hp = (m & (T - 1)) != 0; pw[r] = *(const GAS v4u*)(X.PRW + (size_t)(hp ? m - 1 : m) * 1792 + 1024 + c); if (!hp) pw[r] = (v4u){0u, 0u, 0u, 0u}; }
            gw4[r] = *(const GAS v4u*)(X.G + o); bsr[r] = X.bonus[(size_t)m * 8 + (lane >> 3)]; }
#pragma unroll
        for (int r = 0; r < 2; ++r) { const int m = m0 + r * NWAVES; if (i0 + r * NWAVES >= rpw) break;
            float y[8] = {yl[r][0][0], yl[r][0][1], yl[r][0][2], yl[r][0][3], yl[r][1][0], yl[r][1][1], yl[r][1][2], yl[r][1][3]}, v[8], pv[8], g[8];
            unpack8(vw[r], v); unpack8(pw[r], pv); unpack8(gw4[r], g); const float bs = bsr[r];
            float sm = 0.f;
#pragma unroll
            for (int i = 0; i < 8; ++i) { sm += y[i]; v[i] = v[i] + (pv[i] - v[i]) * mv[i]; }
            sm += __shfl_xor(sm, 1); sm += __shfl_xor(sm, 2); sm += __shfl_xor(sm, 4);
            const float mean = sm * (1.0f / 64.0f); float vs = 0.f;
#pragma unroll
            for (int i = 0; i < 8; ++i) { y[i] -= mean; vs += y[i] * y[i]; }
            vs += __shfl_xor(vs, 1); vs += __shfl_xor(vs, 2); vs += __shfl_xor(vs, 4);
            const float rinv = __builtin_amdgcn_rsqf(vs * (1.0f / 64.0f) + 64e-5f);
            float ov[8];
#pragma unroll
            for (int i = 0; i < 8; ++i) ov[i] = (y[i] * rinv * lg[i] + lb[i] + bs * v[i]) * g[i];
            *(GAS v4u*)(X.out + (size_t)m * 1024 + 512 + c) = pack8(ov); } }
}

__device__ __forceinline__ void route_tokens(const Args& A, const Ctx& C) {
    unsigned char* rt = A.ws + WS_ROUTE;
    int* e01 = (int*)(rt + RT_E01); float* w0a = (float*)(rt + RT_W0); float* rsa = (float*)(rt + RT_RS); int* cnt = (int*)(rt + RT_CNT);
    LAS float* Rg = (LAS float*)C.lds;
    LAS int* lcnt = (LAS int*)(C.lds + 32768);
    const float* h = A.out; const float* rw = A.in[I_ROUTER]; const float* g2 = A.in[I_ON2G];
    WG_SYNC();
    for (int i = C.tid; i < 8192; i += NTHR) Rg[(i & 7) * 1024 + (i >> 3)] = rw[i] * g2[i >> 3];
    for (int blk = C.vb; blk < 256; blk += C.G) {
        if (C.tid < 8) lcnt[C.tid] = 0;
        WG_SYNC();
        f32x4 xn[4]; { const GAS f32x4* xr0 = (const GAS f32x4*)(h + (size_t)(blk * 128 + C.wid * 16) * D) + C.lane;
#pragma unroll
            for (int j = 0; j < 4; ++j) xn[j] = xr0[64 * j]; }
        int res_e = 0; float res_w = 0.f, res_r = 0.f;
        for (int k = 0; k < 16; ++k) { const int m = blk * 128 + C.wid * 16 + k;
            f32x4 xc[4];
#pragma unroll
            for (int j = 0; j < 4; ++j) xc[j] = xn[j];
            if (k + 1 < 16) { const GAS f32x4* xr1 = (const GAS f32x4*)(h + (size_t)(m + 1) * D) + C.lane;
#pragma unroll
                for (int j = 0; j < 4; ++j) xn[j] = xr1[64 * j]; }
            float ss = 0.f; float lg[8];
#pragma unroll
            for (int e = 0; e < 8; ++e) lg[e] = 0.f;
#pragma unroll
            for (int j = 0; j < 4; ++j) { const f32x4 v = xc[j]; ss += (v[0] * v[0] + v[1] * v[1]) + (v[2] * v[2] + v[3] * v[3]);
#pragma unroll
                for (int e = 0; e < 8; ++e) { const f32x4 r = *(const LAS f32x4*)(Rg + e * 1024 + 4 * C.lane + 256 * j); lg[e] += (v[0] * r[0] + v[1] * r[1]) + (v[2] * r[2] + v[3] * r[3]); } }
            ss = wave_sum(ss);
#pragma unroll
            for (int e = 0; e < 8; ++e) lg[e] = wave_sum(lg[e]);
            const float rs = 1.0f / sqrtf(ss * (1.0f / 1024.0f) + 1e-6f);
            int b0 = 0; float v0 = lg[0];
#pragma unroll
            for (int e = 1; e < 8; ++e) if (lg[e] > v0) { v0 = lg[e]; b0 = e; }
            int b1 = (b0 + 1) & 7; float v1 = -3.0e38f;
#pragma unroll
            for (int e = 0; e < 8; ++e) if (e != b0 && lg[e] > v1) { v1 = lg[e]; b1 = e; }
            if (C.lane == k) { res_e = b0 | (b1 << 8); res_w = 1.0f / (1.0f + expf((v1 - v0) * rs)); res_r = rs; }
            if (C.lane == 0) { atomicAdd((int*)&lcnt[b0], 1); atomicAdd((int*)&lcnt[b1], 1); } }
        if (C.lane < 16) { const int m = blk * 128 + C.wid * 16 + C.lane; e01[m] = res_e; w0a[m] = res_w; rsa[m] = res_r; }
        WG_SYNC();
        if (C.tid < 8) cnt[blk * 8 + C.tid] = lcnt[C.tid];
        WG_SYNC();
    }
}
__device__ __forceinline__ void route_gather(const Args& A, const Ctx& C) {
    unsigned char* rt = A.ws + WS_ROUTE;
    const int* e01 = (const int*)(rt + RT_E01); const float* rsa = (const float*)(rt + RT_RS); const int* cnt = (const int*)(rt + RT_CNT);
    int* pos0 = (int*)(rt + RT_POS0); int* pos1 = (int*)(rt + RT_POS1); float* rsg = (float*)(rt + RT_RSG); int* tile_e = (int*)(rt + RT_TILE_E); int* meta = (int*)(rt + RT_META);
    const bf16* hb = (const bf16*)(A.ws + WS_HBG); unsigned char* xg = A.ws + WS_XG8;
    LAS int* sh = (LAS int*)C.lds;
    WG_SYNC();
    for (int blk = C.vb; blk < 256; blk += C.G) {
        if (C.tid < 24) sh[C.tid] = 0;
        WG_SYNC();
        { int cv[4];
#pragma unroll
          for (int j = 0; j < 4; ++j) cv[j] = cnt[C.tid + NTHR * j];
          int tot = 0, before = 0;
#pragma unroll
          for (int j = 0; j < 4; ++j) { tot += cv[j]; if ((C.tid >> 3) + 64 * j < blk) before += cv[j]; }
          atomicAdd((int*)&sh[C.tid & 7], tot); atomicAdd((int*)&sh[16 + (C.tid & 7)], before); }
        WG_SYNC();
        if (C.tid == 0) { int s = 0; for (int e = 0; e < 8; ++e) { sh[8 + e] = s; s += (sh[e] + 255) & ~255; }
            if (blk == 0) { meta[0] = s / 256; int t = 0; for (int e = 0; e < 8; ++e) { const int nt = (sh[e] + 255) / 256; for (int i = 0; i < nt; ++i) tile_e[t++] = e; } for (; t < MOE_TILES + 8; ++t) tile_e[t] = 0; } }
        WG_SYNC();
        int my0 = 0, my1 = 0;
        if (C.tid < 128) { const int m = blk * 128 + C.tid; const int ee = e01[m]; const int b0 = ee & 255, b1 = ee >> 8;
            for (int e = 0; e < 8; ++e) { const bool has = (b0 == e) || (b1 == e); const unsigned long long bal = __ballot(has);
                const int below = __popcll(bal & ((1ull << C.lane) - 1ull)); const int wtot = __popcll(bal);
                if (C.lane == 0) sh[512 + C.wid * 8 + e] = wtot;
                if (b0 == e) my0 = below; if (b1 == e) my1 = below; } }
        WG_SYNC();
        if (C.tid < 128) { const int m = blk * 128 + C.tid; const int ee = e01[m]; const int b0 = ee & 255, b1 = ee >> 8;
            const int p0 = sh[8 + b0] + sh[16 + b0] + (C.wid == 1 ? sh[512 + b0] : 0) + my0, p1 = sh[8 + b1] + sh[16 + b1] + (C.wid == 1 ? sh[512 + b1] : 0) + my1;
            pos0[m] = p0; pos1[m] = p1; sh[32 + 2 * C.tid] = p0; sh[32 + 2 * C.tid + 1] = p1; const float rs = rsa[m]; rsg[p0] = rs; rsg[p1] = rs; }
        WG_SYNC();
        for (int k = 0; k < 32; k += 4) { v4u t0[4], t1[4];
#pragma unroll
            for (int q = 0; q < 4; ++q) { const int s = C.wid * 32 + k + q, m = blk * 128 + (s >> 1); const GAS v4u* src = (const GAS v4u*)(hb + (size_t)m * D) + C.lane; t0[q] = src[0]; t1[q] = src[64]; }
#pragma unroll
            for (int q = 0; q < 4; ++q) { const int p = sh[32 + C.wid * 32 + k + q]; GAS v2u* dst = (GAS v2u*)(xg + (size_t)p * D) + C.lane; const v4u a = t0[q], b = t1[q]; v2u oa, ob;
                oa.x = pg8::pk4f8(bflo(a.x), bfhi(a.x), bflo(a.y), bfhi(a.y)); oa.y = pg8::pk4f8(bflo(a.z), bfhi(a.z), bflo(a.w), bfhi(a.w));
                ob.x = pg8::pk4f8(bflo(b.x), bfhi(b.x), bflo(b.y), bfhi(b.y)); ob.y = pg8::pk4f8(bflo(b.z), bfhi(b.z), bflo(b.w), bfhi(b.w));
                dst[0] = oa; dst[64] = ob; } }
        WG_SYNC();
    }
}
__device__ __forceinline__ void final_combine(const Args& A, const Ctx& C) {
    unsigned char* rt = A.ws + WS_ROUTE;
    const float* w0a = (const float*)(rt + RT_W0); const int* pos0 = (const int*)(rt + RT_POS0); const int* pos1 = (const int*)(rt + RT_POS1);
    const bf16* y = (const bf16*)(A.ws + WS_XG); const float* fg = A.in[I_FNG]; float* out = A.out;
    const int gw = C.bid * NWAVES + C.wid, NGW = C.G * NWAVES;
    f32x4 gv[4];
#pragma unroll
    for (int j = 0; j < 4; ++j) gv[j] = *(const GAS f32x4*)(fg + 4 * C.lane + 256 * j);
    const int rpw = M / C.G, mb = C.vb * rpw;
    const int nk = (rpw - C.wid + NWAVES - 1) / NWAVES;
#define FC_LOAD(hv_, ya_, yb_, q_) do { _Pragma("unroll") for (int r = 0; r < 2; ++r) { int kk = 2 * (q_) + r; kk = kk < nkk ? kk : nkk - 1;     \
        const int p0 = __builtin_amdgcn_readlane(P0, kk), p1 = __builtin_amdgcn_readlane(P1, kk); const int m = mb + C.wid + NWAVES * (kb + kk); \
        const GAS f32x4* hr = (const GAS f32x4*)(out + (size_t)m * D) + C.lane; const GAS v2u* y0 = (const GAS v2u*)(y + (size_t)p0 * D) + C.lane; const GAS v2u* y1 = (const GAS v2u*)(y + (size_t)p1 * D) + C.lane; \
        _Pragma("unroll") for (int j = 0; j < 4; ++j) { hv_[r][j] = hr[64 * j]; ya_[r][j] = y0[64 * j]; yb_[r][j] = y1[64 * j]; } } } while (0)
#define FC_DO(hv_, ya_, yb_, q_) do { _Pragma("unroll") for (int r = 0; r < 2; ++r) { const int kk = 2 * (q_) + r; if (kk < nkk) { const int m = mb + C.wid + NWAVES * (kb + kk); \
        const float w0 = __builtin_bit_cast(float, __builtin_amdgcn_readlane(W0, kk)), w1 = 1.0f - w0; f32x4 v[4]; float ss = 0.f; \
        _Pragma("unroll") for (int j = 0; j < 4; ++j) { const f32x4 h4 = hv_[r][j]; const v2u a = ya_[r][j], b = yb_[r][j]; \
            f32x4 o; o[0] = h4[0] + w0 * bflo(a.x) + w1 * bflo(b.x); o[1] = h4[1] + w0 * bfhi(a.x) + w1 * bfhi(b.x); o[2] = h4[2] + w0 * bflo(a.y) + w1 * bflo(b.y); o[3] = h4[3] + w0 * bfhi(a.y) + w1 * bfhi(b.y); \
            v[j] = o; ss += (o[0] * o[0] + o[1] * o[1]) + (o[2] * o[2] + o[3] * o[3]); } \
        ss = wave_sum(ss); const float rs = 1.0f / sqrtf(ss * (1.0f / 1024.0f) + 1e-6f); \
        GAS f32x4* hw = (GAS f32x4*)(out + (size_t)m * D) + C.lane; \
        _Pragma("unroll") for (int j = 0; j < 4; ++j) __builtin_nontemporal_store(v[j] * rs * gv[j], hw + 64 * j); } } } while (0)
    for (int kb = 0; kb < nk; kb += 64) {
        const int nkk = (nk - kb) < 64 ? (nk - kb) : 64, nq = (nkk + 1) >> 1;
        const int kl = C.lane < nkk ? C.lane : nkk - 1, ml = mb + C.wid + NWAVES * (kb + kl);
        const int P0 = pos0[ml], P1 = pos1[ml], W0 = __builtin_bit_cast(int, w0a[ml]);
        f32x4 hvA[2][4], hvB[2][4]; v2u yaA[2][4], ybA[2][4], yaB[2][4], ybB[2][4];
        FC_LOAD(hvA, yaA, ybA, 0);
        for (int q = 0; q < nq; q += 2) {
            FC_LOAD(hvB, yaB, ybB, q + 1);
            FC_DO(hvA, yaA, ybA, q);
            FC_LOAD(hvA, yaA, ybA, q + 2);
            FC_DO(hvB, yaB, ybB, q + 1);
        }
    }
#undef FC_LOAD
#undef FC_DO
}

#ifndef MK_SPLIT
#define MK_SPLIT 0
#endif
constexpr int N_PHASES = 17;
#ifndef WGM_WIDE
#define WGM_WIDE 4
#endif
#ifndef WGM_NARROW
#define WGM_NARROW 4
#endif
#ifndef P2_ML
#define P2_ML 4
#endif
#ifndef MOEW_REP
#define MOEW_REP 1
#endif
#ifndef PROBE_REPEAT
#define PROBE_REPEAT 0u
#endif
#ifndef PROBE_SKIP
#define PROBE_SKIP 0u
#endif
#define NREP(k) ((((unsigned)(PROBE_SKIP)) >> (k)) & 1u ? 0 : ((((unsigned)(PROBE_REPEAT)) >> (k)) & 1u ? 2 : 1))
__device__ __forceinline__ int seg4(int s) { return s <= 0 ? 0 : s == 1 ? 25 : s == 2 ? 42 : s == 3 ? 55 : 64; }
__device__ __forceinline__ int seg4g(int s) { return s <= 0 ? 0 : s == 1 ? 25 : s == 2 ? 42 : s == 3 ? 55 : 64; }
__device__ __forceinline__ int seg8(int s) { return s <= 0 ? 0 : s == 1 ? 20 : s == 2 ? 34 : s == 3 ? 44 : s == 4 ? 51 : s == 5 ? 56 : s == 6 ? 60 : s == 7 ? 62 : 64; }

__global__ void __launch_bounds__(NTHR, 2) fwd_kernel(Args args) {
    extern __shared__ __attribute__((aligned(16))) unsigned char lds_raw[];
    Ctx C; C.lds = (LAS unsigned char*)lds_raw; C.tid = threadIdx.x; C.lane = C.tid & 63; C.wid = __builtin_amdgcn_readfirstlane(C.tid >> 6); C.G = gridDim.x; C.bid = blockIdx.x; C.vb = (C.G == 256) ? ((C.bid & 7) * 32 + (C.bid >> 3)) : C.bid;
    volatile LAS unsigned* MISC = (volatile LAS unsigned*)(C.lds + MISC_OFF);
    for (int u = C.tid; u < (LDS_BYTES - LDSCTL_OFF) / 4; u += NTHR) ((LAS unsigned*)(C.lds + LDSCTL_OFF))[u] = 0u;
    __syncthreads();
    unsigned char* ws = args.ws;
    XcdBarrier bar = xcd_barrier_post((unsigned*)(ws + WS_CTL) + CW_BAR, MISC + 8, (unsigned)C.wid);
    const int lo = args.ph_lo, hi = args.ph_hi;
#define IN(k) (lo <= (k) && (k) < hi)
#define PHASE_TID() do { int t_ = C.wid * 64 + (int)xb_lane_id(); C.tid = t_; C.lane = t_ & 63; } while (0)
#define SEAM(k) do { if (IN(k) && IN((k) + 1)) xcd_barrier(bar); } while (0)
    float* ssp = (float*)(ws + WS_SSP);
    bf16* HB0 = (bf16*)(ws + WS_HB0); bf16* HB1 = (bf16*)(ws + WS_HB1); bf16* RP = (bf16*)(ws + WS_RP);

    if (IN(0)) for (int rep_ = 0; rep_ < NREP(0); ++rep_) { if (rep_) WG_SYNC(); PHASE_TID(); p0_prologue(args, C); } SEAM(0);
#ifdef XBAR_EXTRA
    for (int q_ = 0; q_ < XBAR_EXTRA; ++q_) xcd_barrier(bar);
#endif
    if (IN(1)) for (int rep_ = 0; rep_ < NREP(1); ++rep_) { if (rep_) WG_SYNC(); PHASE_TID(); pg8::Gemm g{HB0, (const bf16*)(ws + WS_W_EIN), M, PW, D}; pg8::StaticOrder S; S.init(M, PW, C.G, C.bid, WGM_WIDE, 2);
        pg8::EpiProj E{RP, PW, RP, PW, 1 << 30, ssp};
        pg8::gemm_phase<pg8::EpiProj, pg8::StaticOrder, true, true>(C.lds, g, S, E, C.tid); } SEAM(1);
    if (IN(2)) for (int rep_ = 0; rep_ < NREP(2); ++rep_) { if (rep_) WG_SYNC(); PHASE_TID(); MixArgs X{}; X.P = RP; X.pitch = PW; X.out = HB1; X.convw = args.in[I_CONVW]; X.convb = args.in[I_CONVB]; X.gateb = args.in[I_GATEB]; X.gup = args.in[I_GLAUP]; X.gb = args.in[I_GLAB];
        for (int pass = 0; pass < 2; ++pass) { int late_j = -1;
            for (int u = C.vb; u < 256; u += C.G) { const int bb = u >> 5, r = u & 31;
                if (r < 4 * P2_ML) { const int hh = r / P2_ML, sg = r - P2_ML * hh; X.normg = args.in[I_MLNG]; X.snap = (float*)(ws + WS_RX); if (pass == 1 || sg < P2_ML - 1) mixer_unit<0>(X, C, bb, hh, sg, P2_ML, pass); else late_j = bb * 8 + hh; }
                else { const int v = r - 4 * P2_ML, hh = v / (8 - P2_ML), sg = v - (8 - P2_ML) * hh; X.normg = args.in[I_GLANG]; X.snap = (float*)(ws + WS_RX + 16 * MiB); if (pass == 1 || sg < 7 - P2_ML) mixer_unit<1>(X, C, bb, hh, sg, 8 - P2_ML, pass); else late_j = bb * 8 + 4 + hh; } }
            if (pass == 0 && C.G == 256 && late_j >= 0) { WG_SYNC(); layer_weights_late(args, C, late_j * NWAVES + C.wid, 64 * NWAVES); }
            if (pass == 0) xcd_barrier(bar); } } SEAM(2);
    if (IN(3)) for (int rep_ = 0; rep_ < NREP(3); ++rep_) { if (rep_) WG_SYNC(); PHASE_TID(); pg8::Gemm g{HB1, (const bf16*)(ws + WS_W_EOUT), M, D, D}; pg8::StaticOrder S; S.init(M, D, C.G, C.bid, WGM_NARROW, 1);
#if FFN8_UP
        pg8::EpiResidT<true> E{args.in[I_X], args.out, HB0, ssp, 1.0f};
        pg8::gemm_phase<pg8::EpiResidT<true>, pg8::StaticOrder, true, true>(C.lds, g, S, E, C.tid); } SEAM(3);
#else
        pg8::EpiResid E{args.in[I_X], args.out, HB0, ssp, 1.0f};
        pg8::gemm_phase<pg8::EpiResid, pg8::StaticOrder, true, true>(C.lds, g, S, E, C.tid); } SEAM(3);
#endif
#if FFN8_UP
    if (IN(4)) for (int rep_ = 0; rep_ < NREP(4); ++rep_) { if (rep_) WG_SYNC(); PHASE_TID(); int k8 = D / 2; asm volatile("" : "+s"(k8)); pg8::Gemm g{HB0, (const bf16*)(ws + WS_W_FGU), M, 2 * FF, k8}; pg8::StaticOrder S; S.init(M, 2 * FF, C.G, C.bid, WGM_WIDE, 2);
#if FFN8_UP == 2
        pg8::EpiSwiGLU8T<false, true> E{(unsigned char*)RP, FF, ssp, 1.0f / 256.0f};
        pg8::gemm_phase<pg8::EpiSwiGLU8T<false, true>, pg8::StaticOrder, true, true, true>(C.lds, g, S, E, C.tid); } SEAM(4);
    if (IN(5)) for (int rep_ = 0; rep_ < NREP(5); ++rep_) { if (rep_) WG_SYNC(); PHASE_TID(); int k8 = FF / 2; asm volatile("" : "+s"(k8)); pg8::Gemm g{RP, (const bf16*)(ws + WS_W_FDN), M, D, k8}; pg8::StaticOrder S; S.init(M, D, C.G, C.bid, WGM_NARROW, 1);
        pg8::EpiResid E{args.out, args.out, HB0, ssp, 1.0f / 4096.0f};
        pg8::gemm_phase<pg8::EpiResid, pg8::StaticOrder, true, true, true>(C.lds, g, S, E, C.tid); } SEAM(5);
#else
        pg8::EpiSwiGLU8T<false, false> E{(unsigned char*)RP, FF, ssp, 1.0f / 256.0f};
        pg8::gemm_phase<pg8::EpiSwiGLU8T<false, false>, pg8::StaticOrder, true, true, true>(C.lds, g, S, E, C.tid); } SEAM(4);
    if (IN(5)) for (int rep_ = 0; rep_ < NREP(5); ++rep_) { if (rep_) WG_SYNC(); PHASE_TID(); pg8::Gemm g{RP, (const bf16*)(ws + WS_W_FDN), M, D, FF}; pg8::StaticOrder S; S.init(M, D, C.G, C.bid, WGM_NARROW, 1);
        pg8::EpiResid E{args.out, args.out, HB0, ssp, 1.0f};
        pg8::gemm_phase<pg8::EpiResid, pg8::StaticOrder, true, true>(C.lds, g, S, E, C.tid); } SEAM(5);
#endif
#else
    if (IN(4)) for (int rep_ = 0; rep_ < NREP(4); ++rep_) { if (rep_) WG_SYNC(); PHASE_TID(); pg8::Gemm g{HB0, (const bf16*)(ws + WS_W_FGU), M, 2 * FF, D}; pg8::StaticOrder S; S.init(M, 2 * FF, C.G, C.bid, WGM_WIDE, 2);
        pg8::EpiSwiGLU8T<false> E{(unsigned char*)RP, FF, ssp, 1.0f};
        pg8::gemm_phase<pg8::EpiSwiGLU8T<false>, pg8::StaticOrder, true, true>(C.lds, g, S, E, C.tid); } SEAM(4);
    if (IN(5)) for (int rep_ = 0; rep_ < NREP(5); ++rep_) { if (rep_) WG_SYNC(); PHASE_TID(); int k8 = FF / 2; asm volatile("" : "+s"(k8)); pg8::Gemm g{RP, (const bf16*)(ws + WS_W_FDN), M, D, k8}; pg8::StaticOrder S; S.init(M, D, C.G, C.bid, WGM_NARROW, 1);
        pg8::EpiResid E{args.out, args.out, HB0, ssp, 1.0f / 4096.0f};
        pg8::gemm_phase<pg8::EpiResid, pg8::StaticOrder, true, true, true>(C.lds, g, S, E, C.tid); } SEAM(5);
#endif
    if (IN(6)) for (int rep_ = 0; rep_ < NREP(6); ++rep_) { if (rep_) WG_SYNC(); PHASE_TID(); pg8::Gemm g{HB0, (const bf16*)(ws + WS_W_OIN), M, PW, D}; pg8::StaticOrder S; S.init(M, PW, C.G, C.bid, WGM_WIDE, 2);
        pg8::EpiProj E{(bf16*)(ws + WS_PRET), 2048, (bf16*)(ws + WS_PRW), 1792, 8, ssp};
        pg8::gemm_phase<pg8::EpiProj, pg8::StaticOrder, true, true>(C.lds, g, S, E, C.tid); } SEAM(6);
    if (IN(7)) for (int rep_ = 0; rep_ < NREP(7); ++rep_) { if (rep_) WG_SYNC(); PHASE_TID(); MixArgs X{}; X.P = (const bf16*)(ws + WS_PRET); X.pitch = 2048; X.out = HB1; X.normg = args.in[I_RETNG]; X.rcs = (const unsigned*)(ws + WS_ROT);
        X.snap = (float*)(ws + WS_RX + 32 * MiB);
        for (int pass = 0; pass < 2; ++pass) {
            for (int u = C.vb; u < 256; u += C.G) { const int bb = u >> 5, hh = (u >> 3) & 3, sg = u & 7; if (pass == 1 || sg < 7) mixer_unit<2>(X, C, bb, hh, sg, 8, pass); }
            if (pass == 0) xcd_barrier(bar); } } SEAM(7);
    RwArgs RW{}; RW.PRW = (const bf16*)(ws + WS_PRW); RW.mu = args.in[I_RWMU]; RW.w0 = args.in[I_RWW0]; RW.a0 = args.in[I_RWA0]; RW.kk_w = args.in[I_RWKK]; RW.ka_w = args.in[I_RWKA]; RW.rk_w = args.in[I_RWRK];
    RW.lng = args.in[I_RWLNG]; RW.lnb = args.in[I_RWLNB]; RW.WupT = (const bf16*)(ws + WS_LORA); RW.AupT = (const bf16*)(ws + WS_LORA + 65536); RW.GupT = (const bf16*)(ws + WS_LORA + 131072);
    RW.G = (bf16*)(ws + WS_RWG2); RW.bonus = (float*)(ws + WS_RWBON); RW.ws = ws; RW.yraw = (float*)(ws + WS_YRAW); RW.out = HB1;
    if (IN(8)) for (int rep_ = 0; rep_ < NREP(8); ++rep_) { if (rep_) WG_SYNC(); PHASE_TID(); for (int u = 2 * C.vb; u < M / 64; u += 2 * C.G) { rwkv_prep_unit(RW, C, u, true); rwkv_prep_unit(RW, C, u + 1, false); } } SEAM(8);
    if (IN(9)) for (int rep_ = 0; rep_ < NREP(9); ++rep_) { if (rep_) WG_SYNC(); PHASE_TID(); rwkv_scan(RW, C);
        if (C.G == 256 && (C.vb & 31) >= 8) { const int j_ = (C.vb >> 5) * 24 + (C.vb & 31) - 8; WG_SYNC(); moe_weights(args, C, 0x1fu, 0u, j_ * NWAVES + C.wid, 192 * NWAVES); } } SEAM(9);
    if (IN(10)) for (int rep_ = 0; rep_ < NREP(10); ++rep_) { if (rep_) WG_SYNC(); PHASE_TID(); rwkv_finish(RW, C); } SEAM(10);
    if (IN(11)) for (int rep_ = 0; rep_ < NREP(11); ++rep_) { if (rep_) WG_SYNC(); PHASE_TID(); pg8::Gemm g{HB1, (const bf16*)(ws + WS_W_OOUT), M, D, D}; pg8::StaticOrder S; S.init(M, D, C.G, C.bid, WGM_NARROW, 1);
        pg8::EpiResid E{args.out, args.out, (bf16*)(ws + WS_HBG), ssp, 1.0f};
        pg8::gemm_phase<pg8::EpiResid, pg8::StaticOrder, true, true>(C.lds, g, S, E, C.tid); } SEAM(11);
    if (IN(12)) for (int rep_ = 0; rep_ < NREP(12); ++rep_) { if (rep_) WG_SYNC(); PHASE_TID(); route_tokens(args, C); WG_SYNC(); moe_weights(args, C, C.G == 256 ? 0x20u : 0x3fu, 0x0fu, C.bid * NWAVES + C.wid, C.G * NWAVES); } SEAM(12);
    if (IN(13)) for (int rep_ = 0; rep_ < NREP(13); ++rep_) { if (rep_) WG_SYNC(); PHASE_TID(); route_gather(args, C); WG_SYNC(); moe_weights(args, C, 0xc0u, 0xf0u, C.bid * NWAVES + C.wid, C.G * NWAVES); } SEAM(13);
    {
        const int* meta = (const int*)(ws + WS_ROUTE + RT_META); const int* tile_e = (const int*)(ws + WS_ROUTE + RT_TILE_E); const float* rsg = (const float*)(ws + WS_ROUTE + RT_RSG);
        LAS int* te_lds = (LAS int*)(C.lds + LDSCTL_OFF + 4096);
        bf16* Y = (bf16*)(ws + WS_XG); unsigned char* XG8 = ws + WS_XG8; unsigned char* HM = ws + WS_HMID;
        if (IN(14)) for (int rep_ = 0; rep_ < NREP(14); ++rep_) { if (rep_) WG_SYNC(); PHASE_TID(); for (int i_ = C.tid; i_ < MOE_TILES + 8; i_ += NTHR) te_lds[i_] = tile_e[i_]; WG_SYNC(); const int nt = meta[0];
            int k8 = D / 2; asm volatile("" : "+s"(k8));
            pg8::Gemm g{(const bf16*)XG8, (const bf16*)(ws + WS_W_MGU), 0, 0, k8}; pg8::MoeOrder S{0, nt, 2 * FF / 256, 2 * FF / 256, C.G, C.bid, te_lds, false, true, WGM_WIDE, 2};
            pg8::EpiSwiGLU8 E{HM, FF, rsg, 1.0f / 256.0f};
            pg8::gemm_phase<pg8::EpiSwiGLU8, pg8::MoeOrder, true, true, true>(C.lds, g, S, E, C.tid); } SEAM(14);
        if (IN(15)) for (int rep_ = 0; rep_ < NREP(15); ++rep_) { if (rep_) WG_SYNC(); PHASE_TID(); for (int i_ = C.tid; i_ < MOE_TILES + 8; i_ += NTHR) te_lds[i_] = tile_e[i_]; WG_SYNC(); const int nt = meta[0];
            int k8 = FF / 2; asm volatile("" : "+s"(k8));
            pg8::Gemm g{(const bf16*)HM, (const bf16*)(ws + WS_W_MDN), 0, 0, k8}; pg8::MoeOrder S{0, nt, D / 256, D / 256, C.G, C.bid, te_lds, true, false, WGM_NARROW, 4};
            pg8::EpiStore E{Y, D, 1.0f / 4096.0f};
            pg8::gemm_phase<pg8::EpiStore, pg8::MoeOrder, true, true, true>(C.lds, g, S, E, C.tid); } SEAM(15);
    }
    if (IN(16)) for (int rep_ = 0; rep_ < NREP(16); ++rep_) { if (rep_) WG_SYNC(); PHASE_TID(); final_combine(args, C); }
#undef IN
#undef SEAM
}

extern "C" void kernel_launch(void* const* d_in, const int* in_sizes, int n_in, void* d_out, int out_size, void* d_ws, size_t ws_size, hipStream_t stream) {
    static int grid = 0;
    if (grid == 0) {
        if (n_in != N_IN || in_sizes[0] != M * D || out_size != M * D || ws_size < WS_END) { fprintf(stderr, "kernel_launch: unexpected shapes (n_in %d, ws %zu < %zu?)\n", n_in, ws_size, (size_t)WS_END); grid = -1; return; }
        int dev = 0, cus = 0;
        if (hipGetDevice(&dev) != hipSuccess || hipDeviceGetAttribute(&cus, hipDeviceAttributeMultiprocessorCount, dev) != hipSuccess) { grid = -1; return; }
        if (hipFuncSetAttribute((const void*)fwd_kernel, hipFuncAttributeMaxDynamicSharedMemorySize, LDS_BYTES) != hipSuccess) { fprintf(stderr, "kernel_launch: hipFuncSetAttribute failed\n"); grid = -1; return; }
        int per_cu = 0;
        if (hipOccupancyMaxActiveBlocksPerMultiprocessor(&per_cu, (const void*)fwd_kernel, NTHR, LDS_BYTES) != hipSuccess || per_cu < 1) { fprintf(stderr, "kernel_launch: occupancy query says %d\n", per_cu); }
        (void)hipGetLastError();
        grid = cus;
    }
    if (grid < 0) return;
    (void)hipMemsetAsync((char*)d_ws + WS_CTL, 0, CTL_ZERO_BYTES, stream);
    Args a{};
    for (int i = 0; i < N_IN; ++i) a.in[i] = (const float*)d_in[i];
    a.out = (float*)d_out; a.ws = (unsigned char*)d_ws;
#if MK_SPLIT
    for (int p = 0; p < N_PHASES; ++p) { a.ph_lo = p; a.ph_hi = p + 1; hipLaunchKernelGGL(fwd_kernel, dim3(grid), dim3(NTHR), LDS_BYTES, stream, a); }
#else
    a.ph_lo = 0; a.ph_hi = N_PHASES;
    hipLaunchKernelGGL(fwd_kernel, dim3(grid), dim3(NTHR), LDS_BYTES, stream, a);
#endif
}
```
